# Optimizing an MI355X kernel written in HIP

```python
import math
import jax, jax.numpy as jnp
from jax import lax
import numpy as np

D_MODEL = 2048
BATCH = 8
SEQ = 2048
DEPTH = 2

GRID_W = 64
EPS = 1e-6
WIDTH_A = D_MODEL // 2
WIDTH_B = D_MODEL // 2
HG_DK = 128
HG_DV = 128
HG_HEADS = WIDTH_A // HG_DV
HG_CHUNK = 32
NA_DH = 64
NA_HEADS = WIDTH_B // NA_DH
NA_KH_MAX = 8
NA_KW = 16
DA_DH = 128
DA_DV = 2 * DA_DH
DA_HEADS = D_MODEL // (2 * DA_DH)
DA_QK_WIDTH = 2 * DA_HEADS * DA_DH
ROPE_THETA = 500000.0
ROPE_DIM = DA_DH // 4
Q_BLOCK = 128
N_EXPERTS = 16
N_GROUPS = 4
EXPERTS_PER_GROUP = N_EXPERTS // N_GROUPS
TOP_K = 2
GROUP_SCORE_K = 2
D_FF = D_MODEL // 2
EVEN_IN_WIDTH = 5 * WIDTH_A + 3 * WIDTH_B
ODD_IN_WIDTH = 2 * DA_QK_WIDTH + DA_HEADS * DA_DV

kernel_name = 'hybrid_hgrn2_natten_diffattn_moe'


def rmsnorm(x, g):
    x32 = x.astype(jnp.float32)
    y = x32 * lax.rsqrt(jnp.mean(x32 * x32, axis=-1, keepdims=True) + EPS)
    return y.astype(x.dtype) * g


def modulate(h, shift, scale):
    return h * (1.0 + scale[:, None, :]) + shift[:, None, :]


def to_heads(x, n_heads):
    B, T, W = x.shape
    return x.reshape(B, T, n_heads, W // n_heads).transpose(0, 2, 1, 3)


def gla_chunked(q, k, v, g):
    B, H, T, dk = q.shape
    dv = v.shape[-1]
    n = T // HG_CHUNK
    q, k, g = [a.astype(jnp.float32).reshape(B, H, n, HG_CHUNK, dk) for a in (q, k, g)]
    v = v.astype(jnp.float32).reshape(B, H, n, HG_CHUNK, dv)
    G = jnp.cumsum(g, axis=3)
    G_last = G[:, :, :, -1:, :]
    qg = q * jnp.exp(G)
    kg = k * jnp.exp(-G)
    lower_tri = jnp.tril(jnp.ones((HG_CHUNK, HG_CHUNK), dtype=bool))
    A = jnp.where(lower_tri, jnp.einsum('bhncd,bhnsd->bhncs', qg, kg), 0.0)
    o_intra = jnp.einsum('bhncs,bhnsv->bhncv', A, v)
    U = jnp.einsum('bhncd,bhncv->bhndv', k * jnp.exp(G_last - G), v)
    decay = jnp.exp(G_last[:, :, :, 0, :])

    def step(S, inp):
        dec, u = inp
        return dec[..., None] * S + u, S

    S0 = jnp.zeros((B, H, dk, dv), jnp.float32)
    _, S_prev = lax.scan(step, S0, (jnp.moveaxis(decay, 2, 0), jnp.moveaxis(U, 2, 0)))
    S_prev = jnp.moveaxis(S_prev, 0, 2)
    o_inter = jnp.einsum('bhncd,bhndv->bhncv', qg, S_prev)
    return (o_intra + o_inter).reshape(B, H, T, dv)


def hgrn2_mixer(q, i, f_fwd, f_bwd, gate, lb, norm_g):
    dt = q.dtype
    qh = jax.nn.silu(to_heads(q, HG_HEADS))
    ih = to_heads(i, HG_HEADS)
    lb_h = lb.reshape(HG_HEADS, 1, HG_DK)

    def run_direction(f_logits, qd, vd):
        f = lb_h + (1.0 - lb_h) * jax.nn.sigmoid(to_heads(f_logits, HG_HEADS).astype(jnp.float32))
        return gla_chunked(qd, 1.0 - f, vd, jnp.log(f))

    o_fwd = run_direction(f_fwd, qh, ih)
    o_bwd = jnp.flip(run_direction(jnp.flip(f_bwd, 1), jnp.flip(qh, 2), jnp.flip(ih, 2)), 2)
    o = (o_fwd + o_bwd).astype(dt).transpose(0, 2, 1, 3)
    o = rmsnorm(o, norm_g)
    B, T = o.shape[:2]
    return o.reshape(B, T, HG_HEADS * HG_DV) * jax.nn.silu(gate)


def neighbourhood_attention(q, k, v, rpb):
    B, T, _ = q.shape
    rows = T // GRID_W
    kh = min(NA_KH_MAX, rows)
    q = q.reshape(B, rows, GRID_W, NA_HEADS, NA_DH)
    k = k.reshape(B, rows, GRID_W, NA_HEADS, NA_DH)
    v = v.reshape(B, rows, GRID_W, NA_HEADS, NA_DH)
    r = jnp.arange(rows)
    row_idx = jnp.clip(r - kh // 2, 0, rows - kh)[:, None] + jnp.arange(kh)[None, :]
    kg = k[:, row_idx]
    vg = v[:, row_idx]
    s = jnp.einsum('brchd,brkshd->bhrcks', q, kg).astype(jnp.float32) * (NA_DH ** -0.5)
    col = jnp.arange(GRID_W)
    col_start = jnp.clip(col - NA_KW // 2, 0, GRID_W - NA_KW)
    in_win = (col[None, :] >= col_start[:, None]) & (col[None, :] < col_start[:, None] + NA_KW)
    dr = row_idx - r[:, None] + (NA_KH_MAX - 1)
    dc = jnp.clip(col[None, :] - col[:, None] + (NA_KW - 1), 0, 2 * NA_KW - 2)
    bias = rpb[:, dr[:, None, :, None], dc[None, :, None, :]]
    s = jnp.where(in_win[:, None, :], s + bias[None].astype(jnp.float32), -1e30)
    shp = s.shape
    p = jax.nn.softmax(s.reshape(shp[:4] + (kh * GRID_W,)), axis=-1).reshape(shp).astype(v.dtype)
    o = jnp.einsum('bhrcks,brkshd->brchd', p, vg)
    return o.reshape(B, T, NA_HEADS * NA_DH)


def rope_partial(x, pos):
    half = ROPE_DIM // 2
    inv = ROPE_THETA ** (-jnp.arange(half, dtype=jnp.float32) / half)
    ang = pos[:, None] * inv[None, :]
    cos = jnp.cos(ang)[None, :, None, :].astype(x.dtype)
    sin = jnp.sin(ang)[None, :, None, :].astype(x.dtype)
    x1 = x[..., :half]
    x2 = x[..., half:ROPE_DIM]
    return jnp.concatenate([x1 * cos - x2 * sin, x1 * sin + x2 * cos, x[..., ROPE_DIM:]], axis=-1)


def even_mixer(h, w_in, hgrn_norm, na_rpb, w_out, lb):
    proj = h @ w_in
    q_hg, i_hg, f_fwd, f_bwd, g_hg, q_na, k_na, v_na = jnp.split(
        proj, np.cumsum([WIDTH_A] * 5 + [WIDTH_B] * 2).tolist(), axis=-1)
    o_a = hgrn2_mixer(q_hg, i_hg, f_fwd, f_bwd, g_hg, lb, hgrn_norm)
    o_b = neighbourhood_attention(q_na, k_na, v_na, na_rpb)
    return jnp.concatenate([o_a, o_b], axis=-1) @ w_out


def odd_mixer(h, w_in, diff_lambda, diff_norm, w_out, layer_idx):
    B, T, _ = h.shape
    proj = h @ w_in
    q, k, v = jnp.split(proj, [DA_QK_WIDTH, 2 * DA_QK_WIDTH], axis=-1)
    pos = jnp.arange(T, dtype=jnp.float32)
    q = rope_partial(q.reshape(B, T, 2 * DA_HEADS, DA_DH), pos).reshape(B, T, DA_HEADS, 2, DA_DH)
    k = rope_partial(k.reshape(B, T, 2 * DA_HEADS, DA_DH), pos).reshape(B, T, DA_HEADS, 2, DA_DH)
    v = v.reshape(B, T, DA_HEADS, DA_DV)
    lam_init = 0.8 - 0.6 * math.exp(-0.3 * layer_idx)
    lp = diff_lambda.astype(jnp.float32)
    lam = jnp.exp(jnp.sum(lp[0] * lp[1])) - jnp.exp(jnp.sum(lp[2] * lp[3])) + lam_init
    nb = T // Q_BLOCK
    qb = jnp.moveaxis(q.reshape(B, nb, Q_BLOCK, DA_HEADS, 2, DA_DH), 1, 0)

    def block(qblk):
        s = jnp.einsum('bqhid,bkhid->bhiqk', qblk, k).astype(jnp.float32) * (DA_DH ** -0.5)
        p = jax.nn.softmax(s, axis=-1)
        a = (p[:, :, 0] - lam * p[:, :, 1]).astype(v.dtype)
        return jnp.einsum('bhqk,bkhv->bqhv', a, v)

    o = lax.map(block, qb)
    o = jnp.moveaxis(o, 0, 1).reshape(B, T, DA_HEADS, DA_DV)
    o = rmsnorm(o, diff_norm) * (1.0 - lam_init)
    return o.reshape(B, T, DA_HEADS * DA_DV) @ w_out


def moe(h, router_w, router_b, wg, wu, wd):
    scores = jax.nn.sigmoid((h @ router_w).astype(jnp.float32))
    sel = scores + router_b.astype(jnp.float32)
    grp = sel.reshape(sel.shape[:-1] + (N_GROUPS, EXPERTS_PER_GROUP))
    grp_score = jnp.sum(lax.top_k(grp, GROUP_SCORE_K)[0], axis=-1)
    best_group = jnp.argmax(grp_score, axis=-1)
    expert_group = jnp.arange(N_EXPERTS) // EXPERTS_PER_GROUP
    masked = jnp.where(best_group[..., None] == expert_group, sel, -jnp.inf)
    _, idx = lax.top_k(masked, TOP_K)
    w = jnp.take_along_axis(scores, idx, axis=-1)
    w = w / jnp.sum(w, axis=-1, keepdims=True)
    gates = jnp.sum(jax.nn.one_hot(idx, N_EXPERTS, dtype=jnp.float32) * w[..., None], axis=-2)

    def per_sequence(args):
        xb, gb = args
        a = jnp.einsum('td,edf->tef', xb, wg)
        u = jnp.einsum('td,edf->tef', xb, wu)
        hid = jax.nn.silu(a) * u * gb[..., None].astype(xb.dtype)
        return jnp.einsum('tef,efd->td', hid, wd)

    return lax.map(per_sequence, (h, gates))


def setup_inputs(seed: int = 0) -> dict:
    key = jax.random.key(seed)
    ks = jax.random.split(key, 32)
    D = D_MODEL

    def nrm(i, shape, s):
        return jax.random.normal(ks[i], shape, jnp.float32) * s

    return {
        'x': nrm(0, (BATCH, SEQ, D), 1.0),
        'c': nrm(1, (BATCH, D), 1.0),
        'ln_attn_0': 1.0 + nrm(2, (D,), 0.05),
        'ada_w_0': nrm(3, (D, 6 * D), 0.5 * D ** -0.5),
        'ada_b_0': nrm(4, (6 * D,), 0.02),
        'w_in_0': nrm(5, (D, EVEN_IN_WIDTH), D ** -0.5),
        'hgrn_norm_0': 1.0 + nrm(6, (HG_HEADS, HG_DV), 0.05),
        'na_rpb_0': nrm(7, (NA_HEADS, 2 * NA_KH_MAX - 1, 2 * NA_KW - 1), 0.1),
        'w_out_0': nrm(8, (WIDTH_A + WIDTH_B, D), (WIDTH_A + WIDTH_B) ** -0.5),
        'ln_ffn_0': 1.0 + nrm(9, (D,), 0.05),
        'moe_wg_0': nrm(10, (N_EXPERTS, D, D_FF), D ** -0.5),
        'moe_wu_0': nrm(11, (N_EXPERTS, D, D_FF), D ** -0.5),
        'moe_wd_0': nrm(12, (N_EXPERTS, D_FF, D), D_FF ** -0.5),
        'ln_attn_1': 1.0 + nrm(13, (D,), 0.05),
        'ada_w_1': nrm(14, (D, 6 * D), 0.5 * D ** -0.5),
        'ada_b_1': nrm(15, (6 * D,), 0.02),
        'w_in_1': nrm(16, (D, ODD_IN_WIDTH), D ** -0.5),
        'diff_lambda_1': nrm(17, (4, DA_DH), 0.1),
        'diff_norm_1': 1.0 + nrm(18, (DA_DV,), 0.05),
        'w_out_1': nrm(19, (DA_HEADS * DA_DV, D), (DA_HEADS * DA_DV) ** -0.5),
        'ln_ffn_1': 1.0 + nrm(20, (D,), 0.05),
        'moe_wg_1': nrm(21, (N_EXPERTS, D, D_FF), D ** -0.5),
        'moe_wu_1': nrm(22, (N_EXPERTS, D, D_FF), D ** -0.5),
        'moe_wd_1': nrm(23, (N_EXPERTS, D_FF, D), D_FF ** -0.5),
        'hgrn_lb_logits': nrm(24, (DEPTH + 1, WIDTH_A), 0.1),
        'router_w': nrm(25, (D, N_EXPERTS), D ** -0.5),
        'router_b': nrm(26, (N_EXPERTS,), 0.01),
        'ln_final': 1.0 + nrm(27, (D,), 0.05),
    }


def reference(x, c, ln_attn_0, ada_w_0, ada_b_0, w_in_0, hgrn_norm_0, na_rpb_0, w_out_0,
              ln_ffn_0, moe_wg_0, moe_wu_0, moe_wd_0, ln_attn_1, ada_w_1, ada_b_1, w_in_1,
              diff_lambda_1, diff_norm_1, w_out_1, ln_ffn_1, moe_wg_1, moe_wu_1, moe_wd_1,
              hgrn_lb_logits, router_w, router_b, ln_final):
    lower_bounds = jnp.cumsum(jax.nn.softmax(hgrn_lb_logits.astype(jnp.float32), axis=0), axis=0)
    layers = [
        dict(ln_attn=ln_attn_0, ada_w=ada_w_0, ada_b=ada_b_0, ln_ffn=ln_ffn_0,
             mix=(w_in_0, hgrn_norm_0, na_rpb_0, w_out_0), moe=(moe_wg_0, moe_wu_0, moe_wd_0)),
        dict(ln_attn=ln_attn_1, ada_w=ada_w_1, ada_b=ada_b_1, ln_ffn=ln_ffn_1,
             mix=(w_in_1, diff_lambda_1, diff_norm_1, w_out_1), moe=(moe_wg_1, moe_wu_1, moe_wd_1)),
    ]
    c_act = jax.nn.silu(c)
    for l in range(DEPTH):
        p = layers[l]
        mod = c_act @ p['ada_w'] + p['ada_b']
        sh_a, sc_a, gt_a, sh_f, sc_f, gt_f = jnp.split(mod, 6, axis=-1)
        h = modulate(rmsnorm(x, p['ln_attn']), sh_a, sc_a)
        if l % 2 == 0:
            m = even_mixer(h, *p['mix'], lb=lower_bounds[l])
        else:
            m = odd_mixer(h, *p['mix'], layer_idx=l)
        x = x + gt_a[:, None, :] * m
        h = modulate(rmsnorm(x, p['ln_ffn']), sh_f, sc_f)
        x = x + gt_f[:, None, :] * moe(h, router_w, router_b, *p['moe'])
    return rmsnorm(x, ln_final)
```

```cpp
#include <hip/hip_runtime.h>
#include <cstdio>
#include <cstdint>
#include <cmath>

#define LAS __attribute__((address_space(3)))
typedef unsigned short bf16_t;
typedef float f32x4 __attribute__((ext_vector_type(4)));
typedef float f32x2 __attribute__((ext_vector_type(2)));
typedef __bf16 bf16x2_t __attribute__((ext_vector_type(2)));
typedef unsigned u32x4 __attribute__((ext_vector_type(4)));
typedef unsigned u32x2 __attribute__((ext_vector_type(2)));

constexpr int NB = 8, T = 2048, D = 2048, M = NB * T;
constexpr int EVW = 8192, ODW = 6144, NE = 16, DFF = 1024;
constexpr int LD0 = EVW + 64, LD1 = ODW + 64, VTLD = M + 64;
constexpr int PMAX = 2 * M + NE * 256;
constexpr float EPS = 1e-6f;
constexpr float LAM_INIT = 0.35550906759f;

constexpr size_t MiB = 1u << 20;
constexpr size_t WS_CTL = 0, CTL_BYTES = 1 * MiB;
constexpr size_t WS_MOD = 1 * MiB;
constexpr size_t WS_ROPE = 2 * MiB;
constexpr size_t WS_TOK = 3 * MiB;
constexpr size_t WS_LIST = 4 * MiB;
constexpr size_t WS_LW = 5 * MiB;
constexpr size_t WS_XB = 8 * MiB;
constexpr size_t WS_ACT = 136 * MiB;
constexpr size_t WS_PROJ = 200 * MiB;
constexpr size_t WS_HID = WS_PROJ, WS_Y = WS_PROJ + 72 * MiB;
constexpr size_t WS_W = 464 * MiB;
constexpr size_t WS_WIN0 = WS_W, WS_WOUT0 = WS_WIN0 + 32 * MiB, WS_WGU0 = WS_WOUT0 + 8 * MiB, WS_WD0 = WS_WGU0 + 128 * MiB;
constexpr size_t WS_WIN1 = WS_WD0 + 64 * MiB, WS_WOUT1 = WS_WIN1 + 24 * MiB, WS_WGU1 = WS_WOUT1 + 8 * MiB, WS_WD1 = WS_WGU1 + 128 * MiB;
constexpr size_t WS_VT = WS_WD1 + 64 * MiB;
constexpr size_t WS_O1 = WS_WD1 + 64 * MiB;
constexpr size_t WS_END = WS_O1 + 128 * MiB;
constexpr int CW_BAR = 4096, CW_CNT = 8192, CW_NAQ = 8448, CW_FLG = 12288;
constexpr int LDS_BYTES = 163840;
constexpr int LDS_BASE_OFF = 131072 + 1024;
constexpr int LDS_UCNT_OFF = LDS_BASE_OFF + 128;

#define XB_TMO      128
#define XB_XCNT(j)  (256  + 64 * (j))
#define XB_XSUB(j)  (1280 + 64 * (j))
#define XB_XGEN(j)  (2304 + 64 * (j))
#define XB_TOP      3328
#define XB_TOPGEN   3392
#define XCD_BAR_WORDS 3456
#define XB_SPIN_CAP (1u << 20)
__device__ __forceinline__ unsigned xb_ld(unsigned* p)              { return __hip_atomic_load(p, __ATOMIC_RELAXED, __HIP_MEMORY_SCOPE_AGENT); }
__device__ __forceinline__ unsigned xb_add(unsigned* p, unsigned v) { return __hip_atomic_fetch_add(p, v, __ATOMIC_RELAXED, __HIP_MEMORY_SCOPE_AGENT); }
__device__ __forceinline__ unsigned xb_xcc_id() { return (unsigned)__builtin_amdgcn_s_getreg((3 << 11) | 20) & 0xFu; }
#define XB_SPIN(cond, bar) do { unsigned _sp = 0; while (cond) { __builtin_amdgcn_s_sleep(1); \
    if ((++_sp & 255u) == 0u) { if (xb_ld(&(bar)[XB_TMO])) break; if (_sp > XB_SPIN_CAP) { atomicAdd(&(bar)[XB_TMO], 1u); break; } } } } while (0)
struct XcdBarrier { unsigned* bar; unsigned x; volatile LAS unsigned* st; };
__device__ __forceinline__ XcdBarrier xcd_barrier_post(unsigned* bar, volatile LAS unsigned* st) {
    XcdBarrier b; b.bar = bar; b.x = xb_xcc_id(); b.st = st;
    if (threadIdx.x == 0) (void)xb_add(&bar[XB_XCNT(b.x)], 1u);
    return b;
}
__device__ __forceinline__ void xcd_barrier_complete(unsigned* bar, unsigned x, unsigned& nloc, unsigned& nx) {
    const unsigned G = gridDim.x * gridDim.y * gridDim.z;
    unsigned sum, cnt, mine, sp = 0u;
    for (;;) {
        sum = 0u; cnt = 0u; mine = 0u;
#pragma unroll
        for (unsigned j = 0; j < 16; ++j) { const unsigned c = xb_ld(&bar[XB_XCNT(j)]); sum += c; cnt += (c > 0u) ? 1u : 0u; mine = (j == x) ? c : mine; }
        if (sum == G) break;
        __builtin_amdgcn_s_sleep(1);
        if ((++sp & 255u) == 0u) { if (xb_ld(&bar[XB_TMO])) break; if (sp > XB_SPIN_CAP) { atomicAdd(&bar[XB_TMO], 1u); break; } }
    }
    nloc = mine > 0u ? mine : 1u; nx = cnt > 0u ? cnt : 1u;
}
__device__ __forceinline__ void xcd_barrier(const XcdBarrier& b) {
    asm volatile("s_waitcnt vmcnt(0)" ::: "memory");
    __syncthreads();
    if (threadIdx.x == 0) {
        unsigned* bar = b.bar;
        __builtin_amdgcn_s_waitcnt(0);
        unsigned nloc = b.st[0], nx = b.st[1];
        if (nloc == 0u) { xcd_barrier_complete(bar, b.x, nloc, nx); b.st[0] = nloc; b.st[1] = nx; }
        const unsigned old = xb_add(&bar[XB_XSUB(b.x)], 1u);
        const unsigned gen = old / nloc;
        if (old + 1u == (gen + 1u) * nloc) {
            __builtin_amdgcn_fence(__ATOMIC_RELEASE, "agent");
            asm volatile("s_waitcnt vmcnt(0)" ::: "memory");
            const unsigned og = xb_add(&bar[XB_TOP], 1u);
            const unsigned tg = og / nx;
            if (og + 1u == (tg + 1u) * nx) xb_add(&bar[XB_TOPGEN], 1u);
            else XB_SPIN(xb_ld(&bar[XB_TOPGEN]) == tg, bar);
            __builtin_amdgcn_fence(__ATOMIC_ACQUIRE, "agent");
            xb_add(&bar[XB_XGEN(b.x)], 1u);
            asm volatile("s_waitcnt vmcnt(0)" ::: "memory");
        } else {
            XB_SPIN(xb_ld(&bar[XB_XGEN(b.x)]) == gen, bar);
            __builtin_amdgcn_fence(__ATOMIC_ACQUIRE, "agent");
            asm volatile("s_waitcnt vmcnt(0)" ::: "memory");
        }
    }
    __syncthreads();
}

__device__ __forceinline__ int opaque_tid() { int t = threadIdx.x; asm volatile("" : "+v"(t)); return t; }
__device__ __forceinline__ float bf2f(bf16_t v) { return __uint_as_float((unsigned)v << 16); }
__device__ __forceinline__ unsigned pk2(float a, float b) { f32x2 v = {a, b}; bf16x2_t r = __builtin_convertvector(v, bf16x2_t); return __builtin_bit_cast(unsigned, r); }
__device__ __forceinline__ bf16_t f2bf(float a) { return (bf16_t)(pk2(a, 0.f) & 0xffffu); }
__device__ __forceinline__ float frcp(float x) { return __builtin_amdgcn_rcpf(x); }
__device__ __forceinline__ float sigm(float x) { return frcp(1.f + __expf(-x)); }
__device__ __forceinline__ float silu(float x) { return x * frcp(1.f + __expf(-x)); }
constexpr bool OUT_F8 = true;
constexpr float F8_SM = 8.f;
constexpr float F8_SA = 16.f, F8_SW = 256.f, F8_SH = 8.f, F8_SWD = 256.f;
__device__ __forceinline__ unsigned pk4_fp8(float a, float b, float c, float d) { unsigned w = 0u; w = __builtin_amdgcn_cvt_pk_fp8_f32(a, b, w, false); w = __builtin_amdgcn_cvt_pk_fp8_f32(c, d, w, true); return w; }
__device__ __forceinline__ float wave_sum(float v) {
#pragma unroll
    for (int o = 1; o < 64; o <<= 1) v += __shfl_xor(v, o);
    return v;
}
__device__ __forceinline__ float wave_max(float v) {
#pragma unroll
    for (int o = 1; o < 64; o <<= 1) v = fmaxf(v, __shfl_xor(v, o));
    return v;
}

enum WsIx { IX_ACT, IX_CTL, IX_HID, IX_LIST, IX_LW, IX_MOD, IX_O1, IX_PROJ, IX_ROPE, IX_TOK, IX_VT, IX_WD0, IX_WD1, IX_WGU0, IX_WGU1, IX_WIN0, IX_WIN1, IX_WOUT0, IX_WOUT1, IX_XB, IX_Y, IX_N };
struct Params {
    const float* in[28];
    float* out;
    unsigned char* wp[IX_N];
    double inv[16];
};

__device__ __forceinline__ void phase_mod(const Params& p, LAS unsigned char* lds) {
    LAS float* cact = (LAS float*)lds;
    LAS float* red = (LAS float*)(lds + 65536);
    const int tid = opaque_tid(), wave = tid >> 6, lane = tid & 63;
    const float* c = p.in[1];
    float* mod = (float*)(p.wp[IX_MOD]);
    for (int i = tid; i < 8 * 2048; i += 512) { const int b = i / 2048, k = i % 2048; cact[k * 8 + b] = silu(c[i]); }
    __syncthreads();
    for (int u = blockIdx.x; u < 192; u += gridDim.x) {
        const int l = u / 96, cb = u % 96;
        const float* W = p.in[l ? 14 : 3]; const float* bias = p.in[l ? 15 : 4];
        float acc[8][2];
#pragma unroll
        for (int b = 0; b < 8; ++b) { acc[b][0] = 0.f; acc[b][1] = 0.f; }
        const float* wp = W + (size_t)(wave * 256) * 12288 + cb * 128 + 2 * lane;
#pragma unroll 16
        for (int k = 0; k < 256; ++k) {
            const f32x2 w = __builtin_nontemporal_load((const f32x2*)(wp + (size_t)k * 12288));
            const f32x4 c0 = *(LAS f32x4*)(cact + (wave * 256 + k) * 8), c1 = *(LAS f32x4*)(cact + (wave * 256 + k) * 8 + 4);
            acc[0][0] += c0.x * w.x; acc[0][1] += c0.x * w.y; acc[1][0] += c0.y * w.x; acc[1][1] += c0.y * w.y;
            acc[2][0] += c0.z * w.x; acc[2][1] += c0.z * w.y; acc[3][0] += c0.w * w.x; acc[3][1] += c0.w * w.y;
            acc[4][0] += c1.x * w.x; acc[4][1] += c1.x * w.y; acc[5][0] += c1.y * w.x; acc[5][1] += c1.y * w.y;
            acc[6][0] += c1.z * w.x; acc[6][1] += c1.z * w.y; acc[7][0] += c1.w * w.x; acc[7][1] += c1.w * w.y;
        }
#pragma unroll
        for (int b = 0; b < 8; ++b) { red[(wave * 8 + b) * 128 + 2 * lane] = acc[b][0]; red[(wave * 8 + b) * 128 + 2 * lane + 1] = acc[b][1]; }
        __syncthreads();
        for (int o = tid; o < 1024; o += 512) {
            const int b = o / 128, j = o % 128; float s = 0.f;
#pragma unroll
            for (int w = 0; w < 8; ++w) s += red[(w * 8 + b) * 128 + j];
            mod[(size_t)(l * 8 + b) * 12288 + cb * 128 + j] = s + bias[cb * 128 + j];
        }
        __syncthreads();
    }
    float* rc = (float*)(p.wp[IX_ROPE]); float* rs = rc + 2048 * 16;
    for (int i = blockIdx.x * 512 + tid; i < 2048 * 16; i += gridDim.x * 512) {
        const int pos = i / 16, j = i % 16;
        const double ang = (double)pos * p.inv[j];
        const double n = rint(ang * 0.15915494309189535);
        double r = fma(-n, 6.283185307179586, ang); r = fma(-n, 2.4492935982947064e-16, r);
        rc[i] = cosf((float)r); rs[i] = sinf((float)r);
    }
}

__device__ __forceinline__ void compute_base(const unsigned* cnt, LAS int* base) {
    if (threadIdx.x == 0) { int s = 0; for (int e = 0; e < NE; ++e) { base[e] = s; s += ((int)cnt[e] + 255) / 256 * 256; } base[NE] = s; *(LAS unsigned*)((LAS unsigned char*)base + 128) = 0u; }
    __syncthreads();
}
template <bool COMBINE, bool ROUTE, bool FINAL, bool OUT8 = false, bool DUMMY = false>
__device__ __forceinline__ void phase_rows(const Params& p, LAS unsigned char* lds, const float* xin, float* xnew, const float* g, const float* modl  ,
                                           int sh_off, int sc_off, const float* modprev  , bf16_t* hout, float* fout,
                                           const unsigned* cnt_prev, unsigned* cnt_cur, const bf16_t* mres = nullptr  ) {
    const int tid = opaque_tid(), wave = tid >> 6, lane = tid & 63;
    LAS int* base = (LAS int*)(lds + LDS_BASE_OFF);
    if (COMBINE) compute_base(cnt_prev, base);
    const int* tok_e = (const int*)(p.wp[IX_TOK]); const int* tok_pos = tok_e + 2 * M;
    int* tok_e_w = DUMMY ? (int*)(p.wp[IX_Y] + 4 * MiB) : (int*)(p.wp[IX_TOK]); int* tok_pos_w = tok_e_w + 2 * M;
    const bf16_t* Y = (const bf16_t*)(p.wp[IX_Y]);
    int* list = DUMMY ? (int*)(p.wp[IX_Y]) : (int*)(p.wp[IX_LIST]); float* lw = DUMMY ? (float*)(p.wp[IX_Y] + 2 * MiB) : (float*)(p.wp[IX_LW]);
    const float* rw = p.in[25]; const float* rb = p.in[26];
    LAS f32x4* WT = (LAS f32x4*)lds;
    LAS unsigned* rt_cnt = (LAS unsigned*)(lds + 131072 + 2048);
    LAS int* rt_sel = (LAS int*)(lds + 131072 + 4096);
    int rslot = 0;
    if (ROUTE) { if (tid < 32) rt_cnt[tid] = 0u;
        for (int i = tid; i < 8192; i += 512) { const int k = i >> 2, eg = i & 3; WT[(((k >> 8) * 4 + (k & 3)) * 4 + eg) * 64 + ((k & 255) >> 2)] = *(const f32x4*)(rw + k * 16 + eg * 4); }
        __syncthreads(); }
    for (int m = blockIdx.x * 8 + wave; m < M; m += gridDim.x * 8) {
        const int b = m / T;
        f32x4 xv[8];
#pragma unroll
        for (int j = 0; j < 8; ++j) xv[j] = *(const f32x4*)(xin + (size_t)m * D + 4 * lane + 256 * j);
        if (mres) { const float* gta = modl + (size_t)b * 12288 + 2 * D;
#pragma unroll
            for (int j = 0; j < 8; ++j) { const int c = 4 * lane + 256 * j; const u32x2 mm = *(const u32x2*)(mres + (size_t)m * D + c); const f32x4 gv = *(const f32x4*)(gta + c);
                xv[j].x += gv.x * __uint_as_float(mm.x << 16); xv[j].y += gv.y * __uint_as_float(mm.x & 0xffff0000u); xv[j].z += gv.z * __uint_as_float(mm.y << 16); xv[j].w += gv.w * __uint_as_float(mm.y & 0xffff0000u); } }
        if (COMBINE) {
            const int e0 = tok_e[2 * m], e1 = tok_e[2 * m + 1];
            const size_t r0 = (size_t)(base[e0] + tok_pos[2 * m]), r1 = (size_t)(base[e1] + tok_pos[2 * m + 1]);
            const float* gt = modprev + (size_t)b * 12288 + 5 * D;
#pragma unroll
            for (int j = 0; j < 8; ++j) {
                const int c = 4 * lane + 256 * j;
                const u32x2 a = *(const u32x2*)(Y + r0 * D + c), bb = *(const u32x2*)(Y + r1 * D + c);
                const f32x4 gv = *(const f32x4*)(gt + c);
                xv[j].x += gv.x * (__uint_as_float(a.x << 16) + __uint_as_float(bb.x << 16));
                xv[j].y += gv.y * (__uint_as_float(a.x & 0xffff0000u) + __uint_as_float(bb.x & 0xffff0000u));
                xv[j].z += gv.z * (__uint_as_float(a.y << 16) + __uint_as_float(bb.y << 16));
                xv[j].w += gv.w * (__uint_as_float(a.y & 0xffff0000u) + __uint_as_float(bb.y & 0xffff0000u));
                if (!FINAL) *(f32x4*)(xnew + (size_t)m * D + c) = xv[j];
            }
        }
        float ss = 0.f;
#pragma unroll
        for (int j = 0; j < 8; ++j) ss += xv[j].x * xv[j].x + xv[j].y * xv[j].y + xv[j].z * xv[j].z + xv[j].w * xv[j].w;
        ss = wave_sum(ss);
        const float rstd = 1.0f / sqrtf(ss * (1.f / D) + EPS);
        if (FINAL) {
#pragma unroll
            for (int j = 0; j < 8; ++j) { const int c = 4 * lane + 256 * j; const f32x4 gv = *(const f32x4*)(g + c); *(f32x4*)(fout + (size_t)m * D + c) = xv[j] * rstd * gv; }
        } else {
            const float* sh = modl + (size_t)b * 12288 + sh_off; const float* sc = modl + (size_t)b * 12288 + sc_off;
#pragma unroll
            for (int j = 0; j < 8; ++j) {
                const int c = 4 * lane + 256 * j;
                const f32x4 gv = *(const f32x4*)(g + c), shv = *(const f32x4*)(sh + c), scv = *(const f32x4*)(sc + c);
                xv[j] = xv[j] * rstd * gv * (1.f + scv) + shv;
                if (OUT8) *(unsigned*)((unsigned char*)hout + (size_t)m * D + c) = pk4_fp8(xv[j].x * F8_SA, xv[j].y * F8_SA, xv[j].z * F8_SA, xv[j].w * F8_SA);
                else { u32x2 o; o.x = pk2(xv[j].x, xv[j].y); o.y = pk2(xv[j].z, xv[j].w); *(u32x2*)(hout + (size_t)m * D + c) = o; }
            }
            if (ROUTE) {
                float lg[16];
#pragma unroll
                for (int e = 0; e < 16; ++e) lg[e] = 0.f;
#pragma unroll
                for (int j = 0; j < 8; ++j) {
#pragma unroll
                    for (int cc = 0; cc < 4; ++cc) {
                        const float hv = xv[j][cc];
                        const f32x4 w0 = WT[((j * 4 + cc) * 4 + 0) * 64 + lane], w1 = WT[((j * 4 + cc) * 4 + 1) * 64 + lane], w2 = WT[((j * 4 + cc) * 4 + 2) * 64 + lane], w3 = WT[((j * 4 + cc) * 4 + 3) * 64 + lane];
                        lg[0] += hv * w0.x; lg[1] += hv * w0.y; lg[2] += hv * w0.z; lg[3] += hv * w0.w;
                        lg[4] += hv * w1.x; lg[5] += hv * w1.y; lg[6] += hv * w1.z; lg[7] += hv * w1.w;
                        lg[8] += hv * w2.x; lg[9] += hv * w2.y; lg[10] += hv * w2.z; lg[11] += hv * w2.w;
                        lg[12] += hv * w3.x; lg[13] += hv * w3.y; lg[14] += hv * w3.z; lg[15] += hv * w3.w;
                    }
                    __builtin_amdgcn_sched_barrier(0);
                }
                float sc_[16], sel[16];
#pragma unroll
                for (int e = 0; e < 16; ++e) { lg[e] = wave_sum(lg[e]); sc_[e] = 1.f / (1.f + expf(-lg[e])); sel[e] = sc_[e] + rb[e]; }
                float gsv[4], gw1[4], gw2[4]; int gi1[4], gi2[4];
#pragma unroll
                for (int gq = 0; gq < 4; ++gq) {
                    float m1 = sel[4 * gq]; int i1 = 0; float s1 = sc_[4 * gq];
#pragma unroll
                    for (int i = 1; i < 4; ++i) if (sel[4 * gq + i] > m1) { m1 = sel[4 * gq + i]; i1 = i; s1 = sc_[4 * gq + i]; }
                    float m2 = -INFINITY; int i2 = 0; float s2 = 0.f;
#pragma unroll
                    for (int i = 0; i < 4; ++i) if (i != i1 && sel[4 * gq + i] > m2) { m2 = sel[4 * gq + i]; i2 = i; s2 = sc_[4 * gq + i]; }
                    gsv[gq] = m1 + m2; gi1[gq] = 4 * gq + i1; gi2[gq] = 4 * gq + i2; gw1[gq] = s1; gw2[gq] = s2;
                }
                float bv = gsv[0]; int e0 = gi1[0], e1 = gi2[0]; float w0 = gw1[0], w1 = gw2[0];
#pragma unroll
                for (int gq = 1; gq < 4; ++gq) if (gsv[gq] > bv) { bv = gsv[gq]; e0 = gi1[gq]; e1 = gi2[gq]; w0 = gw1[gq]; w1 = gw2[gq]; }
                const float wsum = w0 + w1; w0 /= wsum; w1 /= wsum;
                if (lane == 0) {
                    const int k = rslot++;
                    const int l0 = (int)__hip_atomic_fetch_add(rt_cnt + e0, 1u, __ATOMIC_RELAXED, __HIP_MEMORY_SCOPE_WORKGROUP), l1 = (int)__hip_atomic_fetch_add(rt_cnt + e1, 1u, __ATOMIC_RELAXED, __HIP_MEMORY_SCOPE_WORKGROUP);
                    LAS int* rr = rt_sel + (k * 8 + wave) * 8;
                    rr[0] = m; rr[1] = e0; rr[2] = e1; rr[3] = l0; rr[4] = l1; ((LAS float*)rr)[5] = w0; ((LAS float*)rr)[6] = w1;
                }
            }
        }
    }
    if (ROUTE) {
        __syncthreads();
        if (tid < NE) rt_cnt[16 + tid] = atomicAdd(cnt_cur + tid, rt_cnt[tid]);
        __syncthreads();
        const int nrow = (M - (int)blockIdx.x * 8 + (int)gridDim.x * 8 - 1) / ((int)gridDim.x * 8);
        for (int i = tid; i < nrow * 8; i += 512) {
            const LAS int* rr = rt_sel + i * 8; const int m = rr[0], e0 = rr[1], e1 = rr[2];
            const int p0 = (int)rt_cnt[16 + e0] + rr[3], p1 = (int)rt_cnt[16 + e1] + rr[4];
            list[e0 * M + p0] = m; lw[e0 * M + p0] = ((const LAS float*)rr)[5]; list[e1 * M + p1] = m; lw[e1 * M + p1] = ((const LAS float*)rr)[6];
            tok_e_w[2 * m] = e0; tok_e_w[2 * m + 1] = e1; tok_pos_w[2 * m] = p0; tok_pos_w[2 * m + 1] = p1;
        }
    }
}

__device__ __forceinline__ void hgrn_combine(const Params& p) {
    const bf16_t* proj = (const bf16_t*)(p.wp[IX_PROJ]);
    const bf16_t* oscr = (const bf16_t*)(p.wp[IX_XB]);
    unsigned char* mix8 = p.wp[IX_ACT]; bf16_t* mix = (bf16_t*)(p.wp[IX_ACT]);
    const float* ng = p.in[6];
    const int tid_ = opaque_tid(), wave = tid_ >> 6, lane = tid_ & 63, c = 16 * lane;
    f32x4 gn[4];
#pragma unroll
    for (int q = 0; q < 4; ++q) gn[q] = *(const f32x4*)(ng + c + 4 * q);
    const int stride = gridDim.x * 8;
    u32x4 na[2][2], nb[2][2], ng_[2][2];
#define HC_LOAD(r0_) do { _Pragma("unroll") for (int r = 0; r < 2; ++r) { const int rw = ((r0_) + r * stride < M) ? (r0_) + r * stride : (r0_); \
        _Pragma("unroll") for (int hq = 0; hq < 2; ++hq) { na[r][hq] = *(const u32x4*)(oscr + (size_t)rw * 1024 + c + 8 * hq); nb[r][hq] = *(const u32x4*)(oscr + ((size_t)M + rw) * 1024 + c + 8 * hq); \
            ng_[r][hq] = *(const u32x4*)(proj + (size_t)rw * LD0 + 4096 + c + 8 * hq); } } } while (0)
    int row = blockIdx.x * 8 + wave;
    if (row < M) HC_LOAD(row);
    for (; row < M; row += 2 * stride) {
        u32x4 a[2][2], bb[2][2], gg[2][2];
#pragma unroll
        for (int r = 0; r < 2; ++r)
#pragma unroll
            for (int hq = 0; hq < 2; ++hq) { a[r][hq] = na[r][hq]; bb[r][hq] = nb[r][hq]; gg[r][hq] = ng_[r][hq]; }
        if (row + 2 * stride < M) HC_LOAD(row + 2 * stride);
#pragma unroll
        for (int r = 0; r < 2; ++r) { const int rw = row + r * stride; if (rw >= M) break;
            float o[16]; float ss = 0.f;
#pragma unroll
            for (int hq = 0; hq < 2; ++hq)
#pragma unroll
                for (int k = 0; k < 4; ++k) { const unsigned x = a[r][hq][k], y = bb[r][hq][k];
                    const float v0 = __uint_as_float(x << 16) + __uint_as_float(y << 16), v1 = __uint_as_float(x & 0xffff0000u) + __uint_as_float(y & 0xffff0000u);
                    o[8 * hq + 2 * k] = v0; o[8 * hq + 2 * k + 1] = v1; ss += v0 * v0 + v1 * v1; }
            ss += __shfl_xor(ss, 1); ss += __shfl_xor(ss, 2); ss += __shfl_xor(ss, 4);
            const float rstd = 1.0f / sqrtf(ss * (1.f / 128.f) + EPS);
            float res[16];
#pragma unroll
            for (int hq = 0; hq < 2; ++hq)
#pragma unroll
                for (int k = 0; k < 4; ++k) { const unsigned g = gg[r][hq][k]; const int i0 = 8 * hq + 2 * k;
                    res[i0] = o[i0] * rstd * gn[i0 >> 2][i0 & 3] * silu(__uint_as_float(g << 16)); res[i0 + 1] = o[i0 + 1] * rstd * gn[(i0 + 1) >> 2][(i0 + 1) & 3] * silu(__uint_as_float(g & 0xffff0000u)); }
            if (OUT_F8) { u32x4 w; w.x = pk4_fp8(res[0] * F8_SM, res[1] * F8_SM, res[2] * F8_SM, res[3] * F8_SM); w.y = pk4_fp8(res[4] * F8_SM, res[5] * F8_SM, res[6] * F8_SM, res[7] * F8_SM);
                w.z = pk4_fp8(res[8] * F8_SM, res[9] * F8_SM, res[10] * F8_SM, res[11] * F8_SM); w.w = pk4_fp8(res[12] * F8_SM, res[13] * F8_SM, res[14] * F8_SM, res[15] * F8_SM);
                *(u32x4*)(mix8 + (size_t)rw * D + c) = w; }
            else { u32x4 w0, w1; w0.x = pk2(res[0], res[1]); w0.y = pk2(res[2], res[3]); w0.z = pk2(res[4], res[5]); w0.w = pk2(res[6], res[7]);
                w1.x = pk2(res[8], res[9]); w1.y = pk2(res[10], res[11]); w1.z = pk2(res[12], res[13]); w1.w = pk2(res[14], res[15]);
                *(u32x4*)(mix + (size_t)rw * D + c) = w0; *(u32x4*)(mix + (size_t)rw * D + c + 8) = w1; }
        }
    }
#undef HC_LOAD
}
__device__ __forceinline__ void rope_pass(const Params& p) {
    bf16_t* proj = (bf16_t*)(p.wp[IX_PROJ]);
    const float* rc = (const float*)(p.wp[IX_ROPE]); const float* rs = rc + 2048 * 16;
    for (size_t i = (size_t)blockIdx.x * 512 + opaque_tid(); i < (size_t)M * 32 * 16; i += (size_t)gridDim.x * 512) {
        const int j = (int)(i & 15), hh = (int)((i >> 4) & 31); const size_t row = i >> 9; const int pos = (int)(row % T);
        bf16_t* a = proj + row * LD1 + hh * 128 + j;
        const float x1 = bf2f(a[0]), x2 = bf2f(a[16]), cc = rc[pos * 16 + j], sn = rs[pos * 16 + j];
        a[0] = f2bf(x1 * cc - x2 * sn); a[16] = f2bf(x1 * sn + x2 * cc);
    }
}
template <bool FINAL, bool OUT8>
__device__ __forceinline__ void phase_combine(const Params& p, LAS unsigned char* lds, const float* xin, float* xnew, const float* g, const float* modl, const float* modprev, bf16_t* hout, float* fout, const unsigned* cnt_prev, const bf16_t* mres) {
    const int tid = opaque_tid(), wave = tid >> 6, lane = tid & 63;
    LAS int* base = (LAS int*)(lds + LDS_BASE_OFF);
    compute_base(cnt_prev, base);
    const int* tok_e = (const int*)(p.wp[IX_TOK]); const int* tok_pos = tok_e + 2 * M;
    const bf16_t* Y = (const bf16_t*)(p.wp[IX_Y]);
    const int stride = gridDim.x * 8;
    int m = blockIdx.x * 8 + wave;
    f32x4 xn[8]; u32x2 mn_[8]; int en0 = 0, en1 = 0, pn0 = 0, pn1 = 0;
    if (m < M) {
#pragma unroll
        for (int j = 0; j < 8; ++j) { xn[j] = *(const f32x4*)(xin + (size_t)m * D + 4 * lane + 256 * j); mn_[j] = *(const u32x2*)(mres + (size_t)m * D + 4 * lane + 256 * j); }
        en0 = tok_e[2 * m]; en1 = tok_e[2 * m + 1]; pn0 = tok_pos[2 * m]; pn1 = tok_pos[2 * m + 1]; }
    for (; m < M; m += stride) {
        const int b = m / T;
        f32x4 xv[8]; u32x2 mv[8];
#pragma unroll
        for (int j = 0; j < 8; ++j) { xv[j] = xn[j]; mv[j] = mn_[j]; }
        const size_t r0 = (size_t)(base[en0] + pn0), r1 = (size_t)(base[en1] + pn1);
        u32x2 ya[8], yb[8];
#pragma unroll
        for (int j = 0; j < 8; ++j) { const int c = 4 * lane + 256 * j; ya[j] = *(const u32x2*)(Y + r0 * D + c); yb[j] = *(const u32x2*)(Y + r1 * D + c); }
        const int mn = m + stride;
        if (mn < M) {
#pragma unroll
            for (int j = 0; j < 8; ++j) { xn[j] = *(const f32x4*)(xin + (size_t)mn * D + 4 * lane + 256 * j); mn_[j] = *(const u32x2*)(mres + (size_t)mn * D + 4 * lane + 256 * j); }
            en0 = tok_e[2 * mn]; en1 = tok_e[2 * mn + 1]; pn0 = tok_pos[2 * mn]; pn1 = tok_pos[2 * mn + 1]; }
        const float* gt = modprev + (size_t)b * 12288 + 5 * D; const float* gta = modprev + (size_t)b * 12288 + 2 * D;
        float ss = 0.f;
#pragma unroll
        for (int j = 0; j < 8; ++j) { const int c = 4 * lane + 256 * j; const f32x4 gv = *(const f32x4*)(gt + c), ga = *(const f32x4*)(gta + c); const u32x2 a = ya[j], bb = yb[j], mm = mv[j];
            xv[j].x += ga.x * __uint_as_float(mm.x << 16); xv[j].y += ga.y * __uint_as_float(mm.x & 0xffff0000u); xv[j].z += ga.z * __uint_as_float(mm.y << 16); xv[j].w += ga.w * __uint_as_float(mm.y & 0xffff0000u);
            xv[j].x += gv.x * (__uint_as_float(a.x << 16) + __uint_as_float(bb.x << 16)); xv[j].y += gv.y * (__uint_as_float(a.x & 0xffff0000u) + __uint_as_float(bb.x & 0xffff0000u));
            xv[j].z += gv.z * (__uint_as_float(a.y << 16) + __uint_as_float(bb.y << 16)); xv[j].w += gv.w * (__uint_as_float(a.y & 0xffff0000u) + __uint_as_float(bb.y & 0xffff0000u));
            if (!FINAL) *(f32x4*)(xnew + (size_t)m * D + c) = xv[j];
            ss += xv[j].x * xv[j].x + xv[j].y * xv[j].y + xv[j].z * xv[j].z + xv[j].w * xv[j].w; }
        ss = wave_sum(ss);
        const float rstd = 1.0f / sqrtf(ss * (1.f / D) + EPS);
        if (FINAL) {
#pragma unroll
            for (int j = 0; j < 8; ++j) { const int c = 4 * lane + 256 * j; const f32x4 gv = *(const f32x4*)(g + c); *(f32x4*)(fout + (size_t)m * D + c) = xv[j] * rstd * gv; }
        } else {
            const float* sh = modl + (size_t)b * 12288; const float* sc = modl + (size_t)b * 12288 + D;
#pragma unroll
            for (int j = 0; j < 8; ++j) { const int c = 4 * lane + 256 * j;
                const f32x4 gv = *(const f32x4*)(g + c), shv = *(const f32x4*)(sh + c), scv = *(const f32x4*)(sc + c);
                const f32x4 hv = xv[j] * rstd * gv * (1.f + scv) + shv;
                if (OUT8) *(unsigned*)((unsigned char*)hout + (size_t)m * D + c) = pk4_fp8(hv.x * F8_SA, hv.y * F8_SA, hv.z * F8_SA, hv.w * F8_SA);
                else { u32x2 o; o.x = pk2(hv.x, hv.y); o.y = pk2(hv.z, hv.w); *(u32x2*)(hout + (size_t)m * D + c) = o; } }
        }
    }
}

__device__ __forceinline__ void conv_item(const float* W, int K, int N, bf16_t* WT, int k0, int n0, int drow0, LAS unsigned* scr, int lane, bool rperm = false) {
    const int q = lane >> 4, n4 = lane & 15;
    f32x4 va[8], vb[8];
#pragma unroll
    for (int i = 0; i < 8; ++i) { const int rp = 4 * i + q;
        va[i] = *(const f32x4*)(W + (size_t)(k0 + 2 * rp) * N + n0 + 4 * n4); vb[i] = *(const f32x4*)(W + (size_t)(k0 + 2 * rp + 1) * N + n0 + 4 * n4); }
#pragma unroll
    for (int i = 0; i < 8; ++i) { const int rp = 4 * i + q; LAS unsigned* sp = scr + (4 * n4) * 33 + rp;
        sp[0] = pk2(va[i].x, vb[i].x); sp[33] = pk2(va[i].y, vb[i].y); sp[66] = pk2(va[i].z, vb[i].z); sp[99] = pk2(va[i].w, vb[i].w); }
    asm volatile("s_waitcnt lgkmcnt(0)" ::: "memory");
    const int c = lane & 7;
#pragma unroll
    for (int j = 0; j < 8; ++j) {
        const int n = (lane >> 3) + 8 * j; const LAS unsigned* sp = scr + n * 33 + 4 * c;
        u32x4 o; o.x = sp[0]; o.y = sp[1]; o.z = sp[2]; o.w = sp[3];
        const int nr = (rperm && n < 32) ? ((n < 16) ? 2 * n : 2 * (n - 16) + 1) : n;
        *(u32x4*)(WT + (size_t)(drow0 + nr) * K + k0 + 8 * c) = o;
    }
    asm volatile("s_waitcnt lgkmcnt(0)" ::: "memory");
}
__device__ __forceinline__ void conv_item8(const float* W, int K, int N, unsigned char* WT, int k0, int n0, int drow0, LAS unsigned* scr, int lane, float sc, bool rperm = false) {
    const int q = lane >> 4, n4 = lane & 15;
    f32x4 v[4][4];
#pragma unroll
    for (int i = 0; i < 4; ++i)
#pragma unroll
        for (int t = 0; t < 4; ++t) v[i][t] = __builtin_nontemporal_load((const f32x4*)(W + (size_t)(k0 + 4 * (4 * i + q) + t) * N + n0 + 4 * n4));
#pragma unroll
    for (int i = 0; i < 4; ++i) { const int rp = 4 * i + q; LAS unsigned* sp = scr + (4 * n4) * 17 + rp;
        sp[0]  = pk4_fp8(v[i][0].x * sc, v[i][1].x * sc, v[i][2].x * sc, v[i][3].x * sc);
        sp[17] = pk4_fp8(v[i][0].y * sc, v[i][1].y * sc, v[i][2].y * sc, v[i][3].y * sc);
        sp[34] = pk4_fp8(v[i][0].z * sc, v[i][1].z * sc, v[i][2].z * sc, v[i][3].z * sc);
        sp[51] = pk4_fp8(v[i][0].w * sc, v[i][1].w * sc, v[i][2].w * sc, v[i][3].w * sc); }
    asm volatile("s_waitcnt lgkmcnt(0)" ::: "memory");
    const int c = lane & 3;
#pragma unroll
    for (int j = 0; j < 4; ++j) {
        const int n = (lane >> 2) + 16 * j; const LAS unsigned* sp = scr + n * 17 + 4 * c;
        u32x4 o; o.x = sp[0]; o.y = sp[1]; o.z = sp[2]; o.w = sp[3];
        const int nr = (rperm && n < 32) ? ((n < 16) ? 2 * n : 2 * (n - 16) + 1) : n;
        *(u32x4*)(WT + (size_t)(drow0 + nr) * K + k0 + 16 * c) = o;
    }
    asm volatile("s_waitcnt lgkmcnt(0)" ::: "memory");
}
__device__ __forceinline__ void phase_convert(const Params& p, LAS unsigned char* lds) {
    const int tid_ = opaque_tid(), wave = tid_ >> 6, lane = tid_ & 63;
    LAS unsigned* scr = (LAS unsigned*)lds + wave * (64 * 33);
    constexpr int I_IN0 = 32 * 128, I_OUT = 32 * 32, I_G = 16 * 32 * 16, I_D = 16 * 16 * 32, I_IN1 = 32 * 96;
    constexpr int I_L0 = I_IN0 + I_OUT + 2 * I_G + I_D, I_L1 = I_IN1 + I_OUT + 2 * I_G + I_D;
    constexpr int HEAD = 4096; const int nfree = (int)gridDim.x - 192;
    const int NIT = I_L0 + I_L1, nhead = (nfree > 0) ? HEAD : 0;
    for (int pass = 0; pass < 2; ++pass)
    for (int it = (pass == 0) ? (((int)blockIdx.x - 192) * 8 + wave) : (nhead + (int)blockIdx.x * 8 + wave); (pass == 0) ? (nfree > 0 && (int)blockIdx.x >= 192 && it < nhead) : (it < NIT); it += ((pass == 0) ? nfree : (int)gridDim.x) * 8) {
        int r = it; const int l = (r >= I_L0) ? 1 : 0; if (l) r -= I_L0;
        const int i_in = l ? I_IN1 : I_IN0;

        if (r < i_in) { const int N = l ? ODW : EVW, nb = N / 64;
            conv_item8(p.in[l ? 16 : 5], D, N, l ? p.wp[IX_WIN1] : p.wp[IX_WIN0], (r / nb) * 64, (r % nb) * 64, (r % nb) * 64, scr, lane, F8_SW, l == 1 && (r % nb) < 64 && ((r % nb) & 1) == 0);
            continue; } r -= i_in;
        if (r < I_OUT) { if (OUT_F8) conv_item8(p.in[l ? 19 : 8], D, D, l ? p.wp[IX_WOUT1] : p.wp[IX_WOUT0], (r / 32) * 64, (r % 32) * 64, (r % 32) * 64, scr, lane, F8_SWD);
            else conv_item(p.in[l ? 19 : 8], D, D, (bf16_t*)(l ? p.wp[IX_WOUT1] : p.wp[IX_WOUT0]), (r / 32) * 64, (r % 32) * 64, (r % 32) * 64, scr, lane); continue; } r -= I_OUT;
        if (r < 2 * I_G) { const int up = r >= I_G; if (up) r -= I_G; const int e = r / 512, rr = r % 512, kb = rr / 16, nb = rr % 16, n0 = nb * 64;
            conv_item8(p.in[(l ? 21 : 10) + up] + (size_t)e * D * DFF, D, DFF, (l ? p.wp[IX_WGU1] : p.wp[IX_WGU0]) + (size_t)e * 2048 * D, kb * 64, n0, (n0 >> 7) * 256 + (n0 & 127) + up * 128, scr, lane, F8_SW);
            continue; } r -= 2 * I_G;
        { const int e = r / 512, rr = r % 512, kb = rr / 32, nb = rr % 32;
            conv_item8(p.in[l ? 23 : 12] + (size_t)e * DFF * D, DFF, D, (l ? p.wp[IX_WD1] : p.wp[IX_WD0]) + (size_t)e * D * DFF, kb * 64, nb * 64, nb * 64, scr, lane, F8_SWD); }
    }
}

namespace pg8 {
typedef short bf16x8 __attribute__((ext_vector_type(8)));
typedef int v4i_t __attribute__((ext_vector_type(4)));
typedef int v8i_t __attribute__((ext_vector_type(8)));
constexpr int BM = 256, BK = 64, HALF = 128, HTB = HALF * BK * 2, STAGE_BYTES = 8 * HTB, NXCD = 8, WGM = 8;
__host__ __device__ __forceinline__ int lds_byte(int r, int c) { const int st = (r >> 4) * 2 + (c >> 5), rr = r & 15, cc = c & 31, ob = rr * 64 + cc * 2; return st * 1024 + (ob ^ (((ob >> 9) & 1) << 5)); }
__host__ __device__ __forceinline__ void stage_rc(int b, int& R, int& C) { const int st = b / 1024, sb = b % 1024, swz = sb ^ (((sb >> 9) & 1) << 5); R = (st >> 1) * 16 + swz / 64; C = (st & 1) * 32 + (swz % 64) / 2; }
__host__ __device__ __forceinline__ int perm32(int rho) { const int n = rho >> 4, i = rho & 15; return 8 * (i >> 2) + 4 * n + (i & 3); }
struct Unit { int pm, pn, e; };
struct StaticOrder {
    static constexpr bool GATHER = false, SIGF = false, WAITF = false;
    int nM, nN, nwg, G, c;
    __device__ void init(int M_, int N_, int G_, int c_) { nM = M_ / BM; nN = N_ / BM; nwg = nM * nN; G = G_; c = c_; }
    __device__ __forceinline__ bool next(int i, Unit& u) const {
        const long L = (long)i * G + c; if (L >= nwg) return false;
        int wgid = (int)L; { const int q = nwg / NXCD, r = nwg % NXCD, xcd = wgid % NXCD, off = wgid / NXCD; wgid = (xcd < r ? xcd * (q + 1) : r * (q + 1) + (xcd - r) * q) + off; }
        const int nig = WGM * nN, gid = wgid / nig, fm = gid * WGM, gsz = (nM - fm) < WGM ? (nM - fm) : WGM;
        u.pm = fm + ((wgid % nig) % gsz); u.pn = (wgid % nig) / gsz; u.e = 0; return true;
    }
    __device__ __forceinline__ size_t brow(const Unit& u) const { return (size_t)u.pn * BM; }
    __device__ __forceinline__ unsigned arow(const Unit&, int) const { return 0u; }
};
template <bool GATHER_, int TG = 0, bool SIGF_ = false, bool WAITF_ = false>
struct MoeOrder {
    static constexpr bool GATHER = GATHER_, SIGF = SIGF_, WAITF = WAITF_;
    const LAS int* base; const int* list; const unsigned* cnt; int G, c, nT; unsigned* flg;
    __device__ __forceinline__ bool next(int i, Unit& u) const {
        int pm, pn;
        if ((G & 63) == 0) { const int xcd = (c + (WAITF ? 3 : 0)) & 7, j = c >> 3, rt = G >> 6;
            const int nfull = nT / (8 * rt);
            if (i < nfull) pm = (i * 8 + xcd) * rt + (j >> 3);
            else { const int s = (i - nfull) * rt + (((j >> 3) + TG) % rt); pm = nfull * 8 * rt + s * 8 + xcd; }
            pn = j & 7; }
        else { const int L = i * G + c; pm = L >> 3; pn = L & 7; }
        if (pm >= nT) return false;
        u.pm = pm; u.pn = pn; int e = 0;
#pragma unroll
        for (int q = 1; q < NE; ++q) e += (pm * BM >= base[q]) ? 1 : 0;
        u.e = e; return true;
    }
    __device__ __forceinline__ void wait(const Unit& u) const {
        while (__hip_atomic_load(flg + u.pm, __ATOMIC_RELAXED, __HIP_MEMORY_SCOPE_AGENT) < 8u) __builtin_amdgcn_s_sleep(2);
        asm volatile("" ::: "memory");
    }
    __device__ __forceinline__ size_t brow(const Unit& u) const { return (size_t)u.e * 2048 + (size_t)u.pn * BM; }
    __device__ __forceinline__ unsigned arow(const Unit& u, int r) const { const int pos = u.pm * BM + r - base[u.e]; const unsigned t = (unsigned)list[u.e * M + pos]; return (pos < (int)cnt[u.e]) ? t : 0u; }
};

struct EpiBf16 { static constexpr bool PERM = true; bf16_t* O; int ldc; float sc = 1.f;
    __device__ __forceinline__ void operator()(const f32x4 (&acc)[2][2][4][2], const Unit& u, int wr, int wc, int fr, int fq) const {
        const int row0 = u.pm * BM + wr * 64 + fr, col0 = u.pn * BM + wc * 32 + 8 * fq;
#pragma unroll
        for (int ai = 0; ai < 2; ++ai)
#pragma unroll
            for (int m = 0; m < 4; ++m) { bf16_t* rowp = O + (size_t)(row0 + ai * HALF + m * 16) * ldc + col0;
#pragma unroll
                for (int bj = 0; bj < 2; ++bj) { const f32x4 v0 = acc[ai][bj][m][0] * sc, v1 = acc[ai][bj][m][1] * sc;
                    u32x4 w; w.x = pk2(v0[0], v0[1]); w.y = pk2(v0[2], v0[3]); w.z = pk2(v1[0], v1[1]); w.w = pk2(v1[2], v1[3]);
                    *(u32x4*)(rowp + bj * HALF) = w; } }
    }
};
struct EpiProj0 { static constexpr bool PERM = true; bf16_t* O; int ldc; float sc;
    __device__ __forceinline__ void operator()(const f32x4 (&acc)[2][2][4][2], const Unit& u, int wr, int wc, int fr, int fq) const {
        const int row0 = u.pm * BM + wr * 64 + fr, col0 = u.pn * BM + wc * 32 + 8 * fq; const int mode = (u.pn < 4 || (u.pn >= 16 && u.pn < 20)) ? 1 : ((u.pn >= 8 && u.pn < 16) ? 2 : 0);
#pragma unroll
        for (int ai = 0; ai < 2; ++ai)
#pragma unroll
            for (int m = 0; m < 4; ++m) { bf16_t* rowp = O + (size_t)(row0 + ai * HALF + m * 16) * ldc + col0;
#pragma unroll
                for (int bj = 0; bj < 2; ++bj) { f32x4 v0 = acc[ai][bj][m][0] * sc, v1 = acc[ai][bj][m][1] * sc;
                    if (mode == 1) {
#pragma unroll
                        for (int e = 0; e < 4; ++e) { v0[e] = silu(v0[e]); v1[e] = silu(v1[e]); } }
                    else if (mode == 2) {
#pragma unroll
                        for (int e = 0; e < 4; ++e) { v0[e] = frcp(1.f + __expf(v0[e])); v1[e] = frcp(1.f + __expf(v1[e])); } }
                    u32x4 w; w.x = pk2(v0[0], v0[1]); w.y = pk2(v0[2], v0[3]); w.z = pk2(v1[0], v1[1]); w.w = pk2(v1[2], v1[3]);
                    *(u32x4*)(rowp + bj * HALF) = w; } }
    }
};
struct EpiBf16Rope { static constexpr bool PERM = true; bf16_t* O; int ldc; const float* rc; const float* rs; float sc;
    __device__ __forceinline__ void operator()(const f32x4 (&acc)[2][2][4][2], const Unit& u, int wr, int wc, int fr, int fq) const {
        const int row0 = u.pm * BM + wr * 64 + fr, col0 = u.pn * BM + wc * 32 + 8 * fq; const bool rot = (u.pn < 16) && (wc == 0);
#pragma unroll
        for (int ai = 0; ai < 2; ++ai)
#pragma unroll
            for (int m = 0; m < 4; ++m) { const int row = row0 + ai * HALF + m * 16; bf16_t* rowp = O + (size_t)row * ldc + col0;
                f32x4 cv = {1.f, 1.f, 1.f, 1.f}, sv = {0.f, 0.f, 0.f, 0.f};
                if (rot) { const int pos = row & (T - 1); cv = *(const f32x4*)(rc + pos * 16 + 4 * fq); sv = *(const f32x4*)(rs + pos * 16 + 4 * fq); }
#pragma unroll
                for (int bj = 0; bj < 2; ++bj) { f32x4 v0 = acc[ai][bj][m][0] * sc, v1 = acc[ai][bj][m][1] * sc;
                    if (rot) { const f32x4 a = v0, b = v1;
                        v0[0] = a[0] * cv[0] - a[1] * sv[0]; v0[1] = a[0] * sv[0] + a[1] * cv[0]; v0[2] = a[2] * cv[1] - a[3] * sv[1]; v0[3] = a[2] * sv[1] + a[3] * cv[1];
                        v1[0] = b[0] * cv[2] - b[1] * sv[2]; v1[1] = b[0] * sv[2] + b[1] * cv[2]; v1[2] = b[2] * cv[3] - b[3] * sv[3]; v1[3] = b[2] * sv[3] + b[3] * cv[3]; }
                    u32x4 w; w.x = pk2(v0[0], v0[1]); w.y = pk2(v0[2], v0[3]); w.z = pk2(v1[0], v1[1]); w.w = pk2(v1[2], v1[3]);
                    *(u32x4*)(rowp + bj * HALF) = w; } }
    }
};
struct EpiResF32 { static constexpr bool PERM = false; const float* xin; float* xout; const float* gt; float sc = 1.f;
    __device__ __forceinline__ void operator()(const f32x4 (&acc)[2][2][4][2], const Unit& u, int wr, int wc, int fr, int fq) const {
        const int row0 = u.pm * BM + wr * 64 + fr, col0 = u.pn * BM + wc * 32 + 4 * fq; const int b = (u.pm * BM) / T;
        f32x4 gv[2][2];
#pragma unroll
        for (int bj = 0; bj < 2; ++bj)
#pragma unroll
            for (int n = 0; n < 2; ++n) gv[bj][n] = *(const f32x4*)(gt + (size_t)b * 12288 + col0 + bj * HALF + n * 16);
        f32x4 xi[2][2][2];
#pragma unroll
        for (int bj = 0; bj < 2; ++bj)
#pragma unroll
            for (int n = 0; n < 2; ++n) xi[0][bj][n] = *(const f32x4*)(xin + (size_t)row0 * D + col0 + bj * HALF + n * 16);
#pragma unroll
        for (int g = 0; g < 8; ++g) { const int ai = g >> 2, m = g & 3; const size_t off = (size_t)(row0 + ai * HALF + m * 16) * D + col0;
            if (g + 1 < 8) { const int ai2 = (g + 1) >> 2, m2 = (g + 1) & 3; const size_t off2 = (size_t)(row0 + ai2 * HALF + m2 * 16) * D + col0;
#pragma unroll
                for (int bj = 0; bj < 2; ++bj)
#pragma unroll
                    for (int n = 0; n < 2; ++n) xi[(g + 1) & 1][bj][n] = *(const f32x4*)(xin + off2 + bj * HALF + n * 16); }
            __builtin_amdgcn_sched_barrier(0);
#pragma unroll
            for (int bj = 0; bj < 2; ++bj)
#pragma unroll
                for (int n = 0; n < 2; ++n) *(f32x4*)(xout + off + bj * HALF + n * 16) = xi[g & 1][bj][n] + gv[bj][n] * (acc[ai][bj][m][n] * sc);
            __builtin_amdgcn_sched_barrier(0); }
    }
};
struct EpiGluBf16 { static constexpr bool PERM = true; bf16_t* H; const float* lw; const unsigned* cnt; const LAS int* base;
    __device__ __forceinline__ void operator()(const f32x4 (&acc)[2][2][4][2], const Unit& u, int wr, int wc, int fr, int fq) const {
        const int row0 = u.pm * BM + wr * 64 + fr, col0 = u.pn * HALF + wc * 32 + 8 * fq; const int eb = base[u.e], ec = (int)cnt[u.e];
#pragma unroll
        for (int ai = 0; ai < 2; ++ai)
#pragma unroll
            for (int m = 0; m < 4; ++m) { const int row = row0 + ai * HALF + m * 16, pos = row - eb; const float w = (pos < ec) ? lw[u.e * M + pos] : 0.f;
                const f32x4 g0 = acc[ai][0][m][0], g1 = acc[ai][0][m][1], u0 = acc[ai][1][m][0], u1 = acc[ai][1][m][1];
                u32x4 o; o.x = pk2(silu(g0[0]) * u0[0] * w, silu(g0[1]) * u0[1] * w); o.y = pk2(silu(g0[2]) * u0[2] * w, silu(g0[3]) * u0[3] * w);
                o.z = pk2(silu(g1[0]) * u1[0] * w, silu(g1[1]) * u1[1] * w); o.w = pk2(silu(g1[2]) * u1[2] * w, silu(g1[3]) * u1[3] * w);
                *(u32x4*)(H + (size_t)row * DFF + col0) = o; }
    }
};

struct EpiGluF8 { static constexpr bool PERM = true; unsigned char* H; const float* lw; const unsigned* cnt; const LAS int* base;
    __device__ __forceinline__ void operator()(const f32x4 (&acc)[2][2][4][2], const Unit& u, int wr, int wc, int fr, int fq) const {
        const int row0 = u.pm * BM + wr * 64 + fr, col0 = u.pn * HALF + wc * 32 + 8 * fq; const int eb = base[u.e], ec = (int)cnt[u.e];
        constexpr float DQ = 1.f / (F8_SA * F8_SW);
        float wrow[8];
#pragma unroll
        for (int g = 0; g < 8; ++g) { const int pos = row0 + (g >> 2) * HALF + (g & 3) * 16 - eb; wrow[g] = lw[u.e * M + pos]; wrow[g] = (pos < ec) ? wrow[g] * (F8_SH * DQ) : 0.f; }
#pragma unroll
        for (int ai = 0; ai < 2; ++ai)
#pragma unroll
            for (int m = 0; m < 4; ++m) { const int row = row0 + ai * HALF + m * 16; const float w = wrow[ai * 4 + m];
                const f32x4 g0 = acc[ai][0][m][0] * DQ, g1 = acc[ai][0][m][1] * DQ, u0 = acc[ai][1][m][0], u1 = acc[ai][1][m][1];
                u32x2 o; o.x = pk4_fp8(silu(g0[0]) * u0[0] * w, silu(g0[1]) * u0[1] * w, silu(g0[2]) * u0[2] * w, silu(g0[3]) * u0[3] * w);
                o.y = pk4_fp8(silu(g1[0]) * u1[0] * w, silu(g1[1]) * u1[1] * w, silu(g1[2]) * u1[2] * w, silu(g1[3]) * u1[3] * w);
                __hip_atomic_store((unsigned long long*)(H + (size_t)row * DFF + col0), ((unsigned long long)o.y << 32) | (unsigned long long)o.x, __ATOMIC_RELAXED, __HIP_MEMORY_SCOPE_AGENT); }
    }
};
template <class Epi, class Sched, bool ALIGN_EPI, bool SP2, bool F8 = false>
__device__ __forceinline__ void gemm_phase(LAS unsigned char* lds, const void* Ap, const void* Btp, const int K, const Sched& S, const Epi& E) {
    constexpr bool GATHER = Sched::GATHER; constexpr int ESZ = F8 ? 1 : 2;
    const int tid = opaque_tid(), wid = __builtin_amdgcn_readfirstlane(tid >> 6), lane = tid & 63, wr = wid >> 2, wc = wid & 3, fr = lane & 15, fq = lane >> 4;
    const int nt = K * ESZ / (BK * 2);
    unsigned voffA[2], voffB[2]; int sR[2], sC[2];
#pragma unroll
    for (int i = 0; i < 2; ++i) { int R, C; stage_rc(tid * 16 + i * 8192, R, C); const int Rb = Epi::PERM ? ((R & ~31) + perm32(R & 31)) : R; sR[i] = R; sC[i] = C;
        voffA[i] = (unsigned)(R * K * ESZ + C * 2); voffB[i] = (unsigned)(Rb * K * ESZ + C * 2); }
    const size_t kstep = (size_t)(BK * 2);
    const size_t hstep = (size_t)HALF * K * ESZ;
    const size_t tstep = 2 * hstep;
    const unsigned ldsw = (unsigned)wid * 1024u;
    const int aoff = lds_byte(wr * 64 + fr, fq * 8), boff = lds_byte(wc * 32 + fr, fq * 8);
#define PG8_SA(b, h) (((b) * 2 + (h)) * HTB)
#define PG8_SB(b, h) ((4 + (b) * 2 + (h)) * HTB)
#define PG8_ST2X(bufoff, gbase, o0, o1, AUX) do { unsigned _a = (o0), _b = (o1); asm volatile("" : "+v"(_a), "+v"(_b));   \
        __builtin_amdgcn_global_load_lds((const unsigned*)((const char*)(gbase) + _a), (LAS unsigned*)(lds + (bufoff) + ldsw), 16, 0, AUX); \
        __builtin_amdgcn_global_load_lds((const unsigned*)((const char*)(gbase) + _b), (LAS unsigned*)(lds + (bufoff) + ldsw + 8192), 16, 0, AUX); } while (0)
#define PG8_ST2(bufoff, gbase, o0, o1) PG8_ST2X(bufoff, gbase, o0, o1, 0)
#define PG8_STAGEB(bufoff, gbase) PG8_ST2(bufoff, gbase, voffB[0], voffB[1])
#define PG8_STAGEA(bufoff, P, KB, OV, h) do { if constexpr (GATHER) PG8_ST2(bufoff, (const char*)Ap + (KB), OV[h][0], OV[h][1]); else if constexpr (Sched::WAITF) PG8_ST2X(bufoff, (P) + (h) * hstep, voffA[0], voffA[1], 16);   else PG8_ST2(bufoff, (P) + (h) * hstep, voffA[0], voffA[1]); } while (0)
#define PG8_LDA(dst, b, h) do { _Pragma("unroll") for (int m = 0; m < 4; ++m) { if constexpr (F8) dst##8[m] = __builtin_shufflevector(*(const LAS v4i_t*)(lds + PG8_SA(b, h) + aoff + m * 2048), *(const LAS v4i_t*)(lds + PG8_SA(b, h) + aoff + m * 2048 + 1024), 0, 1, 2, 3, 4, 5, 6, 7); \
        else { _Pragma("unroll") for (int k = 0; k < 2; ++k) dst[m][k] = *(const LAS bf16x8*)(lds + PG8_SA(b, h) + aoff + m * 2048 + k * 1024); } } } while (0)
#define PG8_LDB(dst, b, h) do { _Pragma("unroll") for (int n = 0; n < 2; ++n) { if constexpr (F8) dst##8[n] = __builtin_shufflevector(*(const LAS v4i_t*)(lds + PG8_SB(b, h) + boff + n * 2048), *(const LAS v4i_t*)(lds + PG8_SB(b, h) + boff + n * 2048 + 1024), 0, 1, 2, 3, 4, 5, 6, 7); \
        else { _Pragma("unroll") for (int k = 0; k < 2; ++k) dst[n][k] = *(const LAS bf16x8*)(lds + PG8_SB(b, h) + boff + n * 2048 + k * 1024); } } } while (0)
#define PG8_CAT(x) __builtin_shufflevector(__builtin_bit_cast(v4i_t, (x)[0]), __builtin_bit_cast(v4i_t, (x)[1]), 0, 1, 2, 3, 4, 5, 6, 7)
#define PG8_MMA(ai, bj, At, Bt) do { __builtin_amdgcn_s_setprio(1); _Pragma("unroll") for (int m = 0; m < 4; ++m) _Pragma("unroll") for (int n = 0; n < 2; ++n) { \
        if constexpr (F8) asm volatile("v_mfma_scale_f32_16x16x128_f8f6f4 %0, %1, %2, %0, %3, %3 op_sel_hi:[0,0,0]" : "+v"(acc[ai][bj][m][n]) : "v"(Bt##8[n]), "v"(At##8[m]), "v"(sc127));   \
        else { _Pragma("unroll") for (int k = 0; k < 2; ++k) acc[ai][bj][m][n] = __builtin_amdgcn_mfma_f32_16x16x32_bf16(Bt[n][k], At[m][k], acc[ai][bj][m][n], 0, 0, 0); } } __builtin_amdgcn_s_setprio(0); } while (0)
#define PG8_WAIT_V(n) asm volatile("s_waitcnt vmcnt(" #n ")" ::: "memory")
#define PG8_WAIT_L(n) asm volatile("s_waitcnt lgkmcnt(" #n ")" ::: "memory")
#define PG8_BAR __builtin_amdgcn_s_barrier()
#define PG8_SCHED __builtin_amdgcn_sched_barrier(0)
    Unit cur, nxt; int ui = 0;
    if (!S.next(0, cur)) return;
    if constexpr (Sched::WAITF) S.wait(cur);
    f32x4 acc[2][2][4][2];
#pragma unroll
    for (int a = 0; a < 2; ++a)
#pragma unroll
        for (int b = 0; b < 2; ++b)
#pragma unroll
            for (int m = 0; m < 4; ++m)
#pragma unroll
                for (int n = 0; n < 2; ++n) acc[a][b][m][n] = (f32x4){0.f, 0.f, 0.f, 0.f};
    const int sc127 = 0x7F7F7F7F;
    bf16x8 At[4][2], B0[2][2], B1[2][2]; v8i_t At8[4], B08[2], B18[2];
    unsigned vc[2][2] = {{0u, 0u}, {0u, 0u}}, vn[2][2] = {{0u, 0u}, {0u, 0u}};
    if constexpr (GATHER) {
#pragma unroll
        for (int h = 0; h < 2; ++h)
#pragma unroll
            for (int i = 0; i < 2; ++i) vc[h][i] = S.arow(cur, h * HALF + sR[i]) * (unsigned)(K * ESZ) + (unsigned)sC[i] * 2u;
    }
    const char* cA = (const char*)Ap + (GATHER ? (size_t)0 : (size_t)cur.pm * tstep); const char* cB = (const char*)Btp + S.brow(cur) * (size_t)K * ESZ;
    if constexpr (SP2) {
        PG8_STAGEB(PG8_SB(0, 0), cB); PG8_STAGEB(PG8_SB(0, 1), cB + hstep); PG8_STAGEA(PG8_SA(0, 0), cA, 0, vc, 0); PG8_STAGEA(PG8_SA(0, 1), cA, 0, vc, 1);
        if (wr == 1) PG8_BAR;
        PG8_WAIT_V(2); PG8_BAR;
        PG8_STAGEB(PG8_SB(1, 0), cB + kstep); PG8_STAGEA(PG8_SA(1, 0), cA + kstep, kstep, vc, 0); PG8_STAGEB(PG8_SB(1, 1), cB + hstep + kstep);
        PG8_WAIT_V(6); PG8_BAR;
    } else {
        PG8_STAGEB(PG8_SB(0, 0), cB); PG8_STAGEA(PG8_SA(0, 0), cA, 0, vc, 0); PG8_STAGEB(PG8_SB(0, 1), cB + hstep); PG8_STAGEA(PG8_SA(0, 1), cA, 0, vc, 1);
        if (wr == 1) PG8_BAR;
        PG8_WAIT_V(4); PG8_BAR;
        PG8_STAGEB(PG8_SB(1, 0), cB + kstep); PG8_STAGEA(PG8_SA(1, 0), cA + kstep, kstep, vc, 0); PG8_STAGEB(PG8_SB(1, 1), cB + hstep + kstep);
        PG8_WAIT_V(6); PG8_BAR;
    }
    for (;;) {
        const bool has_next = S.next(ui + 1, nxt);
        if constexpr (Sched::WAITF) { if (has_next) S.wait(nxt); }
        const char* nA = (has_next && !GATHER) ? (const char*)Ap + (size_t)nxt.pm * tstep : cA; const char* nB = has_next ? (const char*)Btp + S.brow(nxt) * (size_t)K * ESZ : cB;
        if constexpr (GATHER) {
#pragma unroll
            for (int h = 0; h < 2; ++h)
#pragma unroll
                for (int i = 0; i < 2; ++i) vn[h][i] = has_next ? S.arow(nxt, h * HALF + sR[i]) * (unsigned)(K * ESZ) + (unsigned)sC[i] * 2u : vc[h][i];
        }
#pragma unroll 1
        for (int t = 0; t < nt; t += 2) {
            const bool last = (t == nt - 2);
            const char* a1 = cA + (size_t)(t + 1) * kstep; const size_t kb1 = (size_t)(t + 1) * kstep;
            const char* a2 = last ? nA : cA + (size_t)(t + 2) * kstep; const char* b2 = last ? nB : cB + (size_t)(t + 2) * kstep;
            const char* a3 = a2 + kstep; const char* b3 = b2 + kstep;
            const size_t kb2 = last ? (size_t)0 : (size_t)(t + 2) * kstep, kb3 = kb2 + kstep;
            unsigned v2[2][2];
#pragma unroll
            for (int h = 0; h < 2; ++h)
#pragma unroll
                for (int i = 0; i < 2; ++i) v2[h][i] = last ? vn[h][i] : vc[h][i];
            if constexpr (SP2) {
            PG8_LDB(B0, 0, 0); PG8_LDB(B1, 0, 1); PG8_SCHED; PG8_LDA(At, 0, 0); PG8_STAGEA(PG8_SA(1, 1), a1, kb1, vc, 1);
            PG8_WAIT_V(8); PG8_WAIT_L(0); PG8_BAR; PG8_MMA(0, 0, At, B0); PG8_MMA(0, 1, At, B1); PG8_BAR; PG8_SCHED;
            PG8_LDA(At, 0, 1); PG8_STAGEB(PG8_SB(0, 0), b2); PG8_STAGEB(PG8_SB(0, 1), b2 + hstep); PG8_STAGEA(PG8_SA(0, 0), a2, kb2, v2, 0);
            PG8_WAIT_V(8); PG8_WAIT_L(0); PG8_BAR; PG8_MMA(1, 0, At, B0); PG8_MMA(1, 1, At, B1); PG8_BAR; PG8_SCHED;
            PG8_LDB(B0, 1, 0); PG8_LDB(B1, 1, 1); PG8_SCHED; PG8_LDA(At, 1, 0); PG8_STAGEA(PG8_SA(0, 1), a2, kb2, v2, 1);
            PG8_WAIT_V(8); PG8_WAIT_L(0); PG8_BAR; PG8_MMA(0, 0, At, B0); PG8_MMA(0, 1, At, B1); PG8_BAR; PG8_SCHED;
            PG8_LDA(At, 1, 1); PG8_STAGEB(PG8_SB(1, 0), b3); PG8_STAGEB(PG8_SB(1, 1), b3 + hstep); PG8_STAGEA(PG8_SA(1, 0), a3, kb3, v2, 0);
            PG8_WAIT_V(8); PG8_WAIT_L(0); PG8_BAR; PG8_MMA(1, 0, At, B0); PG8_MMA(1, 1, At, B1); PG8_BAR; PG8_SCHED;
            } else {
            PG8_LDB(B0, 0, 0); PG8_SCHED; PG8_LDA(At, 0, 0); PG8_STAGEA(PG8_SA(1, 1), a1, kb1, vc, 1);
            PG8_WAIT_L(8); PG8_BAR; PG8_WAIT_L(0); PG8_MMA(0, 0, At, B0); PG8_BAR; PG8_SCHED;
            PG8_LDB(B1, 0, 1); PG8_STAGEB(PG8_SB(0, 0), b2);
            PG8_BAR; PG8_WAIT_L(0); PG8_MMA(0, 1, At, B1); PG8_BAR;
            PG8_LDA(At, 0, 1); PG8_STAGEA(PG8_SA(0, 0), a2, kb2, v2, 0);
            PG8_BAR; PG8_WAIT_L(0); PG8_MMA(1, 0, At, B0); PG8_BAR; PG8_SCHED;
            PG8_STAGEB(PG8_SB(0, 1), b2 + hstep);
            PG8_WAIT_V(6); PG8_BAR; PG8_MMA(1, 1, At, B1); PG8_BAR;
            PG8_LDB(B0, 1, 0); PG8_SCHED; PG8_LDA(At, 1, 0); PG8_STAGEA(PG8_SA(0, 1), a2, kb2, v2, 1);
            PG8_WAIT_L(8); PG8_BAR; PG8_WAIT_L(0); PG8_MMA(0, 0, At, B0); PG8_BAR; PG8_SCHED;
            PG8_LDB(B1, 1, 1); PG8_STAGEB(PG8_SB(1, 0), b3);
            PG8_BAR; PG8_WAIT_L(0); PG8_MMA(0, 1, At, B1); PG8_BAR;
            PG8_LDA(At, 1, 1); PG8_STAGEA(PG8_SA(1, 0), a3, kb3, v2, 0);
            PG8_BAR; PG8_WAIT_L(0); PG8_MMA(1, 0, At, B0); PG8_BAR; PG8_SCHED;
            PG8_STAGEB(PG8_SB(1, 1), b3 + hstep);
            PG8_WAIT_V(6); PG8_BAR; PG8_MMA(1, 1, At, B1); PG8_BAR;
            }
        }
        if constexpr (ALIGN_EPI) { if (wr == 0) PG8_BAR; }
        if constexpr (F8) { asm volatile("s_nop 15\n\ts_nop 7" ::: "memory");
#pragma unroll
            for (int a = 0; a < 2; ++a)
#pragma unroll
                for (int b = 0; b < 2; ++b)
#pragma unroll
                    for (int m = 0; m < 4; ++m)
#pragma unroll
                        for (int n = 0; n < 2; ++n) asm volatile("" : "+v"(acc[a][b][m][n])); }
        { const int tz = opaque_tid(), wz = __builtin_amdgcn_readfirstlane(tz >> 6), lz = tz & 63; E(acc, cur, wz >> 2, wz & 3, lz & 15, lz >> 4);
          if constexpr (Sched::SIGF) { asm volatile("s_waitcnt vmcnt(0)" ::: "memory");
              if (lz == 0) { const unsigned old = __hip_atomic_fetch_add((LAS unsigned*)(lds + LDS_UCNT_OFF), 1u, __ATOMIC_ACQ_REL, __HIP_MEMORY_SCOPE_WORKGROUP);
                  if ((old & 7u) == 7u) {   __hip_atomic_fetch_add(S.flg + cur.pm, 1u, __ATOMIC_RELAXED, __HIP_MEMORY_SCOPE_AGENT); } } } }
        if (!has_next) break;
#pragma unroll
        for (int a = 0; a < 2; ++a)
#pragma unroll
            for (int b = 0; b < 2; ++b)
#pragma unroll
                for (int m = 0; m < 4; ++m)
#pragma unroll
                    for (int n = 0; n < 2; ++n) acc[a][b][m][n] = (f32x4){0.f, 0.f, 0.f, 0.f};
        cur = nxt; cA = nA; cB = nB; ++ui;
        if constexpr (GATHER) {
#pragma unroll
            for (int h = 0; h < 2; ++h)
#pragma unroll
                for (int i = 0; i < 2; ++i) vc[h][i] = vn[h][i];
        }
        if constexpr (ALIGN_EPI) { if (wr == 1) PG8_BAR; }
    }
    PG8_WAIT_V(0);
    if constexpr (!ALIGN_EPI) { if (wr == 0) PG8_BAR; }
    PG8_BAR;
#undef PG8_SA
#undef PG8_SB
#undef PG8_ST2
#undef PG8_ST2X
#undef PG8_STAGEA
#undef PG8_STAGEB
#undef PG8_LDA
#undef PG8_LDB
#undef PG8_MMA
#undef PG8_CAT
#undef PG8_WAIT_V
#undef PG8_WAIT_L
#undef PG8_BAR
#undef PG8_SCHED
}
}

namespace att {
constexpr int AD = 128, NW = 8, QBLK = 32, KVBLK = 64;
constexpr float SCALE = 0.088388347648318440f;
constexpr float THR = 8.f;
constexpr int SDEPTH = 2;
constexpr int SHM_V = KVBLK * AD * 2, SHM_K = KVBLK * AD * 2, SHM_ATTN = 2 * SHM_V + 2 * SHM_K + NW * 64 * 4;
using bf16x8 = __attribute__((ext_vector_type(8))) short;
using s16x4  = __attribute__((ext_vector_type(4))) short;
using f32x16 = __attribute__((ext_vector_type(16))) float;
#define KSWZ(row, colB) ((row) * 256 + ((colB) ^ (((row) & 7) << 4)))
#define SBAR() __builtin_amdgcn_sched_barrier(0)
__device__ __forceinline__ int crow(int r, int hi) { return (r & 3) + 8 * (r >> 2) + 4 * hi; }
__device__ __forceinline__ unsigned cvtpk(float lo, float hi) { unsigned r; asm volatile("v_cvt_pk_bf16_f32 %0, %1, %2" : "=v"(r) : "v"(lo), "v"(hi)); return r; }
__device__ __forceinline__ void partialSM(f32x16& p0, f32x16& p1, float& m_reg, float& mn, float& alpha) {
  constexpr float C = SCALE * 1.4426950408889634f;
  float pmax = p0[0]; for (int r = 1; r < 16; ++r) pmax = fmaxf(pmax, p0[r]); for (int r = 0; r < 16; ++r) pmax = fmaxf(pmax, p1[r]);
  { auto rr = __builtin_amdgcn_permlane32_swap(__float_as_uint(pmax), __float_as_uint(pmax), false, false);
    pmax = fmaxf(__uint_as_float(rr[0]), __uint_as_float(rr[1])); }
  if (__builtin_expect(__all(pmax - m_reg <= THR / SCALE), 1)) { mn = m_reg; alpha = 1.f; }
  else { mn = fmaxf(m_reg, pmax); alpha = __builtin_amdgcn_exp2f((m_reg - mn) * C); m_reg = mn; }
  float mnC = -mn * C;
  for (int r = 0; r < 16; ++r) p0[r] = fmaf(p0[r], C, mnC); for (int r = 0; r < 16; ++r) p1[r] = fmaf(p1[r], C, mnC);
  for (int r = 0; r < 16; ++r) p0[r] = __builtin_amdgcn_exp2f(p0[r]);
}
__device__ __forceinline__ void finishSM(f32x16& p0, f32x16& p1, float alpha, float& l_reg, bf16x8& pa0, bf16x8& pa1, bf16x8& pa2, bf16x8& pa3) {
  for (int r = 0; r < 16; ++r) p1[r] = __builtin_amdgcn_exp2f(p1[r]);
  float ps = 0; for (int r = 0; r < 16; ++r) ps += p0[r]; for (int r = 0; r < 16; ++r) ps += p1[r];
  { auto rr = __builtin_amdgcn_permlane32_swap(__float_as_uint(ps), __float_as_uint(ps), false, false);
    ps = __uint_as_float(rr[0]) + __uint_as_float(rr[1]); }
  l_reg = l_reg * alpha + ps;
#define PK4(P, BASE, OUT) do { unsigned a0 = cvtpk(P[BASE + 0], P[BASE + 1]), a1 = cvtpk(P[BASE + 2], P[BASE + 3]);   \
    unsigned b0 = cvtpk(P[BASE + 4], P[BASE + 5]), b1 = cvtpk(P[BASE + 6], P[BASE + 7]);                              \
    auto r0 = __builtin_amdgcn_permlane32_swap(a0, b0, false, false); auto r1 = __builtin_amdgcn_permlane32_swap(a1, b1, false, false); \
    u32x4 w = {r0[0], r1[0], r0[1], r1[1]}; OUT = __builtin_bit_cast(bf16x8, w); } while (0)
  PK4(p0, 0, pa0); PK4(p0, 8, pa1); PK4(p1, 0, pa2); PK4(p1, 8, pa3);
#undef PK4
}
__device__ __forceinline__ void qkt(f32x16& p0, f32x16& p1, const LAS char* Ks, const bf16x8* qr, int r32, int hi) {
  p0 = f32x16{}; p1 = f32x16{};
#pragma unroll
  for (int d0 = 0; d0 < 8; ++d0) { int cb = (d0 * 16 + hi * 8) * 2;
    bf16x8 b0 = *(const LAS bf16x8*)(Ks + KSWZ(r32, cb));
    bf16x8 b1 = *(const LAS bf16x8*)(Ks + KSWZ(32 + r32, cb));
    p0 = __builtin_amdgcn_mfma_f32_32x32x16_bf16(b0, qr[d0], p0, 0, 0, 0);
    p1 = __builtin_amdgcn_mfma_f32_32x32x16_bf16(b1, qr[d0], p1, 0, 0, 0); }
}
__device__ __forceinline__ int v_st(int k, int c) { const int kk = (k & ~0xC) | ((k & 4) << 1) | ((k & 8) >> 1); return ((kk >> 3) * 4 + (c >> 5)) * 512 + ((kk & 7) * 32 + (c & 31)) * 2; }
__device__ __forceinline__ int v_rd_base(int lane) { return ((lane & 3) << 3) | (((lane >> 2) & 3) << 6) | (((lane >> 4) & 1) << 5) | (((lane >> 5) & 1) << 8); }
constexpr int v_rd_off(int d0, int ks, int half) { return d0 * 512 + ks * 4096 + half * 2048; }
template <int OFF> __device__ __forceinline__ s16x4 tr_read(int vb) {
  s16x4 r; asm volatile("ds_read_b64_tr_b16 %0, %1 offset:%2" : "=&v"(r) : "v"(vb), "i"(OFF) : "memory"); return r;
}
template <int D0> __device__ __forceinline__ void pv_one(f32x16& od, int vb, bf16x8 pa0, bf16x8 pa1, bf16x8 pa2, bf16x8 pa3) {
  const s16x4 l0 = tr_read<v_rd_off(D0, 0, 0)>(vb), h0 = tr_read<v_rd_off(D0, 0, 1)>(vb), l1 = tr_read<v_rd_off(D0, 1, 0)>(vb), h1 = tr_read<v_rd_off(D0, 1, 1)>(vb);
  const s16x4 l2 = tr_read<v_rd_off(D0, 2, 0)>(vb), h2 = tr_read<v_rd_off(D0, 2, 1)>(vb), l3 = tr_read<v_rd_off(D0, 3, 0)>(vb), h3 = tr_read<v_rd_off(D0, 3, 1)>(vb);
  asm volatile("s_waitcnt lgkmcnt(0)" ::: "memory"); SBAR();
#define PK(L, H) (bf16x8){L[0], L[1], L[2], L[3], H[0], H[1], H[2], H[3]}
  od = __builtin_amdgcn_mfma_f32_32x32x16_bf16(pa0, PK(l0, h0), od, 0, 0, 0);
  od = __builtin_amdgcn_mfma_f32_32x32x16_bf16(pa1, PK(l1, h1), od, 0, 0, 0);
  od = __builtin_amdgcn_mfma_f32_32x32x16_bf16(pa2, PK(l2, h2), od, 0, 0, 0);
  od = __builtin_amdgcn_mfma_f32_32x32x16_bf16(pa3, PK(l3, h3), od, 0, 0, 0);
#undef PK
}
__device__ __forceinline__ void pv_d0(f32x16* o, int vb, bf16x8 pa0, bf16x8 pa1, bf16x8 pa2, bf16x8 pa3) {
  pv_one<0>(o[0], vb, pa0, pa1, pa2, pa3); pv_one<1>(o[1], vb, pa0, pa1, pa2, pa3); pv_one<2>(o[2], vb, pa0, pa1, pa2, pa3); pv_one<3>(o[3], vb, pa0, pa1, pa2, pa3);
}
template <int LDQ, int LDK, int LDO>
__device__ __forceinline__ void attn_dense_body(const bf16_t* __restrict__ Qb, const bf16_t* __restrict__ Kh, const bf16_t* __restrict__ Vh, float* __restrict__ Ob, int seq, LAS char* lds) {
  const int tid = opaque_tid(), wid = tid >> 6, lane = tid & 63, r32 = lane & 31, hi = lane >> 5;
  LAS char* V_lds = lds; LAS char* K_lds = lds + 2 * SHM_V;
  LAS float* wsl = (LAS float*)(lds + 2 * SHM_V + 2 * SHM_K) + wid * 64; LAS float* li_l = wsl; LAS float* al_l = wsl + 32;
  float m_reg = -1e30f, l_reg = 0; f32x16 o[4] = {}; bf16x8 qr[8];
  const bf16_t* Qw = Qb + (long)(wid * QBLK + r32) * LDQ + hi * 8;
#pragma unroll
  for (int d0 = 0; d0 < 8; ++d0) qr[d0] = *(const bf16x8*)(Qw + d0 * 16);
  const int sr = tid >> 4, sc = (tid & 15) * 8, vst0 = v_st(sr, sc), vst1 = v_st(32 + sr, sc);
  const int vb0 = (int)(uintptr_t)V_lds + v_rd_base(lane);
  struct { bf16x8 vs0, vs1, ks0, ks1; } sr_[SDEPTH];
#define SLOAD(i, k0) do { sr_[i].vs0 = *(const bf16x8*)(&Vh[(long)((k0) + sr) * LDK + sc]); sr_[i].vs1 = *(const bf16x8*)(&Vh[(long)((k0) + 32 + sr) * LDK + sc]); \
    sr_[i].ks0 = *(const bf16x8*)(&Kh[(long)((k0) + sr) * LDK + sc]); sr_[i].ks1 = *(const bf16x8*)(&Kh[(long)((k0) + 32 + sr) * LDK + sc]); } while (0)
#define SWRITE(b, i) do { *(LAS bf16x8*)(V_lds + (b) * SHM_V + vst0) = sr_[i].vs0;          \
    *(LAS bf16x8*)(V_lds + (b) * SHM_V + vst1) = sr_[i].vs1; int kc = sc * 2;               \
    *(LAS bf16x8*)(K_lds + (b) * SHM_K + KSWZ(sr, kc)) = sr_[i].ks0;                       \
    *(LAS bf16x8*)(K_lds + (b) * SHM_K + KSWZ(32 + sr, kc)) = sr_[i].ks1; } while (0)
#define SWAIT() do { asm volatile("s_waitcnt vmcnt(4)" ::: "memory"); } while (0)
#define RESC(a) do { if (__any((a) < 1.f)) { if (hi == 0) al_l[r32] = (a); asm volatile("s_waitcnt lgkmcnt(0)" ::: "memory"); \
    for (int d = 0; d < 4; ++d) for (int r = 0; r < 16; ++r) o[d][r] *= al_l[crow(r, hi)]; } } while (0)
  f32x16 pA0, pA1, pB0, pB1; float mnA, mnB, alA, alB; bf16x8 pa0, pa1, pa2, pa3; const int NT = seq / KVBLK;
  constexpr int SE = 0, SO = SDEPTH - 1;
  SLOAD(SE, 0); asm volatile("s_waitcnt vmcnt(0)" ::: "memory"); SWRITE(0, SE); __syncthreads();
  qkt(pA0, pA1, K_lds, qr, r32, hi); partialSM(pA0, pA1, m_reg, mnA, alA);
  SLOAD(SO, KVBLK); if (2 < NT) SLOAD(SE, 2 * KVBLK);
  SWAIT(); SWRITE(1, SO); __syncthreads();
  for (int j = 1; j + 1 < NT; j += 2) {
    SBAR(); qkt(pB0, pB1, K_lds + SHM_K, qr, r32, hi);
    finishSM(pA0, pA1, alA, l_reg, pa0, pa1, pa2, pa3); SBAR();
    SLOAD(SO, (j + SDEPTH) * KVBLK); SBAR();
    pv_d0(o, vb0, pa0, pa1, pa2, pa3); partialSM(pB0, pB1, m_reg, mnB, alB);
    __syncthreads(); SWAIT(); SWRITE(0, SE);
    RESC(alB); __syncthreads();
    SBAR(); qkt(pA0, pA1, K_lds, qr, r32, hi);
    finishSM(pB0, pB1, alB, l_reg, pa0, pa1, pa2, pa3); SBAR();
    if (j + 3 < NT) SLOAD(SE, (j + 1 + SDEPTH) * KVBLK); SBAR();
    pv_d0(o, vb0 + (int)SHM_V, pa0, pa1, pa2, pa3); partialSM(pA0, pA1, m_reg, mnA, alA);
    __syncthreads(); SWAIT(); SWRITE(1, SO);
    RESC(alA); __syncthreads();
  }
  SBAR(); qkt(pB0, pB1, K_lds + SHM_K, qr, r32, hi);
  finishSM(pA0, pA1, alA, l_reg, pa0, pa1, pa2, pa3); SBAR();
  pv_d0(o, vb0, pa0, pa1, pa2, pa3); partialSM(pB0, pB1, m_reg, mnB, alB);
  __syncthreads(); RESC(alB);
  finishSM(pB0, pB1, alB, l_reg, pa0, pa1, pa2, pa3); SBAR();
  pv_d0(o, vb0 + (int)SHM_V, pa0, pa1, pa2, pa3);
  if (hi == 0) li_l[r32] = l_reg; asm volatile("s_waitcnt lgkmcnt(0)" ::: "memory");
  float rli[16];
#pragma unroll
  for (int r = 0; r < 16; ++r) rli[r] = __builtin_amdgcn_rcpf(li_l[crow(r, hi)]);
  float* Ow = Ob + (long)(wid * QBLK) * LDO;
#pragma unroll
  for (int r = 0; r < 16; ++r) { int orow = crow(r, hi);
#pragma unroll
    for (int d0 = 0; d0 < 4; ++d0) Ow[(long)orow * LDO + d0 * 32 + r32] = o[d0][r] * rli[r]; }
  asm volatile("s_waitcnt vmcnt(0) lgkmcnt(0)" ::: "memory"); __syncthreads();
#undef SLOAD
#undef SWRITE
#undef SWAIT
#undef RESC
}
constexpr int SHM_V2 = KVBLK * 256 * 2, SHM_K2 = KVBLK * AD * 2, SHM_ATTN256 = 2 * SHM_V2 + 2 * SHM_K2 + NW * 64 * 4;
__device__ __forceinline__ int v_st256(int k, int c) { const int kk = (k & ~0xC) | ((k & 4) << 1) | ((k & 8) >> 1); return ((kk >> 3) * 8 + (c >> 5)) * 512 + ((kk & 7) * 32 + (c & 31)) * 2; }
constexpr int v_rd_off256(int d0, int ks, int half) { return d0 * 512 + ks * 8192 + half * 4096; }
template <int D0> __device__ __forceinline__ void pv_one256(f32x16& od, int vb, bf16x8 pa0, bf16x8 pa1, bf16x8 pa2, bf16x8 pa3) {
  const s16x4 l0 = tr_read<v_rd_off256(D0, 0, 0)>(vb), h0 = tr_read<v_rd_off256(D0, 0, 1)>(vb), l1 = tr_read<v_rd_off256(D0, 1, 0)>(vb), h1 = tr_read<v_rd_off256(D0, 1, 1)>(vb);
  const s16x4 l2 = tr_read<v_rd_off256(D0, 2, 0)>(vb), h2 = tr_read<v_rd_off256(D0, 2, 1)>(vb), l3 = tr_read<v_rd_off256(D0, 3, 0)>(vb), h3 = tr_read<v_rd_off256(D0, 3, 1)>(vb);
  asm volatile("s_waitcnt lgkmcnt(0)" ::: "memory"); SBAR();
#define PK(L, H) (bf16x8){L[0], L[1], L[2], L[3], H[0], H[1], H[2], H[3]}
  od = __builtin_amdgcn_mfma_f32_32x32x16_bf16(pa0, PK(l0, h0), od, 0, 0, 0);
  od = __builtin_amdgcn_mfma_f32_32x32x16_bf16(pa1, PK(l1, h1), od, 0, 0, 0);
  od = __builtin_amdgcn_mfma_f32_32x32x16_bf16(pa2, PK(l2, h2), od, 0, 0, 0);
  od = __builtin_amdgcn_mfma_f32_32x32x16_bf16(pa3, PK(l3, h3), od, 0, 0, 0);
#undef PK
}
template <int LDQ, int LDK, int LDO>
__device__ __forceinline__ void attn_body256(const bf16_t* __restrict__ Qb, const bf16_t* __restrict__ Kh, const bf16_t* __restrict__ Vh, float* __restrict__ Ob, int seq, LAS char* lds) {
  const int tid = opaque_tid(), wid = tid >> 6, lane = tid & 63, r32 = lane & 31, hi = lane >> 5;
  LAS char* V_lds = lds; LAS char* K_lds = lds + 2 * SHM_V2;
  LAS float* wsl = (LAS float*)(lds + 2 * SHM_V2 + 2 * SHM_K2) + wid * 64; LAS float* li_l = wsl; LAS float* al_l = wsl + 32;
  float m_reg = -1e30f, l_reg = 0; f32x16 o[8] = {}; bf16x8 qr[8];
  const bf16_t* Qw = Qb + (long)(wid * QBLK + r32) * LDQ + hi * 8;
#pragma unroll
  for (int d0 = 0; d0 < 8; ++d0) qr[d0] = *(const bf16x8*)(Qw + d0 * 16);
  const int sr = tid >> 4, sc = (tid & 15) * 8;
  const int vst00 = v_st256(sr, sc), kst0 = KSWZ(sr, sc * 2);
  const unsigned toff = (unsigned)(sr * LDK + sc);
  const int vb0 = (int)(uintptr_t)V_lds + v_rd_base(lane);
  bf16x8 sa0, sa1, sa2, sa3;
#define SLOAD_A(k0) do { const bf16_t* vp_ = Vh + (long)(k0) * LDK + toff; const bf16_t* kp_ = Kh + (long)(k0) * LDK + toff; \
    sa0 = *(const bf16x8*)kp_; sa1 = *(const bf16x8*)(kp_ + 32L * LDK); sa2 = *(const bf16x8*)vp_; sa3 = *(const bf16x8*)(vp_ + 128); } while (0)
#define SWRITE_A(b) do { LAS char* vb_ = V_lds + (b) * SHM_V2 + vst00; LAS char* kb_ = K_lds + (b) * SHM_K2 + kst0; \
    *(LAS bf16x8*)(kb_) = sa0; *(LAS bf16x8*)(kb_ + 8192) = sa1; *(LAS bf16x8*)(vb_) = sa2; *(LAS bf16x8*)(vb_ + 2048) = sa3; } while (0)
#define SLOAD_B(k0) do { const bf16_t* vp_ = Vh + (long)((k0) + 32) * LDK + toff; sa0 = *(const bf16x8*)vp_; sa1 = *(const bf16x8*)(vp_ + 128); } while (0)
#define SWRITE_B(b) do { LAS char* vb_ = V_lds + (b) * SHM_V2 + vst00; *(LAS bf16x8*)(vb_ + 16384) = sa0; *(LAS bf16x8*)(vb_ + 18432) = sa1; } while (0)
  f32x16 p0, p1; float mn, al; bf16x8 pa0, pa1, pa2, pa3; const int NT = seq / KVBLK;
  SLOAD_A(0); asm volatile("s_waitcnt vmcnt(0)" ::: "memory"); SWRITE_A(0); SLOAD_B(0); asm volatile("s_waitcnt vmcnt(0)" ::: "memory"); SWRITE_B(0); __syncthreads();
#pragma unroll 1
  for (int j = 0; j < NT; ++j) {
    if (j + 1 < NT) SLOAD_A((j + 1) * KVBLK);
    SBAR(); qkt(p0, p1, K_lds + (j & 1) * SHM_K2, qr, r32, hi);
    partialSM(p0, p1, m_reg, mn, al);
    finishSM(p0, p1, al, l_reg, pa0, pa1, pa2, pa3); SBAR();
    if (j + 1 < NT) { asm volatile("s_waitcnt vmcnt(0)" ::: "memory"); SWRITE_A((j + 1) & 1); SLOAD_B((j + 1) * KVBLK); }
    SBAR();
    if (__any(al < 1.f)) { if (hi == 0) al_l[r32] = al; asm volatile("s_waitcnt lgkmcnt(0)" ::: "memory");
#pragma unroll
      for (int d = 0; d < 8; ++d)
#pragma unroll
        for (int r = 0; r < 16; ++r) o[d][r] *= al_l[crow(r, hi)]; }
    { const int vb = vb0 + (j & 1) * SHM_V2;
      pv_one256<0>(o[0], vb, pa0, pa1, pa2, pa3); pv_one256<1>(o[1], vb, pa0, pa1, pa2, pa3); pv_one256<2>(o[2], vb, pa0, pa1, pa2, pa3); pv_one256<3>(o[3], vb, pa0, pa1, pa2, pa3);
      pv_one256<4>(o[4], vb, pa0, pa1, pa2, pa3); pv_one256<5>(o[5], vb, pa0, pa1, pa2, pa3); pv_one256<6>(o[6], vb, pa0, pa1, pa2, pa3); pv_one256<7>(o[7], vb, pa0, pa1, pa2, pa3); }
    if (j + 1 < NT) { asm volatile("s_waitcnt vmcnt(0)" ::: "memory"); SWRITE_B((j + 1) & 1); }
    __syncthreads();
  }
  if (hi == 0) li_l[r32] = l_reg; asm volatile("s_waitcnt lgkmcnt(0)" ::: "memory");
  float* Ow = Ob + (long)(wid * QBLK) * LDO;
#pragma unroll
  for (int r = 0; r < 16; ++r) { const int orow = crow(r, hi); const float rli = __builtin_amdgcn_rcpf(li_l[orow]);
#pragma unroll
    for (int d0 = 0; d0 < 8; ++d0) Ow[(long)orow * LDO + d0 * 32 + r32] = o[d0][r] * rli; }
  asm volatile("s_waitcnt vmcnt(0) lgkmcnt(0)" ::: "memory"); __syncthreads();
#undef SLOAD_A
#undef SWRITE_A
#undef SLOAD_B
#undef SWRITE_B
}
#undef KSWZ
#undef SBAR
}

__device__ __forceinline__ void diffattn_units(const Params& p, LAS unsigned char* lds, float* O0, float* O1) {
    const bf16_t* proj = (const bf16_t*)(p.wp[IX_PROJ]);
    bf16_t* ao = (bf16_t*)(p.wp[IX_ACT]);
    const float* dl = p.in[17]; const float* dn = p.in[18];
    const int G = gridDim.x, bx = blockIdx.x; const int vcu = (G % 8 == 0) ? (bx % 8) * (G / 8) + bx / 8 : bx;
    for (int u = vcu; u < NB * 8 * 8; u += G) {
        const int qb = u & 7, h = (u >> 3) & 7, b = u >> 6;
        const size_t row0 = (size_t)b * T;
#pragma unroll 1
        for (int i = 0; i < 2; ++i) {
            const bf16_t* Q = proj + (row0 + qb * 256) * LD1 + h * 256 + i * 128;
            const bf16_t* K = proj + row0 * LD1 + 2048 + h * 256 + i * 128;
            const bf16_t* V = proj + row0 * LD1 + 4096 + h * 256;
            float* O = (i ? O1 : O0) + (row0 + qb * 256) * D + h * 256;
            att::attn_body256<LD1, LD1, D>(Q, K, V, O, T, (LAS char*)lds);
        }
    }
    const int tid_ = opaque_tid(), wave = tid_ >> 6, lane = tid_ & 63;
    float la = dl[lane] * dl[128 + lane] + dl[64 + lane] * dl[192 + lane], lb2 = dl[256 + lane] * dl[384 + lane] + dl[320 + lane] * dl[448 + lane];
    la = wave_sum(la); lb2 = wave_sum(lb2);
    const float lam = expf(la) - expf(lb2) + LAM_INIT;
    const f32x4 gv = *(const f32x4*)(dn + 4 * lane);
    for (int u = vcu; u < NB * 8 * 8; u += G) {
        const int qb = u & 7, h = (u >> 3) & 7, b = u >> 6;
        const size_t row0 = (size_t)b * T;
#pragma unroll 1
        for (int rr = 0; rr < 32; rr += 4) {
            f32x4 a[4], bb[4];
#pragma unroll
            for (int k = 0; k < 4; ++k) { const size_t off = (row0 + qb * 256 + wave * 32 + rr + k) * D + h * 256 + 4 * lane; a[k] = *(const f32x4*)(O0 + off); bb[k] = *(const f32x4*)(O1 + off); }
#pragma unroll
            for (int k = 0; k < 4; ++k) { const size_t off = (row0 + qb * 256 + wave * 32 + rr + k) * D + h * 256 + 4 * lane;
                const f32x4 o = a[k] - lam * bb[k];
                const float ss = wave_sum(o.x * o.x + o.y * o.y + o.z * o.z + o.w * o.w);
                const float rstd = (1.f - LAM_INIT) / sqrtf(ss * (1.f / 256.f) + EPS);
                if (OUT_F8) *(unsigned*)((unsigned char*)ao + off) = pk4_fp8(o.x * rstd * gv.x * F8_SM, o.y * rstd * gv.y * F8_SM, o.z * rstd * gv.z * F8_SM, o.w * rstd * gv.w * F8_SM);
                else { u32x2 ov; ov.x = pk2(o.x * rstd * gv.x, o.y * rstd * gv.y); ov.y = pk2(o.z * rstd * gv.z, o.w * rstd * gv.w); *(u32x2*)(ao + off) = ov; } }
        }
    }
}

namespace hg {
typedef short bf16x8 __attribute__((ext_vector_type(8)));
typedef short bf16x4 __attribute__((ext_vector_type(4)));
constexpr int SET_BYTES = 8192 * 3 + 512;
__device__ __forceinline__ int rm_byte(int c, int d) { return c * 256 + ((2 * d) ^ ((c & 7) << 4)); }
__device__ __forceinline__ bf16x8 pack8(const f32x4& a, const f32x4& b) { u32x4 w; w.x = pk2(a.x, a.y); w.y = pk2(a.z, a.w); w.z = pk2(b.x, b.y); w.w = pk2(b.z, b.w); return __builtin_bit_cast(bf16x8, w); }
}
__device__ __forceinline__ void hgrn_mfma(const Params& p, LAS unsigned char* lds) {
    using namespace hg;
    const bf16_t* proj = (const bf16_t*)(p.wp[IX_PROJ]);
    bf16_t* oscr = (bf16_t*)(p.wp[IX_XB]);
    const float* lbl = p.in[24];
    const int tid = opaque_tid(), w = __builtin_amdgcn_readfirstlane(tid >> 6), lane = tid & 63, fr = lane & 15, fq = lane >> 4;
    for (int u = blockIdx.x; u < 128; u += gridDim.x) {
        const int b = u >> 4, h = (u >> 1) & 7, dir = u & 1;
        const int d = 16 * w + fr;
        float lb; { const float l0 = lbl[h * 128 + d], l1 = lbl[1024 + h * 128 + d], l2 = lbl[2048 + h * 128 + d];
            const float mx = fmaxf(l0, fmaxf(l1, l2)); const float e0 = expf(l0 - mx), e1 = expf(l1 - mx), e2 = expf(l2 - mx); lb = e0 / (e0 + e1 + e2); }
        f32x4 S[8];
#pragma unroll
        for (int mi = 0; mi < 8; ++mi) S[mi] = (f32x4){0.f, 0.f, 0.f, 0.f};
        const bf16_t* pb = proj + (size_t)b * T * LD0 + h * 128 + d;
        const int zoff = dir ? 3072 : 2048;
        bf16_t rq[8], rz[8], rv[8], rp[8];
#define HG_LOAD(nn) do { _Pragma("unroll") for (int i = 0; i < 8; ++i) { \
                const int c_ = 8 * fq + i, tt_ = dir ? (T - 1 - (32 * (nn) + c_)) : (32 * (nn) + c_); const bf16_t* pr_ = pb + (size_t)tt_ * LD0; \
                rq[i] = pr_[0]; rv[i] = pr_[1024]; rz[i] = pr_[zoff]; \
                const int cp_ = (i < 4) ? (4 * fq + i) : (16 + 4 * fq + (i - 4)), tp_ = dir ? (T - 1 - (32 * (nn) + cp_)) : (32 * (nn) + cp_); \
                rp[i] = pb[(size_t)tp_ * LD0 + 1024]; } } while (0)
        HG_LOAD(0);
        for (int n = 0; n < T / 32; ++n) {
            LAS unsigned char* set = lds + (n & 1) * SET_BYTES;
            LAS unsigned char* QG = set; LAS unsigned char* KG = set + 8192; LAS unsigned char* KDT = set + 16384; LAS float* DEC = (LAS float*)(set + 24576);
            float qv[8], fv[8], vv[8], vp[8];
#pragma unroll
            for (int i = 0; i < 8; ++i) { qv[i] = bf2f(rq[i]); vv[i] = bf2f(rv[i]); fv[i] = bf2f(rz[i]); vp[i] = bf2f(rp[i]); }
            if (n + 1 < T / 32) HG_LOAD(n + 1);
            float Pl[8]; float P = 1.f;
#pragma unroll
            for (int i = 0; i < 8; ++i) { fv[i] = lb + (1.f - lb) * sigm(fv[i]); P *= fv[i]; Pl[i] = P; }
            const float p0 = __shfl(P, fr), p1 = __shfl(P, fr + 16), p2 = __shfl(P, fr + 32), p3 = __shfl(P, fr + 48);
            const float pre = (fq > 0 ? p0 : 1.f) * (fq > 1 ? p1 : 1.f) * (fq > 2 ? p2 : 1.f), tot = (p0 * p1) * (p2 * p3);
            float kd[8];
#pragma unroll
            for (int i = 0; i < 8; ++i) {
                const int c = 8 * fq + i; const float E = pre * Pl[i], rE = frcp(E), k = 1.f - fv[i];
                *(LAS bf16_t*)(QG + rm_byte(c, d)) = f2bf(silu(qv[i]) * E);
                *(LAS bf16_t*)(KG + rm_byte(c, d)) = f2bf(k * rE);
                kd[i] = k * tot * rE;
            }
            { u32x4 wv; wv.x = pk2(kd[0], kd[1]); wv.y = pk2(kd[2], kd[3]); wv.z = pk2(kd[4], kd[5]); wv.w = pk2(kd[6], kd[7]);
              *(LAS u32x4*)(KDT + d * 64 + ((fq ^ ((d >> 2) & 3)) << 4)) = wv; }
            if (fq == 0) DEC[d] = tot;
            const bf16x8 vB = pack8((f32x4){vv[0], vv[1], vv[2], vv[3]}, (f32x4){vv[4], vv[5], vv[6], vv[7]});
            const bf16x8 vP = pack8((f32x4){vp[0], vp[1], vp[2], vp[3]}, (f32x4){vp[4], vp[5], vp[6], vp[7]});
            __syncthreads();
            f32x4 at00 = {0.f, 0.f, 0.f, 0.f}, at01 = at00, at11 = at00;
#pragma unroll
            for (int ks = 0; ks < 4; ++ks) {
                const int d0 = 32 * ks + 8 * fq;
                const bf16x8 kg0 = *(const LAS bf16x8*)(KG + rm_byte(fr, d0)), kg1 = *(const LAS bf16x8*)(KG + rm_byte(16 + fr, d0));
                const bf16x8 qg0 = *(const LAS bf16x8*)(QG + rm_byte(fr, d0)), qg1 = *(const LAS bf16x8*)(QG + rm_byte(16 + fr, d0));
                at00 = __builtin_amdgcn_mfma_f32_16x16x32_bf16(kg0, qg0, at00, 0, 0, 0);
                at01 = __builtin_amdgcn_mfma_f32_16x16x32_bf16(kg0, qg1, at01, 0, 0, 0);
                at11 = __builtin_amdgcn_mfma_f32_16x16x32_bf16(kg1, qg1, at11, 0, 0, 0);
            }
#pragma unroll
            for (int j = 0; j < 4; ++j) { const bool ok = (4 * fq + j) <= fr; at00[j] = ok ? at00[j] : 0.f; at11[j] = ok ? at11[j] : 0.f; }
            const bf16x8 bi0 = pack8(at00, (f32x4){0.f, 0.f, 0.f, 0.f}), bi1 = pack8(at01, at11);
            f32x4 o0 = {0.f, 0.f, 0.f, 0.f}, o1 = o0;
            o0 = __builtin_amdgcn_mfma_f32_16x16x32_bf16(vP, bi0, o0, 0, 0, 0);
            o1 = __builtin_amdgcn_mfma_f32_16x16x32_bf16(vP, bi1, o1, 0, 0, 0);
#pragma unroll
            for (int ks = 0; ks < 4; ++ks) {
                const bf16x8 sb = pack8(S[2 * ks], S[2 * ks + 1]);
                const int da = 32 * ks + 4 * fq, db = da + 16;
                const bf16x4 q0a = *(const LAS bf16x4*)(QG + rm_byte(fr, da)), q0b = *(const LAS bf16x4*)(QG + rm_byte(fr, db));
                const bf16x4 q1a = *(const LAS bf16x4*)(QG + rm_byte(16 + fr, da)), q1b = *(const LAS bf16x4*)(QG + rm_byte(16 + fr, db));
                const bf16x8 qp0 = {q0a[0], q0a[1], q0a[2], q0a[3], q0b[0], q0b[1], q0b[2], q0b[3]}, qp1 = {q1a[0], q1a[1], q1a[2], q1a[3], q1b[0], q1b[1], q1b[2], q1b[3]};
                o0 = __builtin_amdgcn_mfma_f32_16x16x32_bf16(sb, qp0, o0, 0, 0, 0);
                o1 = __builtin_amdgcn_mfma_f32_16x16x32_bf16(sb, qp1, o1, 0, 0, 0);
            }
            { const int c0 = fr, c1 = 16 + fr; const int t0 = dir ? (T - 1 - (32 * n + c0)) : (32 * n + c0), t1 = dir ? (T - 1 - (32 * n + c1)) : (32 * n + c1);
              bf16_t* ob = oscr + ((size_t)dir * M + (size_t)b * T) * 1024 + h * 128 + 16 * w + 4 * fq;
              u32x2 w0; w0.x = pk2(o0[0], o0[1]); w0.y = pk2(o0[2], o0[3]); u32x2 w1; w1.x = pk2(o1[0], o1[1]); w1.y = pk2(o1[2], o1[3]);
              *(u32x2*)(ob + (size_t)t0 * 1024) = w0; *(u32x2*)(ob + (size_t)t1 * 1024) = w1; }
#pragma unroll
            for (int mi = 0; mi < 8; ++mi) {
                const int dr = 16 * mi + fr;
                const bf16x8 ka = *(const LAS bf16x8*)(KDT + dr * 64 + ((fq ^ ((dr >> 2) & 3)) << 4));
                const f32x4 dc = *(const LAS f32x4*)(DEC + 16 * mi + 4 * fq);
                S[mi] = __builtin_amdgcn_mfma_f32_16x16x32_bf16(ka, vB, S[mi] * dc, 0, 0, 0);
            }
        }
        __syncthreads();
    }
#undef HG_LOAD
}

__device__ __forceinline__ void na_task(const bf16_t* proj, const bf16_t* VT, const float* rpb, bf16_t* mix, LAS float* btab, int b, int r, int h, int qb, int lane) {
    typedef short bf16x8 __attribute__((ext_vector_type(8)));
    const int fr = lane & 15, fq = lane >> 4;
    const int r0 = min(max(r - 4, 0), 24), cb0 = (qb <= 1) ? 0 : 1;
    constexpr float LOG2E = 1.4426950408889634f, C = 0.125f * LOG2E;
    for (int i = lane; i < 8 * 31; i += 64) { const int kr = i / 31, dc = i % 31; btab[kr * 32 + dc] = rpb[(h * 15 + (r0 + kr - r + 7)) * 31 + dc] * LOG2E; }
    const size_t qtok = (size_t)b * T + r * 64 + 16 * qb + fr;
    bf16x8 qf[2];
#pragma unroll
    for (int ks = 0; ks < 2; ++ks) qf[ks] = *(const bf16x8*)(proj + qtok * LD0 + 5120 + h * 64 + 32 * ks + 8 * fq);
    f32x4 sc[24];
#pragma unroll
    for (int g = 0; g < 2; ++g) {
        bf16x8 kf[12][2];
#pragma unroll
        for (int t = 0; t < 12; ++t) { const int tile = 12 * g + t, kr = tile / 3, cbi = tile % 3;
            const size_t ktok = (size_t)b * T + (r0 + kr) * 64 + 16 * (cb0 + cbi) + fr;
            const bf16_t* kp = proj + ktok * LD0 + 6144 + h * 64 + 8 * fq;
            kf[t][0] = *(const bf16x8*)kp; kf[t][1] = *(const bf16x8*)(kp + 32); }
        __builtin_amdgcn_sched_barrier(0);
#pragma unroll
        for (int t = 0; t < 12; ++t) { f32x4 a = {0.f, 0.f, 0.f, 0.f};
            a = __builtin_amdgcn_mfma_f32_16x16x32_bf16(kf[t][0], qf[0], a, 0, 0, 0);
            a = __builtin_amdgcn_mfma_f32_16x16x32_bf16(kf[t][1], qf[1], a, 0, 0, 0);
            sc[12 * g + t] = a; }
        __builtin_amdgcn_sched_barrier(0);
    }
    const bf16_t* vbase = VT + (size_t)(h * 64 + fr) * VTLD + (size_t)b * T + 4 * fq;
    u32x2 vbuf[2][24];
#define NA_VLOAD(buf, nd) do { const bf16_t* vp_ = vbase + (size_t)(16 * (nd)) * VTLD; _Pragma("unroll") for (int t = 0; t < 24; ++t) vbuf[buf][t] = *(const u32x2*)(vp_ + (r0 + t / 3) * 64 + 16 * (cb0 + t % 3)); } while (0)
    NA_VLOAD(0, 0);
    asm volatile("s_waitcnt lgkmcnt(0)" ::: "memory");
    const int c = 16 * qb + fr, cs = min(max(c - 8, 0), 48);
    float mx = -1e30f;
#pragma unroll
    for (int kr = 0; kr < 8; ++kr)
#pragma unroll
        for (int cbi = 0; cbi < 3; ++cbi)
#pragma unroll
            for (int j = 0; j < 4; ++j) {
                const int sidx = 16 * (cb0 + cbi) + 4 * fq + j; const bool ok = (sidx >= cs) && (sidx < cs + 16);
                const int dc = min(max(sidx - c + 15, 0), 30);
                const float v = fmaf(sc[kr * 3 + cbi][j], C, btab[kr * 32 + dc]) + (ok ? 0.f : -1e30f);
                sc[kr * 3 + cbi][j] = v; mx = fmaxf(mx, v);
            }
    mx = fmaxf(mx, __shfl_xor(mx, 16)); mx = fmaxf(mx, __shfl_xor(mx, 32));
    float sum = 0.f;
#pragma unroll
    for (int t = 0; t < 24; ++t)
#pragma unroll
        for (int j = 0; j < 4; ++j) { const float e = __builtin_amdgcn_exp2f(sc[t][j] - mx); sc[t][j] = e; sum += e; }
    sum += __shfl_xor(sum, 16); sum += __shfl_xor(sum, 32);
    const float rs = 1.f / sum;
    f32x4 o[4];
#pragma unroll
    for (int nd = 0; nd < 4; ++nd) o[nd] = (f32x4){0.f, 0.f, 0.f, 0.f};
    bf16x8 pB[12];
#pragma unroll
    for (int kk = 0; kk < 12; ++kk) { const int t0 = 2 * kk, t1 = 2 * kk + 1;
        u32x4 w; w.x = pk2(sc[t0][0], sc[t0][1]); w.y = pk2(sc[t0][2], sc[t0][3]); w.z = pk2(sc[t1][0], sc[t1][1]); w.w = pk2(sc[t1][2], sc[t1][3]);
        pB[kk] = __builtin_bit_cast(bf16x8, w); }
#pragma unroll
    for (int nd = 0; nd < 4; ++nd) {
        if (nd + 1 < 4) NA_VLOAD((nd + 1) & 1, nd + 1);
#pragma unroll
        for (int kk = 0; kk < 12; ++kk) {
            const u32x2 va = vbuf[nd & 1][2 * kk], vb = vbuf[nd & 1][2 * kk + 1];
            u32x4 vw; vw.x = va.x; vw.y = va.y; vw.z = vb.x; vw.w = vb.y;
            o[nd] = __builtin_amdgcn_mfma_f32_16x16x32_bf16(__builtin_bit_cast(bf16x8, vw), pB[kk], o[nd], 0, 0, 0);
        }
    }
#undef NA_VLOAD
#pragma unroll
    for (int nd = 0; nd < 4; ++nd) { u32x2 ov; ov.x = pk2(o[nd][0] * rs, o[nd][1] * rs); ov.y = pk2(o[nd][2] * rs, o[nd][3] * rs);
        *(u32x2*)(mix + qtok * D + 1024 + h * 64 + 16 * nd + 4 * fq) = ov; }
}
constexpr int NA_UNITS = NB * 32 * 8, NA_FIRST = 1024;
__device__ __forceinline__ void na_mfma(const Params& p, LAS unsigned char* lds, int first, int stride, int lo, int hi) {
    const bf16_t* proj = (const bf16_t*)(p.wp[IX_PROJ]); const bf16_t* VT = (const bf16_t*)(p.wp[IX_VT]);
    bf16_t* mix = (bf16_t*)(p.wp[IX_ACT]);
    const int tid = opaque_tid(), w = __builtin_amdgcn_readfirstlane(tid >> 6), lane = tid & 63;
    LAS float* btab = (LAS float*)(lds + 65536) + w * 256;
    for (int u = lo + first; u < hi; u += stride) {
        const int hp = u & 7, r = (u >> 3) & 31, b = u >> 8;
        na_task(proj, VT, p.in[7], mix, btab, b, r, 2 * hp + (w >> 2), w & 3, lane);
    }
}

namespace na2 { constexpr int KRING = 0, VRING = 73728, MERGE = 147456, BIAS = 157696; }
__device__ __forceinline__ void na_ring(const Params& p, LAS unsigned char* lds, int unit) {
    using namespace na2;
    typedef short bf16x8 __attribute__((ext_vector_type(8)));
    const bf16_t* proj = (const bf16_t*)(p.wp[IX_PROJ]); const bf16_t* VT = (const bf16_t*)(p.wp[IX_VT]);
    bf16_t* mix = (bf16_t*)(p.wp[IX_ACT]); const float* rpb = p.in[7];
    const int tid = opaque_tid(), w = __builtin_amdgcn_readfirstlane(tid >> 6), lane = tid & 63, fr = lane & 15, fq = lane >> 4;
    const int b = unit >> 4, h = unit & 15, qb = w & 3, hf = w >> 2, cb0 = (qb <= 1) ? 0 : 1;
    constexpr float LOG2E = 1.4426950408889634f, C = 0.125f * LOG2E;
    LAS float* btab = (LAS float*)(lds + BIAS);
    for (int i = tid; i < 15 * 31; i += 512) btab[(i / 31) * 32 + (i % 31)] = rpb[h * 465 + i] * LOG2E;
    const int st_row = tid >> 3, st_pc = tid & 7, st_off = st_row * 128 + ((st_pc ^ (st_row & 7)) << 4);
    const bf16_t* kg = proj + ((size_t)b * T + st_row) * LD0 + 6144 + h * 64 + st_pc * 8;
    const bf16_t* vg = VT + (size_t)(h * 64 + st_row) * VTLD + (size_t)b * T + st_pc * 8;
    { u32x4 kk[8], vv[8];
#pragma unroll
      for (int g = 0; g < 8; ++g) { kk[g] = *(const u32x4*)(kg + (size_t)g * 64 * LD0); vv[g] = *(const u32x4*)(vg + g * 64); }
#pragma unroll
      for (int g = 0; g < 8; ++g) { *(LAS u32x4*)(lds + KRING + g * 8192 + st_off) = kk[g]; *(LAS u32x4*)(lds + VRING + g * 8192 + st_off) = vv[g]; } }
    const bf16_t* qg = proj + ((size_t)b * T + 16 * qb + fr) * LD0 + 5120 + h * 64 + 8 * fq;
    bf16x8 qf[2]; qf[0] = *(const bf16x8*)qg; qf[1] = *(const bf16x8*)(qg + 32);
    const int c = 16 * qb + fr, cs = min(max(c - 8, 0), 48);
    LAS unsigned* mb = (LAS unsigned*)(lds + MERGE) + qb * 640 + lane;
    __syncthreads();
    for (int r = 0; r < 32; ++r) {
        const int r0 = min(max(r - 4, 0), 24);
        const bool pf = (r >= 4) && (r < 28);
        u32x4 pk_ = {0u, 0u, 0u, 0u}, pv_ = {0u, 0u, 0u, 0u};
        if (pf) { pk_ = *(const u32x4*)(kg + (size_t)(r + 4) * 64 * LD0); pv_ = *(const u32x4*)(vg + (r + 4) * 64); }
        bf16x8 qn0 = qf[0], qn1 = qf[1];
        if (r + 1 < 32) { qn0 = *(const bf16x8*)(qg + (size_t)(r + 1) * 64 * LD0); qn1 = *(const bf16x8*)(qg + (size_t)(r + 1) * 64 * LD0 + 32); }
        f32x4 sc[12];
        int slot[4];
#pragma unroll
        for (int k4 = 0; k4 < 4; ++k4) { slot[k4] = (r0 + 4 * hf + k4) % 9;
            const LAS unsigned char* ks = lds + KRING + slot[k4] * 8192;
#pragma unroll
            for (int cbi = 0; cbi < 3; ++cbi) { const int tok = 16 * (cb0 + cbi) + fr;
                const bf16x8 a0 = *(const LAS bf16x8*)(ks + tok * 128 + ((fq ^ (tok & 7)) << 4)), a1 = *(const LAS bf16x8*)(ks + tok * 128 + (((4 + fq) ^ (tok & 7)) << 4));
                f32x4 a = {0.f, 0.f, 0.f, 0.f};
                a = __builtin_amdgcn_mfma_f32_16x16x32_bf16(a0, qf[0], a, 0, 0, 0);
                a = __builtin_amdgcn_mfma_f32_16x16x32_bf16(a1, qf[1], a, 0, 0, 0);
                sc[k4 * 3 + cbi] = a; } }
        float mx = -1e30f;
#pragma unroll
        for (int k4 = 0; k4 < 4; ++k4) { const LAS float* bt = btab + (r0 + 4 * hf + k4 - r + 7) * 32;
#pragma unroll
            for (int cbi = 0; cbi < 3; ++cbi)
#pragma unroll
                for (int j = 0; j < 4; ++j) { const int sidx = 16 * (cb0 + cbi) + 4 * fq + j; const bool ok = (sidx >= cs) && (sidx < cs + 16);
                    const int dc = min(max(sidx - c + 15, 0), 30);
                    const float v = fmaf(sc[k4 * 3 + cbi][j], C, bt[dc]) + (ok ? 0.f : -1e30f);
                    sc[k4 * 3 + cbi][j] = v; mx = fmaxf(mx, v); } }
        mx = fmaxf(mx, __shfl_xor(mx, 16)); mx = fmaxf(mx, __shfl_xor(mx, 32));
        float sum = 0.f;
#pragma unroll
        for (int t = 0; t < 12; ++t)
#pragma unroll
            for (int j = 0; j < 4; ++j) { const float e = __builtin_amdgcn_exp2f(sc[t][j] - mx); sc[t][j] = e; sum += e; }
        sum += __shfl_xor(sum, 16); sum += __shfl_xor(sum, 32);
        bf16x8 pB[6];
#pragma unroll
        for (int kk = 0; kk < 6; ++kk) { const int t0 = 2 * kk, t1 = 2 * kk + 1;
            u32x4 wv; wv.x = pk2(sc[t0][0], sc[t0][1]); wv.y = pk2(sc[t0][2], sc[t0][3]); wv.z = pk2(sc[t1][0], sc[t1][1]); wv.w = pk2(sc[t1][2], sc[t1][3]);
            pB[kk] = __builtin_bit_cast(bf16x8, wv); }
        f32x4 o[4];
#pragma unroll
        for (int nd = 0; nd < 4; ++nd) { o[nd] = (f32x4){0.f, 0.f, 0.f, 0.f}; const int d = 16 * nd + fr;
#pragma unroll
            for (int kk = 0; kk < 6; ++kk) { const int t0 = 2 * kk, t1 = 2 * kk + 1;
                const int tc0 = 16 * (cb0 + t0 % 3) + 4 * fq, tc1 = 16 * (cb0 + t1 % 3) + 4 * fq;
                const u32x2 va = *(const LAS u32x2*)(lds + VRING + slot[t0 / 3] * 8192 + d * 128 + (((tc0 >> 3) ^ (d & 7)) << 4) + (tc0 & 7) * 2);
                const u32x2 vb = *(const LAS u32x2*)(lds + VRING + slot[t1 / 3] * 8192 + d * 128 + (((tc1 >> 3) ^ (d & 7)) << 4) + (tc1 & 7) * 2);
                u32x4 vw; vw.x = va.x; vw.y = va.y; vw.z = vb.x; vw.w = vb.y;
                o[nd] = __builtin_amdgcn_mfma_f32_16x16x32_bf16(__builtin_bit_cast(bf16x8, vw), pB[kk], o[nd], 0, 0, 0); } }
        const bool merger = (hf == (r & 1));
        if (!merger) { mb[0] = __float_as_uint(mx); mb[64] = __float_as_uint(sum);
#pragma unroll
            for (int nd = 0; nd < 4; ++nd) { mb[(2 + 2 * nd) * 64] = pk2(o[nd][0], o[nd][1]); mb[(3 + 2 * nd) * 64] = pk2(o[nd][2], o[nd][3]); } }
        if (pf) { const int sl = (r + 4) % 9; *(LAS u32x4*)(lds + KRING + sl * 8192 + st_off) = pk_; *(LAS u32x4*)(lds + VRING + sl * 8192 + st_off) = pv_; }
        __syncthreads();
        if (merger) {
            const float m2 = __uint_as_float(mb[0]), l2 = __uint_as_float(mb[64]);
            const float mN = fmaxf(mx, m2), a1 = __builtin_amdgcn_exp2f(mx - mN), a2 = __builtin_amdgcn_exp2f(m2 - mN);
            const float rl = frcp(sum * a1 + l2 * a2);
            bf16_t* op = mix + ((size_t)b * T + r * 64 + 16 * qb + fr) * D + 1024 + h * 64 + 4 * fq;
            unsigned char* op8 = (unsigned char*)mix + ((size_t)b * T + r * 64 + 16 * qb + fr) * D + 1024 + h * 64 + 4 * fq;
#pragma unroll
            for (int nd = 0; nd < 4; ++nd) { const unsigned w0 = mb[(2 + 2 * nd) * 64], w1 = mb[(3 + 2 * nd) * 64];
                const float x0 = (o[nd][0] * a1 + __uint_as_float(w0 << 16) * a2) * rl, x1 = (o[nd][1] * a1 + __uint_as_float(w0 & 0xffff0000u) * a2) * rl;
                const float x2 = (o[nd][2] * a1 + __uint_as_float(w1 << 16) * a2) * rl, x3 = (o[nd][3] * a1 + __uint_as_float(w1 & 0xffff0000u) * a2) * rl;
                if (OUT_F8) *(unsigned*)(op8 + 16 * nd) = pk4_fp8(x0 * F8_SM, x1 * F8_SM, x2 * F8_SM, x3 * F8_SM);
                else { u32x2 ov; ov.x = pk2(x0, x1); ov.y = pk2(x2, x3); *(u32x2*)(op + 16 * nd) = ov; } }
        }
        qf[0] = qn0; qf[1] = qn1;
    }
    __syncthreads();
}

#ifndef PROBE
#define PROBE 0
#endif
#define PH(k, ...) do { __VA_ARGS__ if constexpr (PROBE == (k)) { xcd_barrier(bar); __VA_ARGS__ } } while (0)
__global__ void __launch_bounds__(512, 2) fwd_kernel(Params p) {
    extern __shared__ __attribute__((aligned(16))) unsigned char lds_raw[];
    LAS unsigned char* lds = (LAS unsigned char*)lds_raw;
    volatile LAS unsigned* xbw = (volatile LAS unsigned*)(lds + LDS_BYTES - 16);
    if (threadIdx.x < 4) xbw[threadIdx.x] = 0u;
    __syncthreads();
    unsigned* ctl = (unsigned*)(p.wp[IX_CTL]);
    XcdBarrier bar = xcd_barrier_post(ctl + CW_BAR, xbw);
    float* mod = (float*)(p.wp[IX_MOD]);
    float* xb = (float*)(p.wp[IX_XB]);
    bf16_t* act = (bf16_t*)(p.wp[IX_ACT]);
    bf16_t* proj = (bf16_t*)(p.wp[IX_PROJ]);
    bf16_t* hid = (bf16_t*)(p.wp[IX_HID]);
    bf16_t* ybuf = (bf16_t*)(p.wp[IX_Y]);
    bf16_t* mres = (bf16_t*)(p.wp[IX_O1]);
    unsigned* cnt0 = ctl + CW_CNT; unsigned* cnt1 = ctl + CW_CNT + 64;
    LAS int* base = (LAS int*)(lds + LDS_BASE_OFF);
    const int G = gridDim.x, cid = blockIdx.x;
    if constexpr (PROBE == 20) { for (int i = 0; i < 10; ++i) xcd_barrier(bar); }
    if constexpr (PROBE == 22) { xcd_barrier(bar); }

    PH(1, phase_mod(p, lds); __syncthreads(););
    PH(2, phase_convert(p, lds););
    xcd_barrier(bar);
    PH(3, phase_rows<false, false, false, true>(p, lds, p.in[0], nullptr, p.in[2], mod, 0, D, nullptr, act, nullptr, nullptr, nullptr););
    xcd_barrier(bar);
    if constexpr (PROBE == 21) { xcd_barrier(bar); xcd_barrier(bar); xcd_barrier(bar); xcd_barrier(bar); xcd_barrier(bar); xcd_barrier(bar); xcd_barrier(bar); xcd_barrier(bar); xcd_barrier(bar); xcd_barrier(bar); }
    PH(4, { pg8::StaticOrder S; S.init(M, 7168, G, cid); pg8::EpiBf16 E{proj, LD0, 1.f / (F8_SA * F8_SW)};
        pg8::gemm_phase<pg8::EpiBf16, pg8::StaticOrder, true, true, true>(lds, act, p.wp[IX_WIN0], D, S, E);
        pg8::StaticOrder S2; S2.init(1024, M, G, cid); pg8::EpiBf16 E2{(bf16_t*)(p.wp[IX_VT]), VTLD, 1.f / (F8_SA * F8_SW)};
        pg8::gemm_phase<pg8::EpiBf16, pg8::StaticOrder, true, true, true>(lds, p.wp[IX_WIN0] + (size_t)7168 * D, act, D, S2, E2); });
    xcd_barrier(bar);
    PH(5, hgrn_mfma(p, lds););
    if (G >= 256) { if (cid >= 128) for (int u = cid - 128; u < NB * 16; u += G - 128) na_ring(p, lds, u); }
    else for (int u = cid; u < NB * 16; u += G) na_ring(p, lds, u);
    if constexpr (PROBE == 6) { xcd_barrier(bar); for (int u = cid; u < NB * 16; u += G) na_ring(p, lds, u); }
    xcd_barrier(bar);
    PH(7, hgrn_combine(p););
    xcd_barrier(bar);
    PH(8, { pg8::StaticOrder S; S.init(M, D, G, cid); pg8::EpiBf16 E{mres, D, OUT_F8 ? 1.f / (F8_SM * F8_SWD) : 1.f};
        pg8::gemm_phase<pg8::EpiBf16, pg8::StaticOrder, true, true, OUT_F8>(lds, act, p.wp[IX_WOUT0], D, S, E); });
    xcd_barrier(bar);
    phase_rows<false, true, false, true>(p, lds, p.in[0], nullptr, p.in[9], mod, 3 * D, 4 * D, nullptr, act, nullptr, nullptr, cnt0, mres);
    if constexpr (PROBE == 15) { xcd_barrier(bar); phase_rows<false, true, false, true, true>(p, lds, p.in[0], nullptr, p.in[9], mod, 3 * D, 4 * D, nullptr, act, nullptr, nullptr, ctl + CW_CNT + 128, mres); }
    xcd_barrier(bar);
    compute_base(cnt0, base);
    { pg8::MoeOrder<true, 0, true, false> S{base, (const int*)(p.wp[IX_LIST]), cnt0, G, cid, base[NE] / 256, ctl + CW_FLG}; pg8::EpiGluF8 E{(unsigned char*)hid, (const float*)(p.wp[IX_LW]), cnt0, base};
        pg8::gemm_phase<pg8::EpiGluF8, pg8::MoeOrder<true, 0, true, false>, true, true, true>(lds, act, p.wp[IX_WGU0], D, S, E); }
    { pg8::MoeOrder<false, 2, false, true> S{base, nullptr, cnt0, G, cid, base[NE] / 256, ctl + CW_FLG}; pg8::EpiBf16 E{ybuf, D, 1.f / (F8_SH * F8_SWD)};
        pg8::gemm_phase<pg8::EpiBf16, pg8::MoeOrder<false, 2, false, true>, true, true, true>(lds, hid, p.wp[IX_WD0], DFF, S, E); }
    xcd_barrier(bar);
    PH(11, phase_combine<false, true>(p, lds, p.in[0], xb, p.in[13], mod + 8 * 12288, mod, act, nullptr, cnt0, mres););
    xcd_barrier(bar);
    PH(12, { pg8::StaticOrder S; S.init(M, ODW, G, cid); pg8::EpiBf16Rope E{proj, LD1, (const float*)(p.wp[IX_ROPE]), (const float*)(p.wp[IX_ROPE]) + 2048 * 16, 1.f / (F8_SA * F8_SW)};
        pg8::gemm_phase<pg8::EpiBf16Rope, pg8::StaticOrder, true, true, true>(lds, act, p.wp[IX_WIN1], D, S, E); });
    xcd_barrier(bar);
    PH(13, diffattn_units(p, lds, p.out, (float*)(p.wp[IX_O1])););
    xcd_barrier(bar);
    { pg8::StaticOrder S; S.init(M, D, G, cid); pg8::EpiBf16 E{mres, D, OUT_F8 ? 1.f / (F8_SM * F8_SWD) : 1.f};
      pg8::gemm_phase<pg8::EpiBf16, pg8::StaticOrder, true, true, OUT_F8>(lds, act, p.wp[IX_WOUT1], D, S, E); }
    xcd_barrier(bar);
    phase_rows<false, true, false, true>(p, lds, xb, nullptr, p.in[20], mod + 8 * 12288, 3 * D, 4 * D, nullptr, act, nullptr, nullptr, cnt1, mres);
    xcd_barrier(bar);
    compute_base(cnt1, base);
    { pg8::MoeOrder<true, 0, true, false> S{base, (const int*)(p.wp[IX_LIST]), cnt1, G, cid, base[NE] / 256, ctl + CW_FLG + 256}; pg8::EpiGluF8 E{(unsigned char*)hid, (const float*)(p.wp[IX_LW]), cnt1, base};
      pg8::gemm_phase<pg8::EpiGluF8, pg8::MoeOrder<true, 0, true, false>, true, true, true>(lds, act, p.wp[IX_WGU1], D, S, E); }
    { pg8::MoeOrder<false, 2, false, true> S{base, nullptr, cnt1, G, cid, base[NE] / 256, ctl + CW_FLG + 256}; pg8::EpiBf16 E{ybuf, D, 1.f / (F8_SH * F8_SWD)};
      pg8::gemm_phase<pg8::EpiBf16, pg8::MoeOrder<false, 2, false, true>, true, true, true>(lds, hid, p.wp[IX_WD1], DFF, S, E); }
    xcd_barrier(bar);
    PH(16, phase_combine<true, false>(p, lds, xb, nullptr, p.in[27], nullptr, mod + 8 * 12288, nullptr, p.out, cnt1, mres););
}

extern "C" void kernel_launch(void* const* d_in, const int* in_sizes, int n_in, void* d_out, int out_size, void* d_ws, size_t ws_size, hipStream_t stream) {
    static int grid = 0;
    if (grid == 0) {
        if (n_in != 28 || out_size != M * D || ws_size < WS_END) { fprintf(stderr, "kernel_launch: unexpected shapes: n_in %d out %d ws %zu\n", n_in, out_size, ws_size); grid = -1; return; }
        int dev = 0, cus = 0, per_cu = 0;
        if (hipGetDevice(&dev) != hipSuccess || hipDeviceGetAttribute(&cus, hipDeviceAttributeMultiprocessorCount, dev) != hipSuccess) { grid = -1; return; }
        if (hipFuncSetAttribute((const void*)fwd_kernel, hipFuncAttributeMaxDynamicSharedMemorySize, LDS_BYTES) != hipSuccess) { fprintf(stderr, "kernel_launch: hipFuncSetAttribute failed\n"); grid = -1; return; }
        if (hipOccupancyMaxActiveBlocksPerMultiprocessor(&per_cu, (const void*)fwd_kernel, 512, LDS_BYTES) != hipSuccess || per_cu < 1) { fprintf(stderr, "kernel_launch: occupancy query says %d\n", per_cu); grid = -1; return; }
        (void)hipGetLastError();
        grid = cus;
    }
    if (grid < 0) return;
    if (hipMemsetAsync((char*)d_ws + WS_CTL, 0, CTL_BYTES, stream) != hipSuccess) return;
    Params p{};
    for (int i = 0; i < 28; ++i) p.in[i] = (const float*)d_in[i];
    p.out = (float*)d_out;
    p.wp[IX_ACT] = (unsigned char*)d_ws + WS_ACT;
    p.wp[IX_CTL] = (unsigned char*)d_ws + WS_CTL;
    p.wp[IX_HID] = (unsigned char*)d_ws + WS_HID;
    p.wp[IX_LIST] = (unsigned char*)d_ws + WS_LIST;
    p.wp[IX_LW] = (unsigned char*)d_ws + WS_LW;
    p.wp[IX_MOD] = (unsigned char*)d_ws + WS_MOD;
    p.wp[IX_O1] = (unsigned char*)d_ws + WS_O1;
    p.wp[IX_PROJ] = (unsigned char*)d_ws + WS_PROJ;
    p.wp[IX_ROPE] = (unsigned char*)d_ws + WS_ROPE;
    p.wp[IX_TOK] = (unsigned char*)d_ws + WS_TOK;
    p.wp[IX_VT] = (unsigned char*)d_ws + WS_VT;
    p.wp[IX_WD0] = (unsigned char*)d_ws + WS_WD0;
    p.wp[IX_WD1] = (unsigned char*)d_ws + WS_WD1;
    p.wp[IX_WGU0] = (unsigned char*)d_ws + WS_WGU0;
    p.wp[IX_WGU1] = (unsigned char*)d_ws + WS_WGU1;
    p.wp[IX_WIN0] = (unsigned char*)d_ws + WS_WIN0;
    p.wp[IX_WIN1] = (unsigned char*)d_ws + WS_WIN1;
    p.wp[IX_WOUT0] = (unsigned char*)d_ws + WS_WOUT0;
    p.wp[IX_WOUT1] = (unsigned char*)d_ws + WS_WOUT1;
    p.wp[IX_XB] = (unsigned char*)d_ws + WS_XB;
    p.wp[IX_Y] = (unsigned char*)d_ws + WS_Y;
    for (int j = 0; j < 16; ++j) p.inv[j] = pow(500000.0, -(double)j / 16.0);
    hipLaunchKernelGGL(fwd_kernel, dim3(grid), dim3(512), LDS_BYTES, stream, p);
    const hipError_t le = hipPeekAtLastError();
    if (le != hipSuccess) fprintf(stderr, "kernel_launch: launch failed: %s\n", hipGetErrorName(le));
}
```

```cpp
#include <hip/hip_runtime.h>
#include <cstdio>
#include <cstdint>
#include <cmath>

#define LAS __attribute__((address_space(3)))
typedef unsigned short bf16_t;
typedef float f32x4 __attribute__((ext_vector_type(4)));
typedef float f32x2 __attribute__((ext_vector_type(2)));
typedef __bf16 bf16x2_t __attribute__((ext_vector_type(2)));
typedef unsigned u32x4 __attribute__((ext_vector_type(4)));
typedef unsigned u32x2 __attribute__((ext_vector_type(2)));

constexpr int NB = 8, T = 2048, D = 2048, M = NB * T;
constexpr int EVW = 8192, ODW = 6144, NE = 16, DFF = 1024;
constexpr int LD0 = EVW + 64, LD1 = ODW + 64, VTLD = M + 64;
constexpr int PMAX = 2 * M + NE * 256;
constexpr float EPS = 1e-6f;
constexpr float LAM_INIT = 0.35550906759f;

constexpr size_t MiB = 1u << 20;
constexpr size_t WS_CTL = 0, CTL_BYTES = 1 * MiB;
constexpr size_t WS_MOD = 1 * MiB;
constexpr size_t WS_ROPE = 2 * MiB;
constexpr size_t WS_TOK = 3 * MiB;
constexpr size_t WS_LIST = 4 * MiB;
constexpr size_t WS_LW = 5 * MiB;
constexpr size_t WS_XB = 8 * MiB;
constexpr size_t WS_ACT = 136 * MiB;
constexpr size_t WS_PROJ = 200 * MiB;
constexpr size_t WS_HID = WS_PROJ, WS_Y = WS_PROJ + 72 * MiB;
constexpr size_t WS_W = 464 * MiB;
constexpr size_t WS_WIN0 = WS_W, WS_WOUT0 = WS_WIN0 + 32 * MiB, WS_WGU0 = WS_WOUT0 + 8 * MiB, WS_WD0 = WS_WGU0 + 128 * MiB;
constexpr size_t WS_WIN1 = WS_WD0 + 64 * MiB, WS_WOUT1 = WS_WIN1 + 24 * MiB, WS_WGU1 = WS_WOUT1 + 8 * MiB, WS_WD1 = WS_WGU1 + 128 * MiB;
constexpr size_t WS_VT = WS_WD1 + 64 * MiB;
constexpr size_t WS_O1 = WS_WD1 + 64 * MiB;
constexpr size_t WS_END = WS_O1 + 128 * MiB;
constexpr int CW_BAR = 4096, CW_CNT = 8192, CW_NAQ = 8448, CW_FLG = 12288;
constexpr int LDS_BYTES = 163840;
constexpr int LDS_BASE_OFF = 131072 + 1024;
constexpr int LDS_UCNT_OFF = LDS_BASE_OFF + 128;

#define XB_TMO      128
#define XB_XCNT(j)  (256  + 64 * (j))
#define XB_XSUB(j)  (1280 + 64 * (j))
#define XB_XGEN(j)  (2304 + 64 * (j))
#define XB_TOP      3328
#define XB_TOPGEN   3392
#define XCD_BAR_WORDS 3456
#define XB_SPIN_CAP (1u << 20)
__device__ __forceinline__ unsigned xb_ld(unsigned* p)              { return __hip_atomic_load(p, __ATOMIC_RELAXED, __HIP_MEMORY_SCOPE_AGENT); }
__device__ __forceinline__ unsigned xb_add(unsigned* p, unsigned v) { return __hip_atomic_fetch_add(p, v, __ATOMIC_RELAXED, __HIP_MEMORY_SCOPE_AGENT); }
__device__ __forceinline__ unsigned xb_xcc_id() { return (unsigned)__builtin_amdgcn_s_getreg((3 << 11) | 20) & 0xFu; }
#define XB_SPIN(cond, bar) do { unsigned _sp = 0; while (cond) { __builtin_amdgcn_s_sleep(1); \
    if ((++_sp & 255u) == 0u) { if (xb_ld(&(bar)[XB_TMO])) break; if (_sp > XB_SPIN_CAP) { atomicAdd(&(bar)[XB_TMO], 1u); break; } } } } while (0)
struct XcdBarrier { unsigned* bar; unsigned x; volatile LAS unsigned* st; };
__device__ __forceinline__ XcdBarrier xcd_barrier_post(unsigned* bar, volatile LAS unsigned* st) {
    XcdBarrier b; b.bar = bar; b.x = xb_xcc_id(); b.st = st;
    if (threadIdx.x == 0) (void)xb_add(&bar[XB_XCNT(b.x)], 1u);
    return b;
}
__device__ __forceinline__ void xcd_barrier_complete(unsigned* bar, unsigned x, unsigned& nloc, unsigned& nx) {
    const unsigned G = gridDim.x * gridDim.y * gridDim.z;
    unsigned sum, cnt, mine, sp = 0u;
    for (;;) {
        sum = 0u; cnt = 0u; mine = 0u;
#pragma unroll
        for (unsigned j = 0; j < 16; ++j) { const unsigned c = xb_ld(&bar[XB_XCNT(j)]); sum += c; cnt += (c > 0u) ? 1u : 0u; mine = (j == x) ? c : mine; }
        if (sum == G) break;
        __builtin_amdgcn_s_sleep(1);
        if ((++sp & 255u) == 0u) { if (xb_ld(&bar[XB_TMO])) break; if (sp > XB_SPIN_CAP) { atomicAdd(&bar[XB_TMO], 1u); break; } }
    }
    nloc = mine > 0u ? mine : 1u; nx = cnt > 0u ? cnt : 1u;
}
__device__ __forceinline__ void xcd_barrier(const XcdBarrier& b) {
    asm volatile("s_waitcnt vmcnt(0)" ::: "memory");
    __syncthreads();
    if (threadIdx.x == 0) {
        unsigned* bar = b.bar;
        __builtin_amdgcn_s_waitcnt(0);
        unsigned nloc = b.st[0], nx = b.st[1];
        if (nloc == 0u) { xcd_barrier_complete(bar, b.x, nloc, nx); b.st[0] = nloc; b.st[1] = nx; }
        const unsigned old = xb_add(&bar[XB_XSUB(b.x)], 1u);
        const unsigned gen = old / nloc;
        if (old + 1u == (gen + 1u) * nloc) {
            __builtin_amdgcn_fence(__ATOMIC_RELEASE, "agent");
            asm volatile("s_waitcnt vmcnt(0)" ::: "memory");
            const unsigned og = xb_add(&bar[XB_TOP], 1u);
            const unsigned tg = og / nx;
            if (og + 1u == (tg + 1u) * nx) xb_add(&bar[XB_TOPGEN], 1u);
            else XB_SPIN(xb_ld(&bar[XB_TOPGEN]) == tg, bar);
            __builtin_amdgcn_fence(__ATOMIC_ACQUIRE, "agent");
            xb_add(&bar[XB_XGEN(b.x)], 1u);
            asm volatile("s_waitcnt vmcnt(0)" ::: "memory");
        } else {
            XB_SPIN(xb_ld(&bar[XB_XGEN(b.x)]) == gen, bar);
            __builtin_amdgcn_fence(__ATOMIC_ACQUIRE, "agent");
            asm volatile("s_waitcnt vmcnt(0)" ::: "memory");
        }
    }
    __syncthreads();
}

__device__ __forceinline__ int opaque_tid() { int t = threadIdx.x; asm volatile("" : "+v"(t)); return t; }
__device__ __forceinline__ float bf2f(bf16_t v) { return __uint_as_float((unsigned)v << 16); }
__device__ __forceinline__ unsigned pk2(float a, float b) { f32x2 v = {a, b}; bf16x2_t r = __builtin_convertvector(v, bf16x2_t); return __builtin_bit_cast(unsigned, r); }
__device__ __forceinline__ bf16_t f2bf(float a) { return (bf16_t)(pk2(a, 0.f) & 0xffffu); }
__device__ __forceinline__ float frcp(float x) { return __builtin_amdgcn_rcpf(x); }
__device__ __forceinline__ float sigm(float x) { return frcp(1.f + __expf(-x)); }
__device__ __forceinline__ float silu(float x) { return x * frcp(1.f + __expf(-x)); }
constexpr bool OUT_F8 = true;
constexpr float F8_SM = 8.f;
constexpr float F8_SA = 16.f, F8_SW = 256.f, F8_SH = 8.f, F8_SWD = 256.f;
__device__ __forceinline__ unsigned pk4_fp8(float a, float b, float c, float d) { unsigned w = 0u; w = __builtin_amdgcn_cvt_pk_fp8_f32(a, b, w, false); w = __builtin_amdgcn_cvt_pk_fp8_f32(c, d, w, true); return w; }
__device__ __forceinline__ float wave_sum(float v) {
#pragma unroll
    for (int o = 1; o < 64; o <<= 1) v += __shfl_xor(v, o);
    return v;
}
__device__ __forceinline__ float wave_max(float v) {
#pragma unroll
    for (int o = 1; o < 64; o <<= 1) v = fmaxf(v, __shfl_xor(v, o));
    return v;
}

enum WsIx { IX_ACT, IX_CTL, IX_HID, IX_LIST, IX_LW, IX_MOD, IX_O1, IX_PROJ, IX_ROPE, IX_TOK, IX_VT, IX_WD0, IX_WD1, IX_WGU0, IX_WGU1, IX_WIN0, IX_WIN1, IX_WOUT0, IX_WOUT1, IX_XB, IX_Y, IX_N };
struct Params {
    const float* in[28];
    float* out;
    unsigned char* wp[IX_N];
    double inv[16];
};

__device__ __forceinline__ void phase_mod(const Params& p, LAS unsigned char* lds) {
    LAS float* cact = (LAS float*)lds;
    LAS float* red = (LAS float*)(lds + 65536);
    const int tid = opaque_tid(), wave = tid >> 6, lane = tid & 63;
    const float* c = p.in[1];
    float* mod = (float*)(p.wp[IX_MOD]);
    for (int i = tid; i < 8 * 2048; i += 512) { const int b = i / 2048, k = i % 2048; cact[k * 8 + b] = silu(c[i]); }
    __syncthreads();
    for (int u = blockIdx.x; u < 192; u += gridDim.x) {
        const int l = u / 96, cb = u % 96;
        const float* W = p.in[l ? 14 : 3]; const float* bias = p.in[l ? 15 : 4];
        float acc[8][2];
#pragma unroll
        for (int b = 0; b < 8; ++b) { acc[b][0] = 0.f; acc[b][1] = 0.f; }
        const float* wp = W + (size_t)(wave * 256) * 12288 + cb * 128 + 2 * lane;
#pragma unroll 16
        for (int k = 0; k < 256; ++k) {
            const f32x2 w = __builtin_nontemporal_load((const f32x2*)(wp + (size_t)k * 12288));
            const f32x4 c0 = *(LAS f32x4*)(cact + (wave * 256 + k) * 8), c1 = *(LAS f32x4*)(cact + (wave * 256 + k) * 8 + 4);
            acc[0][0] += c0.x * w.x; acc[0][1] += c0.x * w.y; acc[1][0] += c0.y * w.x; acc[1][1] += c0.y * w.y;
            acc[2][0] += c0.z * w.x; acc[2][1] += c0.z * w.y; acc[3][0] += c0.w * w.x; acc[3][1] += c0.w * w.y;
            acc[4][0] += c1.x * w.x; acc[4][1] += c1.x * w.y; acc[5][0] += c1.y * w.x; acc[5][1] += c1.y * w.y;
            acc[6][0] += c1.z * w.x; acc[6][1] += c1.z * w.y; acc[7][0] += c1.w * w.x; acc[7][1] += c1.w * w.y;
        }
#pragma unroll
        for (int b = 0; b < 8; ++b) { red[(wave * 8 + b) * 128 + 2 * lane] = acc[b][0]; red[(wave * 8 + b) * 128 + 2 * lane + 1] = acc[b][1]; }
        __syncthreads();
        for (int o = tid; o < 1024; o += 512) {
            const int b = o / 128, j = o % 128; float s = 0.f;
#pragma unroll
            for (int w = 0; w < 8; ++w) s += red[(w * 8 + b) * 128 + j];
            mod[(size_t)(l * 8 + b) * 12288 + cb * 128 + j] = s + bias[cb * 128 + j];
        }
        __syncthreads();
    }
    float* rc = (float*)(p.wp[IX_ROPE]); float* rs = rc + 2048 * 16;
    for (int i = blockIdx.x * 512 + tid; i < 2048 * 16; i += gridDim.x * 512) {
        const int pos = i / 16, j = i % 16;
        const double ang = (double)pos * p.inv[j];
        const double n = rint(ang * 0.15915494309189535);
        double r = fma(-n, 6.283185307179586, ang); r = fma(-n, 2.4492935982947064e-16, r);
        rc[i] = cosf((float)r); rs[i] = sinf((float)r);
    }
}

__device__ __forceinline__ void compute_base(const unsigned* cnt, LAS int* base) {
    if (threadIdx.x == 0) { int s = 0; for (int e = 0; e < NE; ++e) { base[e] = s; s += ((int)cnt[e] + 255) / 256 * 256; } base[NE] = s; *(LAS unsigned*)((LAS unsigned char*)base + 128) = 0u; }
    __syncthreads();
}
template <bool COMBINE, bool ROUTE, bool FINAL, bool OUT8 = false, bool DUMMY = false>
__device__ __forceinline__ void phase_rows(const Params& p, LAS unsigned char* lds, const float* xin, float* xnew, const float* g, const float* modl  ,
                                           int sh_off, int sc_off, const float* modprev  , bf16_t* hout, float* fout,
                                           const unsigned* cnt_prev, unsigned* cnt_cur, const bf16_t* mres = nullptr  ) {
    const int tid = opaque_tid(), wave = tid >> 6, lane = tid & 63;
    LAS int* base = (LAS int*)(lds + LDS_BASE_OFF);
    if (COMBINE) compute_base(cnt_prev, base);
    const int* tok_e = (const int*)(p.wp[IX_TOK]); const int* tok_pos = tok_e + 2 * M;
    int* tok_e_w = DUMMY ? (int*)(p.wp[IX_Y] + 4 * MiB) : (int*)(p.wp[IX_TOK]); int* tok_pos_w = tok_e_w + 2 * M;
    const bf16_t* Y = (const bf16_t*)(p.wp[IX_Y]);
    int* list = DUMMY ? (int*)(p.wp[IX_Y]) : (int*)(p.wp[IX_LIST]); float* lw = DUMMY ? (float*)(p.wp[IX_Y] + 2 * MiB) : (float*)(p.wp[IX_LW]);
    const float* rw = p.in[25]; const float* rb = p.in[26];
    LAS f32x4* WT = (LAS f32x4*)lds;
    LAS unsigned* rt_cnt = (LAS unsigned*)(lds + 131072 + 2048);
    LAS int* rt_sel = (LAS int*)(lds + 131072 + 4096);
    int rslot = 0;
    if (ROUTE) { if (tid < 32) rt_cnt[tid] = 0u;
        for (int i = tid; i < 8192; i += 512) { const int k = i >> 2, eg = i & 3; WT[(((k >> 8) * 4 + (k & 3)) * 4 + eg) * 64 + ((k & 255) >> 2)] = *(const f32x4*)(rw + k * 16 + eg * 4); }
        __syncthreads(); }
    for (int m = blockIdx.x * 8 + wave; m < M; m += gridDim.x * 8) {
        const int b = m / T;
        f32x4 xv[8];
#pragma unroll
        for (int j = 0; j < 8; ++j) xv[j] = *(const f32x4*)(xin + (size_t)m * D + 4 * lane + 256 * j);
        if (mres) { const float* gta = modl + (size_t)b * 12288 + 2 * D;
#pragma unroll
            for (int j = 0; j < 8; ++j) { const int c = 4 * lane + 256 * j; const u32x2 mm = *(const u32x2*)(mres + (size_t)m * D + c); const f32x4 gv = *(const f32x4*)(gta + c);
                xv[j].x += gv.x * __uint_as_float(mm.x << 16); xv[j].y += gv.y * __uint_as_float(mm.x & 0xffff0000u); xv[j].z += gv.z * __uint_as_float(mm.y << 16); xv[j].w += gv.w * __uint_as_float(mm.y & 0xffff0000u); } }
        if (COMBINE) {
            const int e0 = tok_e[2 * m], e1 = tok_e[2 * m + 1];
            const size_t r0 = (size_t)(base[e0] + tok_pos[2 * m]), r1 = (size_t)(base[e1] + tok_pos[2 * m + 1]);
            const float* gt = modprev + (size_t)b * 12288 + 5 * D;
#pragma unroll
            for (int j = 0; j < 8; ++j) {
                const int c = 4 * lane + 256 * j;
                const u32x2 a = *(const u32x2*)(Y + r0 * D + c), bb = *(const u32x2*)(Y + r1 * D + c);
                const f32x4 gv = *(const f32x4*)(gt + c);
                xv[j].x += gv.x * (__uint_as_float(a.x << 16) + __uint_as_float(bb.x << 16));
                xv[j].y += gv.y * (__uint_as_float(a.x & 0xffff0000u) + __uint_as_float(bb.x & 0xffff0000u));
                xv[j].z += gv.z * (__uint_as_float(a.y << 16) + __uint_as_float(bb.y << 16));
                xv[j].w += gv.w * (__uint_as_float(a.y & 0xffff0000u) + __uint_as_float(bb.y & 0xffff0000u));
                if (!FINAL) *(f32x4*)(xnew + (size_t)m * D + c) = xv[j];
            }
        }
        float ss = 0.f;
#pragma unroll
        for (int j = 0; j < 8; ++j) ss += xv[j].x * xv[j].x + xv[j].y * xv[j].y + xv[j].z * xv[j].z + xv[j].w * xv[j].w;
        ss = wave_sum(ss);
        const float rstd = 1.0f / sqrtf(ss * (1.f / D) + EPS);
        if (FINAL) {
#pragma unroll
            for (int j = 0; j < 8; ++j) { const int c = 4 * lane + 256 * j; const f32x4 gv = *(const f32x4*)(g + c); *(f32x4*)(fout + (size_t)m * D + c) = xv[j] * rstd * gv; }
        } else {
            const float* sh = modl + (size_t)b * 12288 + sh_off; const float* sc = modl + (size_t)b * 12288 + sc_off;
#pragma unroll
            for (int j = 0; j < 8; ++j) {
                const int c = 4 * lane + 256 * j;
                const f32x4 gv = *(const f32x4*)(g + c), shv = *(const f32x4*)(sh + c), scv = *(const f32x4*)(sc + c);
                xv[j] = xv[j] * rstd * gv * (1.f + scv) + shv;
                if (OUT8) *(unsigned*)((unsigned char*)hout + (size_t)m * D + c) = pk4_fp8(xv[j].x * F8_SA, xv[j].y * F8_SA, xv[j].z * F8_SA, xv[j].w * F8_SA);
                else { u32x2 o; o.x = pk2(xv[j].x, xv[j].y); o.y = pk2(xv[j].z, xv[j].w); *(u32x2*)(hout + (size_t)m * D + c) = o; }
            }
            if (ROUTE) {
                float lg[16];
#pragma unroll
                for (int e = 0; e < 16; ++e) lg[e] = 0.f;
#pragma unroll
                for (int j = 0; j < 8; ++j) {
#pragma unroll
                    for (int cc = 0; cc < 4; ++cc) {
                        const float hv = xv[j][cc];
                        const f32x4 w0 = WT[((j * 4 + cc) * 4 + 0) * 64 + lane], w1 = WT[((j * 4 + cc) * 4 + 1) * 64 + lane], w2 = WT[((j * 4 + cc) * 4 + 2) * 64 + lane], w3 = WT[((j * 4 + cc) * 4 + 3) * 64 + lane];
                        lg[0] += hv * w0.x; lg[1] += hv * w0.y; lg[2] += hv * w0.z; lg[3] += hv * w0.w;
                        lg[4] += hv * w1.x; lg[5] += hv * w1.y; lg[6] += hv * w1.z; lg[7] += hv * w1.w;
                        lg[8] += hv * w2.x; lg[9] += hv * w2.y; lg[10] += hv * w2.z; lg[11] += hv * w2.w;
                        lg[12] += hv * w3.x; lg[13] += hv * w3.y; lg[14] += hv * w3.z; lg[15] += hv * w3.w;
                    }
                    __builtin_amdgcn_sched_barrier(0);
                }
                float sc_[16], sel[16];
#pragma unroll
                for (int e = 0; e < 16; ++e) { lg[e] = wave_sum(lg[e]); sc_[e] = 1.f / (1.f + expf(-lg[e])); sel[e] = sc_[e] + rb[e]; }
                float gsv[4], gw1[4], gw2[4]; int gi1[4], gi2[4];
#pragma unroll
                for (int gq = 0; gq < 4; ++gq) {
                    float m1 = sel[4 * gq]; int i1 = 0; float s1 = sc_[4 * gq];
#pragma unroll
                    for (int i = 1; i < 4; ++i) if (sel[4 * gq + i] > m1) { m1 = sel[4 * gq + i]; i1 = i; s1 = sc_[4 * gq + i]; }
                    float m2 = -INFINITY; int i2 = 0; float s2 = 0.f;
#pragma unroll
                    for (int i = 0; i < 4; ++i) if (i != i1 && sel[4 * gq + i] > m2) { m2 = sel[4 * gq + i]; i2 = i; s2 = sc_[4 * gq + i]; }
                    gsv[gq] = m1 + m2; gi1[gq] = 4 * gq + i1; gi2[gq] = 4 * gq + i2; gw1[gq] = s1; gw2[gq] = s2;
                }
                float bv = gsv[0]; int e0 = gi1[0], e1 = gi2[0]; float w0 = gw1[0], w1 = gw2[0];
#pragma unroll
                for (int gq = 1; gq < 4; ++gq) if (gsv[gq] > bv) { bv = gsv[gq]; e0 = gi1[gq]; e1 = gi2[gq]; w0 = gw1[gq]; w1 = gw2[gq]; }
                const float wsum = w0 + w1; w0 /= wsum; w1 /= wsum;
                if (lane == 0) {
                    const int k = rslot++;
                    const int l0 = (int)__hip_atomic_fetch_add(rt_cnt + e0, 1u, __ATOMIC_RELAXED, __HIP_MEMORY_SCOPE_WORKGROUP), l1 = (int)__hip_atomic_fetch_add(rt_cnt + e1, 1u, __ATOMIC_RELAXED, __HIP_MEMORY_SCOPE_WORKGROUP);
                    LAS int* rr = rt_sel + (k * 8 + wave) * 8;
                    rr[0] = m; rr[1] = e0; rr[2] = e1; rr[3] = l0; rr[4] = l1; ((LAS float*)rr)[5] = w0; ((LAS float*)rr)[6] = w1;
                }
            }
        }
    }
    if (ROUTE) {
        __syncthreads();
        if (tid < NE) rt_cnt[16 + tid] = atomicAdd(cnt_cur + tid, rt_cnt[tid]);
        __syncthreads();
        const int nrow = (M - (int)blockIdx.x * 8 + (int)gridDim.x * 8 - 1) / ((int)gridDim.x * 8);
        for (int i = tid; i < nrow * 8; i += 512) {
            const LAS int* rr = rt_sel + i * 8; const int m = rr[0], e0 = rr[1], e1 = rr[2];
            const int p0 = (int)rt_cnt[16 + e0] + rr[3], p1 = (int)rt_cnt[16 + e1] + rr[4];
            list[e0 * M + p0] = m; lw[e0 * M + p0] = ((const LAS float*)rr)[5]; list[e1 * M + p1] = m; lw[e1 * M + p1] = ((const LAS float*)rr)[6];
            tok_e_w[2 * m] = e0; tok_e_w[2 * m + 1] = e1; tok_pos_w[2 * m] = p0; tok_pos_w[2 * m + 1] = p1;
        }
    }
}

__device__ __forceinline__ void hgrn_combine(const Params& p) {
    const bf16_t* proj = (const bf16_t*)(p.wp[IX_PROJ]);
    const bf16_t* oscr = (const bf16_t*)(p.wp[IX_XB]);
    unsigned char* mix8 = p.wp[IX_ACT]; bf16_t* mix = (bf16_t*)(p.wp[IX_ACT]);
    const float* ng = p.in[6];
    const int tid_ = opaque_tid(), wave = tid_ >> 6, lane = tid_ & 63, c = 16 * lane;
    f32x4 gn[4];
#pragma unroll
    for (int q = 0; q < 4; ++q) gn[q] = *(const f32x4*)(ng + c + 4 * q);
    const int stride = gridDim.x * 8;
    u32x4 na[2][2], nb[2][2], ng_[2][2];
#define HC_LOAD(r0_) do { _Pragma("unroll") for (int r = 0; r < 2; ++r) { const int rw = ((r0_) + r * stride < M) ? (r0_) + r * stride : (r0_); \
        _Pragma("unroll") for (int hq = 0; hq < 2; ++hq) { na[r][hq] = *(const u32x4*)(oscr + (size_t)rw * 1024 + c + 8 * hq); nb[r][hq] = *(const u32x4*)(oscr + ((size_t)M + rw) * 1024 + c + 8 * hq); \
            ng_[r][hq] = *(const u32x4*)(proj + (size_t)rw * LD0 + 4096 + c + 8 * hq); } } } while (0)
    int row = blockIdx.x * 8 + wave;
    if (row < M) HC_LOAD(row);
    for (; row < M; row += 2 * stride) {
        u32x4 a[2][2], bb[2][2], gg[2][2];
#pragma unroll
        for (int r = 0; r < 2; ++r)
#pragma unroll
            for (int hq = 0; hq < 2; ++hq) { a[r][hq] = na[r][hq]; bb[r][hq] = nb[r][hq]; gg[r][hq] = ng_[r][hq]; }
        if (row + 2 * stride < M) HC_LOAD(row + 2 * stride);
#pragma unroll
        for (int r = 0; r < 2; ++r) { const int rw = row + r * stride; if (rw >= M) break;
            float o[16]; float ss = 0.f;
#pragma unroll
            for (int hq = 0; hq < 2; ++hq)
#pragma unroll
                for (int k = 0; k < 4; ++k) { const unsigned x = a[r][hq][k], y = bb[r][hq][k];
                    const float v0 = __uint_as_float(x << 16) + __uint_as_float(y << 16), v1 = __uint_as_float(x & 0xffff0000u) + __uint_as_float(y & 0xffff0000u);
                    o[8 * hq + 2 * k] = v0; o[8 * hq + 2 * k + 1] = v1; ss += v0 * v0 + v1 * v1; }
            ss += __shfl_xor(ss, 1); ss += __shfl_xor(ss, 2); ss += __shfl_xor(ss, 4);
            const float rstd = 1.0f / sqrtf(ss * (1.f / 128.f) + EPS);
            float res[16];
#pragma unroll
            for (int hq = 0; hq < 2; ++hq)
#pragma unroll
                for (int k = 0; k < 4; ++k) { const unsigned g = gg[r][hq][k]; const int i0 = 8 * hq + 2 * k;
                    res[i0] = o[i0] * rstd * gn[i0 >> 2][i0 & 3] * silu(__uint_as_float(g << 16)); res[i0 + 1] = o[i0 + 1] * rstd * gn[(i0 + 1) >> 2][(i0 + 1) & 3] * silu(__uint_as_float(g & 0xffff0000u)); }
            if (OUT_F8) { u32x4 w; w.x = pk4_fp8(res[0] * F8_SM, res[1] * F8_SM, res[2] * F8_SM, res[3] * F8_SM); w.y = pk4_fp8(res[4] * F8_SM, res[5] * F8_SM, res[6] * F8_SM, res[7] * F8_SM);
                w.z = pk4_fp8(res[8] * F8_SM, res[9] * F8_SM, res[10] * F8_SM, res[11] * F8_SM); w.w = pk4_fp8(res[12] * F8_SM, res[13] * F8_SM, res[14] * F8_SM, res[15] * F8_SM);
                *(u32x4*)(mix8 + (size_t)rw * D + c) = w; }
            else { u32x4 w0, w1; w0.x = pk2(res[0], res[1]); w0.y = pk2(res[2], res[3]); w0.z = pk2(res[4], res[5]); w0.w = pk2(res[6], res[7]);
                w1.x = pk2(res[8], res[9]); w1.y = pk2(res[10], res[11]); w1.z = pk2(res[12], res[13]); w1.w = pk2(res[14], res[15]);
                *(u32x4*)(mix + (size_t)rw * D + c) = w0; *(u32x4*)(mix + (size_t)rw * D + c + 8) = w1; }
        }
    }
#undef HC_LOAD
}
__device__ __forceinline__ void rope_pass(const Params& p) {
    bf16_t* proj = (bf16_t*)(p.wp[IX_PROJ]);
    const float* rc = (const float*)(p.wp[IX_ROPE]); const float* rs = rc + 2048 * 16;
    for (size_t i = (size_t)blockIdx.x * 512 + opaque_tid(); i < (size_t)M * 32 * 16; i += (size_t)gridDim.x * 512) {
        const int j = (int)(i & 15), hh = (int)((i >> 4) & 31); const size_t row = i >> 9; const int pos = (int)(row % T);
        bf16_t* a = proj + row * LD1 + hh * 128 + j;
        const float x1 = bf2f(a[0]), x2 = bf2f(a[16]), cc = rc[pos * 16 + j], sn = rs[pos * 16 + j];
        a[0] = f2bf(x1 * cc - x2 * sn); a[16] = f2bf(x1 * sn + x2 * cc);
    }
}
template <bool FINAL, bool OUT8>
__device__ __forceinline__ void phase_combine(const Params& p, LAS unsigned char* lds, const float* xin, float* xnew, const float* g, const float* modl, const float* modprev, bf16_t* hout, float* fout, const unsigned* cnt_prev, const bf16_t* mres) {
    const int tid = opaque_tid(), wave = tid >> 6, lane = tid & 63;
    LAS int* base = (LAS int*)(lds + LDS_BASE_OFF);
    compute_base(cnt_prev, base);
    const int* tok_e = (const int*)(p.wp[IX_TOK]); const int* tok_pos = tok_e + 2 * M;
    const bf16_t* Y = (const bf16_t*)(p.wp[IX_Y]);
    const int stride = gridDim.x * 8;
    int m = blockIdx.x * 8 + wave;
    f32x4 xn[8]; u32x2 mn_[8]; int en0 = 0, en1 = 0, pn0 = 0, pn1 = 0;
    if (m < M) {
#pragma unroll
        for (int j = 0; j < 8; ++j) { xn[j] = *(const f32x4*)(xin + (size_t)m * D + 4 * lane + 256 * j); mn_[j] = *(const u32x2*)(mres + (size_t)m * D + 4 * lane + 256 * j); }
        en0 = tok_e[2 * m]; en1 = tok_e[2 * m + 1]; pn0 = tok_pos[2 * m]; pn1 = tok_pos[2 * m + 1]; }
    for (; m < M; m += stride) {
        const int b = m / T;
        f32x4 xv[8]; u32x2 mv[8];
#pragma unroll
        for (int j = 0; j < 8; ++j) { xv[j] = xn[j]; mv[j] = mn_[j]; }
        const size_t r0 = (size_t)(base[en0] + pn0), r1 = (size_t)(base[en1] + pn1);
        u32x2 ya[8], yb[8];
#pragma unroll
        for (int j = 0; j < 8; ++j) { const int c = 4 * lane + 256 * j; ya[j] = *(const u32x2*)(Y + r0 * D + c); yb[j] = *(const u32x2*)(Y + r1 * D + c); }
        const int mn = m + stride;
        if (mn < M) {
#pragma unroll
            for (int j = 0; j < 8; ++j) { xn[j] = *(const f32x4*)(xin + (size_t)mn * D + 4 * lane + 256 * j); mn_[j] = *(const u32x2*)(mres + (size_t)mn * D + 4 * lane + 256 * j); }
            en0 = tok_e[2 * mn]; en1 = tok_e[2 * mn + 1]; pn0 = tok_pos[2 * mn]; pn1 = tok_pos[2 * mn + 1]; }
        const float* gt = modprev + (size_t)b * 12288 + 5 * D; const float* gta = modprev + (size_t)b * 12288 + 2 * D;
        float ss = 0.f;
#pragma unroll
        for (int j = 0; j < 8; ++j) { const int c = 4 * lane + 256 * j; const f32x4 gv = *(const f32x4*)(gt + c), ga = *(const f32x4*)(gta + c); const u32x2 a = ya[j], bb = yb[j], mm = mv[j];
            xv[j].x += ga.x * __uint_as_float(mm.x << 16); xv[j].y += ga.y * __uint_as_float(mm.x & 0xffff0000u); xv[j].z += ga.z * __uint_as_float(mm.y << 16); xv[j].w += ga.w * __uint_as_float(mm.y & 0xffff0000u);
            xv[j].x += gv.x * (__uint_as_float(a.x << 16) + __uint_as_float(bb.x << 16)); xv[j].y += gv.y * (__uint_as_float(a.x & 0xffff0000u) + __uint_as_float(bb.x & 0xffff0000u));
            xv[j].z += gv.z * (__uint_as_float(a.y << 16) + __uint_as_float(bb.y << 16)); xv[j].w += gv.w * (__uint_as_float(a.y & 0xffff0000u) + __uint_as_float(bb.y & 0xffff0000u));
            if (!FINAL) *(f32x4*)(xnew + (size_t)m * D + c) = xv[j];
            ss += xv[j].x * xv[j].x + xv[j].y * xv[j].y + xv[j].z * xv[j].z + xv[j].w * xv[j].w; }
        ss = wave_sum(ss);
        const float rstd = 1.0f / sqrtf(ss * (1.f / D) + EPS);
        if (FINAL) {
#pragma unroll
            for (int j = 0; j < 8; ++j) { const int c = 4 * lane + 256 * j; const f32x4 gv = *(const f32x4*)(g + c); *(f32x4*)(fout + (size_t)m * D + c) = xv[j] * rstd * gv; }
        } else {
            const float* sh = modl + (size_t)b * 12288; const float* sc = modl + (size_t)b * 12288 + D;
#pragma unroll
            for (int j = 0; j < 8; ++j) { const int c = 4 * lane + 256 * j;
                const f32x4 gv = *(const f32x4*)(g + c), shv = *(const f32x4*)(sh + c), scv = *(const f32x4*)(sc + c);
                const f32x4 hv = xv[j] * rstd * gv * (1.f + scv) + shv;
                if (OUT8) *(unsigned*)((unsigned char*)hout + (size_t)m * D + c) = pk4_fp8(hv.x * F8_SA, hv.y * F8_SA, hv.z * F8_SA, hv.w * F8_SA);
                else { u32x2 o; o.x = pk2(hv.x, hv.y); o.y = pk2(hv.z, hv.w); *(u32x2*)(hout + (size_t)m * D + c) = o; } }
        }
    }
}

__device__ __forceinline__ void conv_item(const float* W, int K, int N, bf16_t* WT, int k0, int n0, int drow0, LAS unsigned* scr, int lane, bool rperm = false) {
    const int q = lane >> 4, n4 = lane & 15;
    f32x4 va[8], vb[8];
#pragma unroll
    for (int i = 0; i < 8; ++i) { const int rp = 4 * i + q;
        va[i] = *(const f32x4*)(W + (size_t)(k0 + 2 * rp) * N + n0 + 4 * n4); vb[i] = *(const f32x4*)(W + (size_t)(k0 + 2 * rp + 1) * N + n0 + 4 * n4); }
#pragma unroll
    for (int i = 0; i < 8; ++i) { const int rp = 4 * i + q; LAS unsigned* sp = scr + (4 * n4) * 33 + rp;
        sp[0] = pk2(va[i].x, vb[i].x); sp[33] = pk2(va[i].y, vb[i].y); sp[66] = pk2(va[i].z, vb[i].z); sp[99] = pk2(va[i].w, vb[i].w); }
    asm volatile("s_waitcnt lgkmcnt(0)" ::: "memory");
    const int c = lane & 7;
#pragma unroll
    for (int j = 0; j < 8; ++j) {
        const int n = (lane >> 3) + 8 * j; const LAS unsigned* sp = scr + n * 33 + 4 * c;
        u32x4 o; o.x = sp[0]; o.y = sp[1]; o.z = sp[2]; o.w = sp[3];
        const int nr = (rperm && n < 32) ? ((n < 16) ? 2 * n : 2 * (n - 16) + 1) : n;
        *(u32x4*)(WT + (size_t)(drow0 + nr) * K + k0 + 8 * c) = o;
    }
    asm volatile("s_waitcnt lgkmcnt(0)" ::: "memory");
}
__device__ __forceinline__ void conv_item8(const float* W, int K, int N, unsigned char* WT, int k0, int n0, int drow0, LAS unsigned* scr, int lane, float sc, bool rperm = false) {
    const int q = lane >> 4, n4 = lane & 15;
    f32x4 v[4][4];
#pragma unroll
    for (int i = 0; i < 4; ++i)
#pragma unroll
        for (int t = 0; t < 4; ++t) v[i][t] = __builtin_nontemporal_load((const f32x4*)(W + (size_t)(k0 + 4 * (4 * i + q) + t) * N + n0 + 4 * n4));
#pragma unroll
    for (int i = 0; i < 4; ++i) { const int rp = 4 * i + q; LAS unsigned* sp = scr + (4 * n4) * 17 + rp;
        sp[0]  = pk4_fp8(v[i][0].x * sc, v[i][1].x * sc, v[i][2].x * sc, v[i][3].x * sc);
        sp[17] = pk4_fp8(v[i][0].y * sc, v[i][1].y * sc, v[i][2].y * sc, v[i][3].y * sc);
        sp[34] = pk4_fp8(v[i][0].z * sc, v[i][1].z * sc, v[i][2].z * sc, v[i][3].z * sc);
        sp[51] = pk4_fp8(v[i][0].w * sc, v[i][1].w * sc, v[i][2].w * sc, v[i][3].w * sc); }
    asm volatile("s_waitcnt lgkmcnt(0)" ::: "memory");
    const int c = lane & 3;
#pragma unroll
    for (int j = 0; j < 4; ++j) {
        const int n = (lane >> 2) + 16 * j; const LAS unsigned* sp = scr + n * 17 + 4 * c;
        u32x4 o; o.x = sp[0]; o.y = sp[1]; o.z = sp[2]; o.w = sp[3];
        const int nr = (rperm && n < 32) ? ((n < 16) ? 2 * n : 2 * (n - 16) + 1) : n;
        *(u32x4*)(WT + (size_t)(drow0 + nr) * K + k0 + 16 * c) = o;
    }
    asm volatile("s_waitcnt lgkmcnt(0)" ::: "memory");
}
namespace cv {
constexpr int I_IN0 = 32 * 128, I_OUT = 32 * 32, I_G = 16 * 32 * 16, I_D = 16 * 16 * 32, I_IN1 = 32 * 96;
constexpr int I_L0 = I_IN0 + I_OUT + 2 * I_G + I_D, I_L1 = I_IN1 + I_OUT + 2 * I_G + I_D, NIT = I_L0 + I_L1;
constexpr int NIT_P0 = NIT - (2 * I_G + I_D);
}
__device__ __forceinline__ void conv_dispatch(const Params& p, int it, LAS unsigned* scr, int lane) {
    using namespace cv;
    int r = it; const int l = (r >= I_L0) ? 1 : 0; if (l) r -= I_L0;
    const int i_in = l ? I_IN1 : I_IN0;
    if (r < i_in) { const int N = l ? ODW : EVW, nb = N / 64;
        conv_item8(p.in[l ? 16 : 5], D, N, l ? p.wp[IX_WIN1] : p.wp[IX_WIN0], (r / nb) * 64, (r % nb) * 64, (r % nb) * 64, scr, lane, F8_SW, l == 1 && (r % nb) < 64 && ((r % nb) & 1) == 0);
        return; } r -= i_in;
    if (r < I_OUT) { if (OUT_F8) conv_item8(p.in[l ? 19 : 8], D, D, l ? p.wp[IX_WOUT1] : p.wp[IX_WOUT0], (r / 32) * 64, (r % 32) * 64, (r % 32) * 64, scr, lane, F8_SWD);
        else conv_item(p.in[l ? 19 : 8], D, D, (bf16_t*)(l ? p.wp[IX_WOUT1] : p.wp[IX_WOUT0]), (r / 32) * 64, (r % 32) * 64, (r % 32) * 64, scr, lane); return; } r -= I_OUT;
    if (r < 2 * I_G) { const int up = r >= I_G; if (up) r -= I_G; const int e = r / 512, rr = r % 512, kb = rr / 16, nb = rr % 16, n0 = nb * 64;
        conv_item8(p.in[(l ? 21 : 10) + up] + (size_t)e * D * DFF, D, DFF, (l ? p.wp[IX_WGU1] : p.wp[IX_WGU0]) + (size_t)e * 2048 * D, kb * 64, n0, (n0 >> 7) * 256 + (n0 & 127) + up * 128, scr, lane, F8_SW);
        return; } r -= 2 * I_G;
    { const int e = r / 512, rr = r % 512, kb = rr / 32, nb = rr % 32;
        conv_item8(p.in[l ? 23 : 12] + (size_t)e * DFF * D, DFF, D, (l ? p.wp[IX_WD1] : p.wp[IX_WD0]) + (size_t)e * D * DFF, kb * 64, nb * 64, nb * 64, scr, lane, F8_SWD); }
}
__device__ __forceinline__ void phase_convert(const Params& p, LAS unsigned char* lds) {
    const int tid_ = opaque_tid(), wave = tid_ >> 6, lane = tid_ & 63;
    LAS unsigned* scr = (LAS unsigned*)lds + wave * (64 * 33);
    constexpr int HEAD = 4096; const int nfree = (int)gridDim.x - 192;
    const int NIT = cv::NIT_P0, nhead = (nfree > 0) ? HEAD : 0;
    for (int pass = 0; pass < 2; ++pass)
    for (int it = (pass == 0) ? (((int)blockIdx.x - 192) * 8 + wave) : (nhead + (int)blockIdx.x * 8 + wave); (pass == 0) ? (nfree > 0 && (int)blockIdx.x >= 192 && it < nhead) : (it < NIT); it += ((pass == 0) ? nfree : (int)gridDim.x) * 8)
        conv_dispatch(p, it, scr, lane);
}
__device__ __forceinline__ void convert_late(const Params& p, LAS unsigned char* lds) {
    const int tid_ = opaque_tid(), wave = tid_ >> 6, lane = tid_ & 63;
    LAS unsigned* scr = (LAS unsigned*)lds + wave * (64 * 33);
    for (int it = cv::NIT_P0 + (int)blockIdx.x * 8 + wave; it < cv::NIT; it += (int)gridDim.x * 8) conv_dispatch(p, it, scr, lane);
    __syncthreads();
}
namespace pg8 {
typedef short bf16x8 __attribute__((ext_vector_type(8)));
typedef int v4i_t __attribute__((ext_vector_type(4)));
typedef int v8i_t __attribute__((ext_vector_type(8)));
constexpr int BM = 256, BK = 64, HALF = 128, HTB = HALF * BK * 2, STAGE_BYTES = 8 * HTB, NXCD = 8, WGM = 8;
__host__ __device__ __forceinline__ int lds_byte(int r, int c) { const int st = (r >> 4) * 2 + (c >> 5), rr = r & 15, cc = c & 31, ob = rr * 64 + cc * 2; return st * 1024 + (ob ^ (((ob >> 9) & 1) << 5)); }
__host__ __device__ __forceinline__ void stage_rc(int b, int& R, int& C) { const int st = b / 1024, sb = b % 1024, swz = sb ^ (((sb >> 9) & 1) << 5); R = (st >> 1) * 16 + swz / 64; C = (st & 1) * 32 + (swz % 64) / 2; }
__host__ __device__ __forceinline__ int perm32(int rho) { const int n = rho >> 4, i = rho & 15; return 8 * (i >> 2) + 4 * n + (i & 3); }
struct Unit { int pm, pn, e; };
struct StaticOrder {
    static constexpr bool GATHER = false, SIGF = false, WAITF = false;
    int nM, nN, nwg, G, c;
    __device__ void init(int M_, int N_, int G_, int c_) { nM = M_ / BM; nN = N_ / BM; nwg = nM * nN; G = G_; c = c_; }
    __device__ __forceinline__ bool next(int i, Unit& u) const {
        const long L = (long)i * G + c; if (L >= nwg) return false;
        int wgid = (int)L; { const int q = nwg / NXCD, r = nwg % NXCD, xcd = wgid % NXCD, off = wgid / NXCD; wgid = (xcd < r ? xcd * (q + 1) : r * (q + 1) + (xcd - r) * q) + off; }
        const int nig = WGM * nN, gid = wgid / nig, fm = gid * WGM, gsz = (nM - fm) < WGM ? (nM - fm) : WGM;
        u.pm = fm + ((wgid % nig) % gsz); u.pn = (wgid % nig) / gsz; u.e = 0; return true;
    }
    __device__ __forceinline__ size_t brow(const Unit& u) const { return (size_t)u.pn * BM; }
    __device__ __forceinline__ unsigned arow(const Unit&, int) const { return 0u; }
};
template <bool GATHER_, int TG = 0, bool SIGF_ = false, bool WAITF_ = false>
struct MoeOrder {
    static constexpr bool GATHER = GATHER_, SIGF = SIGF_, WAITF = WAITF_;
    const LAS int* base; const int* list; const unsigned* cnt; int G, c, nT; unsigned* flg;
    __device__ __forceinline__ bool next(int i, Unit& u) const {
        int pm, pn;
        if ((G & 63) == 0) { const int xcd = (c + (WAITF ? 3 : 0)) & 7, j = c >> 3, rt = G >> 6;
            const int nfull = nT / (8 * rt);
            if (i < nfull) pm = (i * 8 + xcd) * rt + (j >> 3);
            else { const int s = (i - nfull) * rt + (((j >> 3) + TG) % rt); pm = nfull * 8 * rt + s * 8 + xcd; }
            pn = j & 7; }
        else { const int L = i * G + c; pm = L >> 3; pn = L & 7; }
        if (pm >= nT) return false;
        u.pm = pm; u.pn = pn; int e = 0;
#pragma unroll
        for (int q = 1; q < NE; ++q) e += (pm * BM >= base[q]) ? 1 : 0;
        u.e = e; return true;
    }
    __device__ __forceinline__ void wait(const Unit& u) const {
        while (__hip_atomic_load(flg + u.pm, __ATOMIC_RELAXED, __HIP_MEMORY_SCOPE_AGENT) < 8u) __builtin_amdgcn_s_sleep(2);
        asm volatile("" ::: "memory");
    }
    __device__ __forceinline__ size_t brow(const Unit& u) const { return (size_t)u.e * 2048 + (size_t)u.pn * BM; }
    __device__ __forceinline__ unsigned arow(const Unit& u, int r) const { const int pos = u.pm * BM + r - base[u.e]; const unsigned t = (unsigned)list[u.e * M + pos]; return (pos < (int)cnt[u.e]) ? t : 0u; }
};

struct EpiBf16 { static constexpr bool PERM = true; bf16_t* O; int ldc; float sc = 1.f;
    __device__ __forceinline__ void operator()(const f32x4 (&acc)[2][2][4][2], const Unit& u, int wr, int wc, int fr, int fq) const {
        const int row0 = u.pm * BM + wr * 64 + fr, col0 = u.pn * BM + wc * 32 + 8 * fq;
#pragma unroll
        for (int ai = 0; ai < 2; ++ai)
#pragma unroll
            for (int m = 0; m < 4; ++m) { bf16_t* rowp = O + (size_t)(row0 + ai * HALF + m * 16) * ldc + col0;
#pragma unroll
                for (int bj = 0; bj < 2; ++bj) { const f32x4 v0 = acc[ai][bj][m][0] * sc, v1 = acc[ai][bj][m][1] * sc;
                    u32x4 w; w.x = pk2(v0[0], v0[1]); w.y = pk2(v0[2], v0[3]); w.z = pk2(v1[0], v1[1]); w.w = pk2(v1[2], v1[3]);
                    *(u32x4*)(rowp + bj * HALF) = w; } }
    }
};
struct EpiProj0 { static constexpr bool PERM = true; bf16_t* O; int ldc; float sc;
    __device__ __forceinline__ void operator()(const f32x4 (&acc)[2][2][4][2], const Unit& u, int wr, int wc, int fr, int fq) const {
        const int row0 = u.pm * BM + wr * 64 + fr, col0 = u.pn * BM + wc * 32 + 8 * fq; const int mode = (u.pn < 4 || (u.pn >= 16 && u.pn < 20)) ? 1 : ((u.pn >= 8 && u.pn < 16) ? 2 : 0);
#pragma unroll
        for (int ai = 0; ai < 2; ++ai)
#pragma unroll
            for (int m = 0; m < 4; ++m) { bf16_t* rowp = O + (size_t)(row0 + ai * HALF + m * 16) * ldc + col0;
#pragma unroll
                for (int bj = 0; bj < 2; ++bj) { f32x4 v0 = acc[ai][bj][m][0] * sc, v1 = acc[ai][bj][m][1] * sc;
                    if (mode == 1) {
#pragma unroll
                        for (int e = 0; e < 4; ++e) { v0[e] = silu(v0[e]); v1[e] = silu(v1[e]); } }
                    else if (mode == 2) {
#pragma unroll
                        for (int e = 0; e < 4; ++e) { v0[e] = frcp(1.f + __expf(v0[e])); v1[e] = frcp(1.f + __expf(v1[e])); } }
                    u32x4 w; w.x = pk2(v0[0], v0[1]); w.y = pk2(v0[2], v0[3]); w.z = pk2(v1[0], v1[1]); w.w = pk2(v1[2], v1[3]);
                    *(u32x4*)(rowp + bj * HALF) = w; } }
    }
};
struct EpiBf16Rope { static constexpr bool PERM = true; bf16_t* O; int ldc; const float* rc; const float* rs; float sc;
    __device__ __forceinline__ void operator()(const f32x4 (&acc)[2][2][4][2], const Unit& u, int wr, int wc, int fr, int fq) const {
        const int row0 = u.pm * BM + wr * 64 + fr, col0 = u.pn * BM + wc * 32 + 8 * fq; const bool rot = (u.pn < 16) && (wc == 0);
#pragma unroll
        for (int ai = 0; ai < 2; ++ai)
#pragma unroll
            for (int m = 0; m < 4; ++m) { const int row = row0 + ai * HALF + m * 16; bf16_t* rowp = O + (size_t)row * ldc + col0;
                f32x4 cv = {1.f, 1.f, 1.f, 1.f}, sv = {0.f, 0.f, 0.f, 0.f};
                if (rot) { const int pos = row & (T - 1); cv = *(const f32x4*)(rc + pos * 16 + 4 * fq); sv = *(const f32x4*)(rs + pos * 16 + 4 * fq); }
#pragma unroll
                for (int bj = 0; bj < 2; ++bj) { f32x4 v0 = acc[ai][bj][m][0] * sc, v1 = acc[ai][bj][m][1] * sc;
                    if (rot) { const f32x4 a = v0, b = v1;
                        v0[0] = a[0] * cv[0] - a[1] * sv[0]; v0[1] = a[0] * sv[0] + a[1] * cv[0]; v0[2] = a[2] * cv[1] - a[3] * sv[1]; v0[3] = a[2] * sv[1] + a[3] * cv[1];
                        v1[0] = b[0] * cv[2] - b[1] * sv[2]; v1[1] = b[0] * sv[2] + b[1] * cv[2]; v1[2] = b[2] * cv[3] - b[3] * sv[3]; v1[3] = b[2] * sv[3] + b[3] * cv[3]; }
                    u32x4 w; w.x = pk2(v0[0], v0[1]); w.y = pk2(v0[2], v0[3]); w.z = pk2(v1[0], v1[1]); w.w = pk2(v1[2], v1[3]);
                    *(u32x4*)(rowp + bj * HALF) = w; } }
    }
};
struct EpiResF32 { static constexpr bool PERM = false; const float* xin; float* xout; const float* gt; float sc = 1.f;
    __device__ __forceinline__ void operator()(const f32x4 (&acc)[2][2][4][2], const Unit& u, int wr, int wc, int fr, int fq) const {
        const int row0 = u.pm * BM + wr * 64 + fr, col0 = u.pn * BM + wc * 32 + 4 * fq; const int b = (u.pm * BM) / T;
        f32x4 gv[2][2];
#pragma unroll
        for (int bj = 0; bj < 2; ++bj)
#pragma unroll
            for (int n = 0; n < 2; ++n) gv[bj][n] = *(const f32x4*)(gt + (size_t)b * 12288 + col0 + bj * HALF + n * 16);
        f32x4 xi[2][2][2];
#pragma unroll
        for (int bj = 0; bj < 2; ++bj)
#pragma unroll
            for (int n = 0; n < 2; ++n) xi[0][bj][n] = *(const f32x4*)(xin + (size_t)row0 * D + col0 + bj * HALF + n * 16);
#pragma unroll
        for (int g = 0; g < 8; ++g) { const int ai = g >> 2, m = g & 3; const size_t off = (size_t)(row0 + ai * HALF + m * 16) * D + col0;
            if (g + 1 < 8) { const int ai2 = (g + 1) >> 2, m2 = (g + 1) & 3; const size_t off2 = (size_t)(row0 + ai2 * HALF + m2 * 16) * D + col0;
#pragma unroll
                for (int bj = 0; bj < 2; ++bj)
#pragma unroll
                    for (int n = 0; n < 2; ++n) xi[(g + 1) & 1][bj][n] = *(const f32x4*)(xin + off2 + bj * HALF + n * 16); }
            __builtin_amdgcn_sched_barrier(0);
#pragma unroll
            for (int bj = 0; bj < 2; ++bj)
#pragma unroll
                for (int n = 0; n < 2; ++n) *(f32x4*)(xout + off + bj * HALF + n * 16) = xi[g & 1][bj][n] + gv[bj][n] * (acc[ai][bj][m][n] * sc);
            __builtin_amdgcn_sched_barrier(0); }
    }
};
struct EpiGluBf16 { static constexpr bool PERM = true; bf16_t* H; const float* lw; const unsigned* cnt; const LAS int* base;
    __device__ __forceinline__ void operator()(const f32x4 (&acc)[2][2][4][2], const Unit& u, int wr, int wc, int fr, int fq) const {
        const int row0 = u.pm * BM + wr * 64 + fr, col0 = u.pn * HALF + wc * 32 + 8 * fq; const int eb = base[u.e], ec = (int)cnt[u.e];
#pragma unroll
        for (int ai = 0; ai < 2; ++ai)
#pragma unroll
            for (int m = 0; m < 4; ++m) { const int row = row0 + ai * HALF + m * 16, pos = row - eb; const float w = (pos < ec) ? lw[u.e * M + pos] : 0.f;
                const f32x4 g0 = acc[ai][0][m][0], g1 = acc[ai][0][m][1], u0 = acc[ai][1][m][0], u1 = acc[ai][1][m][1];
                u32x4 o; o.x = pk2(silu(g0[0]) * u0[0] * w, silu(g0[1]) * u0[1] * w); o.y = pk2(silu(g0[2]) * u0[2] * w, silu(g0[3]) * u0[3] * w);
                o.z = pk2(silu(g1[0]) * u1[0] * w, silu(g1[1]) * u1[1] * w); o.w = pk2(silu(g1[2]) * u1[2] * w, silu(g1[3]) * u1[3] * w);
                *(u32x4*)(H + (size_t)row * DFF + col0) = o; }
    }
};

struct EpiGluF8 { static constexpr bool PERM = true; unsigned char* H; const float* lw; const unsigned* cnt; const LAS int* base;
    __device__ __forceinline__ void operator()(const f32x4 (&acc)[2][2][4][2], const Unit& u, int wr, int wc, int fr, int fq) const {
        const int row0 = u.pm * BM + wr * 64 + fr, col0 = u.pn * HALF + wc * 32 + 8 * fq; const int eb = base[u.e], ec = (int)cnt[u.e];
        constexpr float DQ = 1.f / (F8_SA * F8_SW);
        float wrow[8];
#pragma unroll
        for (int g = 0; g < 8; ++g) { const int pos = row0 + (g >> 2) * HALF + (g & 3) * 16 - eb; wrow[g] = lw[u.e * M + pos]; wrow[g] = (pos < ec) ? wrow[g] * (F8_SH * DQ) : 0.f; }
#pragma unroll
        for (int ai = 0; ai < 2; ++ai)
#pragma unroll
            for (int m = 0; m < 4; ++m) { const int row = row0 + ai * HALF + m * 16; const float w = wrow[ai * 4 + m];
                const f32x4 g0 = acc[ai][0][m][0] * DQ, g1 = acc[ai][0][m][1] * DQ, u0 = acc[ai][1][m][0], u1 = acc[ai][1][m][1];
                u32x2 o; o.x = pk4_fp8(silu(g0[0]) * u0[0] * w, silu(g0[1]) * u0[1] * w, silu(g0[2]) * u0[2] * w, silu(g0[3]) * u0[3] * w);
                o.y = pk4_fp8(silu(g1[0]) * u1[0] * w, silu(g1[1]) * u1[1] * w, silu(g1[2]) * u1[2] * w, silu(g1[3]) * u1[3] * w);
                __hip_atomic_store((unsigned long long*)(H + (size_t)row * DFF + col0), ((unsigned long long)o.y << 32) | (unsigned long long)o.x, __ATOMIC_RELAXED, __HIP_MEMORY_SCOPE_AGENT); }
    }
};
template <class Epi, class Sched, bool ALIGN_EPI, bool SP2, bool F8 = false>
__device__ __forceinline__ void gemm_phase(LAS unsigned char* lds, const void* Ap, const void* Btp, const int K, const Sched& S, const Epi& E) {
    constexpr bool GATHER = Sched::GATHER; constexpr int ESZ = F8 ? 1 : 2;
    const int tid = opaque_tid(), wid = __builtin_amdgcn_readfirstlane(tid >> 6), lane = tid & 63, wr = wid >> 2, wc = wid & 3, fr = lane & 15, fq = lane >> 4;
    const int nt = K * ESZ / (BK * 2);
    unsigned voffA[2], voffB[2]; int sR[2], sC[2];
#pragma unroll
    for (int i = 0; i < 2; ++i) { int R, C; stage_rc(tid * 16 + i * 8192, R, C); const int Rb = Epi::PERM ? ((R & ~31) + perm32(R & 31)) : R; sR[i] = R; sC[i] = C;
        voffA[i] = (unsigned)(R * K * ESZ + C * 2); voffB[i] = (unsigned)(Rb * K * ESZ + C * 2); }
    const size_t kstep = (size_t)(BK * 2);
    const size_t hstep = (size_t)HALF * K * ESZ;
    const size_t tstep = 2 * hstep;
    const unsigned ldsw = (unsigned)wid * 1024u;
    const int aoff = lds_byte(wr * 64 + fr, fq * 8), boff = lds_byte(wc * 32 + fr, fq * 8);
#define PG8_SA(b, h) (((b) * 2 + (h)) * HTB)
#define PG8_SB(b, h) ((4 + (b) * 2 + (h)) * HTB)
#define PG8_ST2X(bufoff, gbase, o0, o1, AUX) do { unsigned _a = (o0), _b = (o1); asm volatile("" : "+v"(_a), "+v"(_b));   \
        __builtin_amdgcn_global_load_lds((const unsigned*)((const char*)(gbase) + _a), (LAS unsigned*)(lds + (bufoff) + ldsw), 16, 0, AUX); \
        __builtin_amdgcn_global_load_lds((const unsigned*)((const char*)(gbase) + _b), (LAS unsigned*)(lds + (bufoff) + ldsw + 8192), 16, 0, AUX); } while (0)
#define PG8_ST2(bufoff, gbase, o0, o1) PG8_ST2X(bufoff, gbase, o0, o1, 0)
#define PG8_STAGEB(bufoff, gbase) PG8_ST2(bufoff, gbase, voffB[0], voffB[1])
#define PG8_STAGEA(bufoff, P, KB, OV, h) do { if constexpr (GATHER) PG8_ST2(bufoff, (const char*)Ap + (KB), OV[h][0], OV[h][1]); else if constexpr (Sched::WAITF) PG8_ST2X(bufoff, (P) + (h) * hstep, voffA[0], voffA[1], 16);   else PG8_ST2(bufoff, (P) + (h) * hstep, voffA[0], voffA[1]); } while (0)
#define PG8_LDA(dst, b, h) do { _Pragma("unroll") for (int m = 0; m < 4; ++m) { if constexpr (F8) dst##8[m] = __builtin_shufflevector(*(const LAS v4i_t*)(lds + PG8_SA(b, h) + aoff + m * 2048), *(const LAS v4i_t*)(lds + PG8_SA(b, h) + aoff + m * 2048 + 1024), 0, 1, 2, 3, 4, 5, 6, 7); \
        else { _Pragma("unroll") for (int k = 0; k < 2; ++k) dst[m][k] = *(const LAS bf16x8*)(lds + PG8_SA(b, h) + aoff + m * 2048 + k * 1024); } } } while (0)
#define PG8_LDB(dst, b, h) do { _Pragma("unroll") for (int n = 0; n < 2; ++n) { if constexpr (F8) dst##8[n] = __builtin_shufflevector(*(const LAS v4i_t*)(lds + PG8_SB(b, h) + boff + n * 2048), *(const LAS v4i_t*)(lds + PG8_SB(b, h) + boff + n * 2048 + 1024), 0, 1, 2, 3, 4, 5, 6, 7); \
        else { _Pragma("unroll") for (int k = 0; k < 2; ++k) dst[n][k] = *(const LAS bf16x8*)(lds + PG8_SB(b, h) + boff + n * 2048 + k * 1024); } } } while (0)
#define PG8_CAT(x) __builtin_shufflevector(__builtin_bit_cast(v4i_t, (x)[0]), __builtin_bit_cast(v4i_t, (x)[1]), 0, 1, 2, 3, 4, 5, 6, 7)
#define PG8_MMA(ai, bj, At, Bt) do { __builtin_amdgcn_s_setprio(1); _Pragma("unroll") for (int m = 0; m < 4; ++m) _Pragma("unroll") for (int n = 0; n < 2; ++n) { \
        if constexpr (F8) asm volatile("v_mfma_scale_f32_16x16x128_f8f6f4 %0, %1, %2, %0, %3, %3 op_sel_hi:[0,0,0]" : "+v"(acc[ai][bj][m][n]) : "v"(Bt##8[n]), "v"(At##8[m]), "v"(sc127));   \
        else { _Pragma("unroll") for (int k = 0; k < 2; ++k) acc[ai][bj][m][n] = __builtin_amdgcn_mfma_f32_16x16x32_bf16(Bt[n][k], At[m][k], acc[ai][bj][m][n], 0, 0, 0); } } __builtin_amdgcn_s_setprio(0); } while (0)
#define PG8_WAIT_V(n) asm volatile("s_waitcnt vmcnt(" #n ")" ::: "memory")
#define PG8_WAIT_L(n) asm volatile("s_waitcnt lgkmcnt(" #n ")" ::: "memory")
#define PG8_BAR __builtin_amdgcn_s_barrier()
#define PG8_SCHED __builtin_amdgcn_sched_barrier(0)
    Unit cur, nxt; int ui = 0;
    if (!S.next(0, cur)) return;
    if constexpr (Sched::WAITF) S.wait(cur);
    f32x4 acc[2][2][4][2];
#pragma unroll
    for (int a = 0; a < 2; ++a)
#pragma unroll
        for (int b = 0; b < 2; ++b)
#pragma unroll
            for (int m = 0; m < 4; ++m)
#pragma unroll
                for (int n = 0; n < 2; ++n) acc[a][b][m][n] = (f32x4){0.f, 0.f, 0.f, 0.f};
    const int sc127 = 0x7F7F7F7F;
    bf16x8 At[4][2], B0[2][2], B1[2][2]; v8i_t At8[4], B08[2], B18[2];
    unsigned vc[2][2] = {{0u, 0u}, {0u, 0u}}, vn[2][2] = {{0u, 0u}, {0u, 0u}};
    if constexpr (GATHER) {
#pragma unroll
        for (int h = 0; h < 2; ++h)
#pragma unroll
            for (int i = 0; i < 2; ++i) vc[h][i] = S.arow(cur, h * HALF + sR[i]) * (unsigned)(K * ESZ) + (unsigned)sC[i] * 2u;
    }
    const char* cA = (const char*)Ap + (GATHER ? (size_t)0 : (size_t)cur.pm * tstep); const char* cB = (const char*)Btp + S.brow(cur) * (size_t)K * ESZ;
    if constexpr (SP2) {
        PG8_STAGEB(PG8_SB(0, 0), cB); PG8_STAGEB(PG8_SB(0, 1), cB + hstep); PG8_STAGEA(PG8_SA(0, 0), cA, 0, vc, 0); PG8_STAGEA(PG8_SA(0, 1), cA, 0, vc, 1);
        if (wr == 1) PG8_BAR;
        PG8_WAIT_V(2); PG8_BAR;
        PG8_STAGEB(PG8_SB(1, 0), cB + kstep); PG8_STAGEA(PG8_SA(1, 0), cA + kstep, kstep, vc, 0); PG8_STAGEB(PG8_SB(1, 1), cB + hstep + kstep);
        PG8_WAIT_V(6); PG8_BAR;
    } else {
        PG8_STAGEB(PG8_SB(0, 0), cB); PG8_STAGEA(PG8_SA(0, 0), cA, 0, vc, 0); PG8_STAGEB(PG8_SB(0, 1), cB + hstep); PG8_STAGEA(PG8_SA(0, 1), cA, 0, vc, 1);
        if (wr == 1) PG8_BAR;
        PG8_WAIT_V(4); PG8_BAR;
        PG8_STAGEB(PG8_SB(1, 0), cB + kstep); PG8_STAGEA(PG8_SA(1, 0), cA + kstep, kstep, vc, 0); PG8_STAGEB(PG8_SB(1, 1), cB + hstep + kstep);
        PG8_WAIT_V(6); PG8_BAR;
    }
    for (;;) {
        const bool has_next = S.next(ui + 1, nxt);
        if constexpr (Sched::WAITF) { if (has_next) S.wait(nxt); }
        const char* nA = (has_next && !GATHER) ? (const char*)Ap + (size_t)nxt.pm * tstep : cA; const char* nB = has_next ? (const char*)Btp + S.brow(nxt) * (size_t)K * ESZ : cB;
        if constexpr (GATHER) {
#pragma unroll
            for (int h = 0; h < 2; ++h)
#pragma unroll
                for (int i = 0; i < 2; ++i) vn[h][i] = has_next ? S.arow(nxt, h * HALF + sR[i]) * (unsigned)(K * ESZ) + (unsigned)sC[i] * 2u : vc[h][i];
        }
#pragma unroll 1
        for (int t = 0; t < nt; t += 2) {
            const bool last = (t == nt - 2);
            const char* a1 = cA + (size_t)(t + 1) * kstep; const size_t kb1 = (size_t)(t + 1) * kstep;
            const char* a2 = last ? nA : cA + (size_t)(t + 2) * kstep; const char* b2 = last ? nB : cB + (size_t)(t + 2) * kstep;
            const char* a3 = a2 + kstep; const char* b3 = b2 + kstep;
            const size_t kb2 = last ? (size_t)0 : (size_t)(t + 2) * kstep, kb3 = kb2 + kstep;
            unsigned v2[2][2];
#pragma unroll
            for (int h = 0; h < 2; ++h)
#pragma unroll
                for (int i = 0; i < 2; ++i) v2[h][i] = last ? vn[h][i] : vc[h][i];
            if constexpr (SP2) {
            PG8_LDB(B0, 0, 0); PG8_LDB(B1, 0, 1); PG8_SCHED; PG8_LDA(At, 0, 0); PG8_STAGEA(PG8_SA(1, 1), a1, kb1, vc, 1);
            PG8_WAIT_V(8); PG8_WAIT_L(0); PG8_BAR; PG8_MMA(0, 0, At, B0); PG8_MMA(0, 1, At, B1); PG8_BAR; PG8_SCHED;
            PG8_LDA(At, 0, 1); PG8_STAGEB(PG8_SB(0, 0), b2); PG8_STAGEB(PG8_SB(0, 1), b2 + hstep); PG8_STAGEA(PG8_SA(0, 0), a2, kb2, v2, 0);
            PG8_WAIT_V(8); PG8_WAIT_L(0); PG8_BAR; PG8_MMA(1, 0, At, B0); PG8_MMA(1, 1, At, B1); PG8_BAR; PG8_SCHED;
            PG8_LDB(B0, 1, 0); PG8_LDB(B1, 1, 1); PG8_SCHED; PG8_LDA(At, 1, 0); PG8_STAGEA(PG8_SA(0, 1), a2, kb2, v2, 1);
            PG8_WAIT_V(8); PG8_WAIT_L(0); PG8_BAR; PG8_MMA(0, 0, At, B0); PG8_MMA(0, 1, At, B1); PG8_BAR; PG8_SCHED;
            PG8_LDA(At, 1, 1); PG8_STAGEB(PG8_SB(1, 0), b3); PG8_STAGEB(PG8_SB(1, 1), b3 + hstep); PG8_STAGEA(PG8_SA(1, 0), a3, kb3, v2, 0);
            PG8_WAIT_V(8); PG8_WAIT_L(0); PG8_BAR; PG8_MMA(1, 0, At, B0); PG8_MMA(1, 1, At, B1); PG8_BAR; PG8_SCHED;
            } else {
            PG8_LDB(B0, 0, 0); PG8_SCHED; PG8_LDA(At, 0, 0); PG8_STAGEA(PG8_SA(1, 1), a1, kb1, vc, 1);
            PG8_WAIT_L(8); PG8_BAR; PG8_WAIT_L(0); PG8_MMA(0, 0, At, B0); PG8_BAR; PG8_SCHED;
            PG8_LDB(B1, 0, 1); PG8_STAGEB(PG8_SB(0, 0), b2);
            PG8_BAR; PG8_WAIT_L(0); PG8_MMA(0, 1, At, B1); PG8_BAR;
            PG8_LDA(At, 0, 1); PG8_STAGEA(PG8_SA(0, 0), a2, kb2, v2, 0);
            PG8_BAR; PG8_WAIT_L(0); PG8_MMA(1, 0, At, B0); PG8_BAR; PG8_SCHED;
            PG8_STAGEB(PG8_SB(0, 1), b2 + hstep);
            PG8_WAIT_V(6); PG8_BAR; PG8_MMA(1, 1, At, B1); PG8_BAR;
            PG8_LDB(B0, 1, 0); PG8_SCHED; PG8_LDA(At, 1, 0); PG8_STAGEA(PG8_SA(0, 1), a2, kb2, v2, 1);
            PG8_WAIT_L(8); PG8_BAR; PG8_WAIT_L(0); PG8_MMA(0, 0, At, B0); PG8_BAR; PG8_SCHED;
            PG8_LDB(B1, 1, 1); PG8_STAGEB(PG8_SB(1, 0), b3);
            PG8_BAR; PG8_WAIT_L(0); PG8_MMA(0, 1, At, B1); PG8_BAR;
            PG8_LDA(At, 1, 1); PG8_STAGEA(PG8_SA(1, 0), a3, kb3, v2, 0);
            PG8_BAR; PG8_WAIT_L(0); PG8_MMA(1, 0, At, B0); PG8_BAR; PG8_SCHED;
            PG8_STAGEB(PG8_SB(1, 1), b3 + hstep);
            PG8_WAIT_V(6); PG8_BAR; PG8_MMA(1, 1, At, B1); PG8_BAR;
            }
        }
        if constexpr (ALIGN_EPI) { if (wr == 0) PG8_BAR; }
        if constexpr (F8) { asm volatile("s_nop 15\n\ts_nop 7" ::: "memory");
#pragma unroll
            for (int a = 0; a < 2; ++a)
#pragma unroll
                for (int b = 0; b < 2; ++b)
#pragma unroll
                    for (int m = 0; m < 4; ++m)
#pragma unroll
                        for (int n = 0; n < 2; ++n) asm volatile("" : "+v"(acc[a][b][m][n])); }
        { const int tz = opaque_tid(), wz = __builtin_amdgcn_readfirstlane(tz >> 6), lz = tz & 63; E(acc, cur, wz >> 2, wz & 3, lz & 15, lz >> 4);
          if constexpr (Sched::SIGF) { asm volatile("s_waitcnt vmcnt(0)" ::: "memory");
              if (lz == 0) { const unsigned old = __hip_atomic_fetch_add((LAS unsigned*)(lds + LDS_UCNT_OFF), 1u, __ATOMIC_ACQ_REL, __HIP_MEMORY_SCOPE_WORKGROUP);
                  if ((old & 7u) == 7u) {   __hip_atomic_fetch_add(S.flg + cur.pm, 1u, __ATOMIC_RELAXED, __HIP_MEMORY_SCOPE_AGENT); } } } }
        if (!has_next) break;
#pragma unroll
        for (int a = 0; a < 2; ++a)
#pragma unroll
            for (int b = 0; b < 2; ++b)
#pragma unroll
                for (int m = 0; m < 4; ++m)
#pragma unroll
                    for (int n = 0; n < 2; ++n) acc[a][b][m][n] = (f32x4){0.f, 0.f, 0.f, 0.f};
        cur = nxt; cA = nA; cB = nB; ++ui;
        if constexpr (GATHER) {
#pragma unroll
            for (int h = 0; h < 2; ++h)
#pragma unroll
                for (int i = 0; i < 2; ++i) vc[h][i] = vn[h][i];
        }
        if constexpr (ALIGN_EPI) { if (wr == 1) PG8_BAR; }
    }
    PG8_WAIT_V(0);
    if constexpr (!ALIGN_EPI) { if (wr == 0) PG8_BAR; }
    PG8_BAR;
#undef PG8_SA
#undef PG8_SB
#undef PG8_ST2
#undef PG8_ST2X
#undef PG8_STAGEA
#undef PG8_STAGEB
#undef PG8_LDA
#undef PG8_LDB
#undef PG8_MMA
#undef PG8_CAT
#undef PG8_WAIT_V
#undef PG8_WAIT_L
#undef PG8_BAR
#undef PG8_SCHED
}
}

namespace att {
constexpr int AD = 128, NW = 8, QBLK = 32, KVBLK = 64;
constexpr float SCALE = 0.088388347648318440f;
constexpr float THR = 8.f;
constexpr int SDEPTH = 2;
constexpr int SHM_V = KVBLK * AD * 2, SHM_K = KVBLK * AD * 2, SHM_ATTN = 2 * SHM_V + 2 * SHM_K + NW * 64 * 4;
using bf16x8 = __attribute__((ext_vector_type(8))) short;
using s16x4  = __attribute__((ext_vector_type(4))) short;
using f32x16 = __attribute__((ext_vector_type(16))) float;
#define KSWZ(row, colB) ((row) * 256 + ((colB) ^ (((row) & 7) << 4)))
#define SBAR() __builtin_amdgcn_sched_barrier(0)
__device__ __forceinline__ int crow(int r, int hi) { return (r & 3) + 8 * (r >> 2) + 4 * hi; }
__device__ __forceinline__ unsigned cvtpk(float lo, float hi) { unsigned r; asm volatile("v_cvt_pk_bf16_f32 %0, %1, %2" : "=v"(r) : "v"(lo), "v"(hi)); return r; }
__device__ __forceinline__ void partialSM(f32x16& p0, f32x16& p1, float& m_reg, float& mn, float& alpha) {
  constexpr float C = SCALE * 1.4426950408889634f;
  float pmax = p0[0]; for (int r = 1; r < 16; ++r) pmax = fmaxf(pmax, p0[r]); for (int r = 0; r < 16; ++r) pmax = fmaxf(pmax, p1[r]);
  { auto rr = __builtin_amdgcn_permlane32_swap(__float_as_uint(pmax), __float_as_uint(pmax), false, false);
    pmax = fmaxf(__uint_as_float(rr[0]), __uint_as_float(rr[1])); }
  if (__builtin_expect(__all(pmax - m_reg <= THR / SCALE), 1)) { mn = m_reg; alpha = 1.f; }
  else { mn = fmaxf(m_reg, pmax); alpha = __builtin_amdgcn_exp2f((m_reg - mn) * C); m_reg = mn; }
  float mnC = -mn * C;
  for (int r = 0; r < 16; ++r) p0[r] = fmaf(p0[r], C, mnC); for (int r = 0; r < 16; ++r) p1[r] = fmaf(p1[r], C, mnC);
  for (int r = 0; r < 16; ++r) p0[r] = __builtin_amdgcn_exp2f(p0[r]);
}
__device__ __forceinline__ void finishSM(f32x16& p0, f32x16& p1, float alpha, float& l_reg, bf16x8& pa0, bf16x8& pa1, bf16x8& pa2, bf16x8& pa3) {
  for (int r = 0; r < 16; ++r) p1[r] = __builtin_amdgcn_exp2f(p1[r]);
  float ps = 0; for (int r = 0; r < 16; ++r) ps += p0[r]; for (int r = 0; r < 16; ++r) ps += p1[r];
  { auto rr = __builtin_amdgcn_permlane32_swap(__float_as_uint(ps), __float_as_uint(ps), false, false);
    ps = __uint_as_float(rr[0]) + __uint_as_float(rr[1]); }
  l_reg = l_reg * alpha + ps;
#define PK4(P, BASE, OUT) do { unsigned a0 = cvtpk(P[BASE + 0], P[BASE + 1]), a1 = cvtpk(P[BASE + 2], P[BASE + 3]);   \
    unsigned b0 = cvtpk(P[BASE + 4], P[BASE + 5]), b1 = cvtpk(P[BASE + 6], P[BASE + 7]);                              \
    auto r0 = __builtin_amdgcn_permlane32_swap(a0, b0, false, false); auto r1 = __builtin_amdgcn_permlane32_swap(a1, b1, false, false); \
    u32x4 w = {r0[0], r1[0], r0[1], r1[1]}; OUT = __builtin_bit_cast(bf16x8, w); } while (0)
  PK4(p0, 0, pa0); PK4(p0, 8, pa1); PK4(p1, 0, pa2); PK4(p1, 8, pa3);
#undef PK4
}
__device__ __forceinline__ void qkt(f32x16& p0, f32x16& p1, const LAS char* Ks, const bf16x8* qr, int r32, int hi) {
  p0 = f32x16{}; p1 = f32x16{};
#pragma unroll
  for (int d0 = 0; d0 < 8; ++d0) { int cb = (d0 * 16 + hi * 8) * 2;
    bf16x8 b0 = *(const LAS bf16x8*)(Ks + KSWZ(r32, cb));
    bf16x8 b1 = *(const LAS bf16x8*)(Ks + KSWZ(32 + r32, cb));
    p0 = __builtin_amdgcn_mfma_f32_32x32x16_bf16(b0, qr[d0], p0, 0, 0, 0);
    p1 = __builtin_amdgcn_mfma_f32_32x32x16_bf16(b1, qr[d0], p1, 0, 0, 0); }
}
__device__ __forceinline__ int v_st(int k, int c) { const int kk = (k & ~0xC) | ((k & 4) << 1) | ((k & 8) >> 1); return ((kk >> 3) * 4 + (c >> 5)) * 512 + ((kk & 7) * 32 + (c & 31)) * 2; }
__device__ __forceinline__ int v_rd_base(int lane) { return ((lane & 3) << 3) | (((lane >> 2) & 3) << 6) | (((lane >> 4) & 1) << 5) | (((lane >> 5) & 1) << 8); }
constexpr int v_rd_off(int d0, int ks, int half) { return d0 * 512 + ks * 4096 + half * 2048; }
template <int OFF> __device__ __forceinline__ s16x4 tr_read(int vb) {
  s16x4 r; asm volatile("ds_read_b64_tr_b16 %0, %1 offset:%2" : "=&v"(r) : "v"(vb), "i"(OFF) : "memory"); return r;
}
template <int D0> __device__ __forceinline__ void pv_one(f32x16& od, int vb, bf16x8 pa0, bf16x8 pa1, bf16x8 pa2, bf16x8 pa3) {
  const s16x4 l0 = tr_read<v_rd_off(D0, 0, 0)>(vb), h0 = tr_read<v_rd_off(D0, 0, 1)>(vb), l1 = tr_read<v_rd_off(D0, 1, 0)>(vb), h1 = tr_read<v_rd_off(D0, 1, 1)>(vb);
  const s16x4 l2 = tr_read<v_rd_off(D0, 2, 0)>(vb), h2 = tr_read<v_rd_off(D0, 2, 1)>(vb), l3 = tr_read<v_rd_off(D0, 3, 0)>(vb), h3 = tr_read<v_rd_off(D0, 3, 1)>(vb);
  asm volatile("s_waitcnt lgkmcnt(0)" ::: "memory"); SBAR();
#define PK(L, H) (bf16x8){L[0], L[1], L[2], L[3], H[0], H[1], H[2], H[3]}
  od = __builtin_amdgcn_mfma_f32_32x32x16_bf16(pa0, PK(l0, h0), od, 0, 0, 0);
  od = __builtin_amdgcn_mfma_f32_32x32x16_bf16(pa1, PK(l1, h1), od, 0, 0, 0);
  od = __builtin_amdgcn_mfma_f32_32x32x16_bf16(pa2, PK(l2, h2), od, 0, 0, 0);
  od = __builtin_amdgcn_mfma_f32_32x32x16_bf16(pa3, PK(l3, h3), od, 0, 0, 0);
#undef PK
}
__device__ __forceinline__ void pv_d0(f32x16* o, int vb, bf16x8 pa0, bf16x8 pa1, bf16x8 pa2, bf16x8 pa3) {
  pv_one<0>(o[0], vb, pa0, pa1, pa2, pa3); pv_one<1>(o[1], vb, pa0, pa1, pa2, pa3); pv_one<2>(o[2], vb, pa0, pa1, pa2, pa3); pv_one<3>(o[3], vb, pa0, pa1, pa2, pa3);
}
template <int LDQ, int LDK, int LDO>
__device__ __forceinline__ void attn_dense_body(const bf16_t* __restrict__ Qb, const bf16_t* __restrict__ Kh, const bf16_t* __restrict__ Vh, float* __restrict__ Ob, int seq, LAS char* lds) {
  const int tid = opaque_tid(), wid = tid >> 6, lane = tid & 63, r32 = lane & 31, hi = lane >> 5;
  LAS char* V_lds = lds; LAS char* K_lds = lds + 2 * SHM_V;
  LAS float* wsl = (LAS float*)(lds + 2 * SHM_V + 2 * SHM_K) + wid * 64; LAS float* li_l = wsl; LAS float* al_l = wsl + 32;
  float m_reg = -1e30f, l_reg = 0; f32x16 o[4] = {}; bf16x8 qr[8];
  const bf16_t* Qw = Qb + (long)(wid * QBLK + r32) * LDQ + hi * 8;
#pragma unroll
  for (int d0 = 0; d0 < 8; ++d0) qr[d0] = *(const bf16x8*)(Qw + d0 * 16);
  const int sr = tid >> 4, sc = (tid & 15) * 8, vst0 = v_st(sr, sc), vst1 = v_st(32 + sr, sc);
  const int vb0 = (int)(uintptr_t)V_lds + v_rd_base(lane);
  struct { bf16x8 vs0, vs1, ks0, ks1; } sr_[SDEPTH];
#define SLOAD(i, k0) do { sr_[i].vs0 = *(const bf16x8*)(&Vh[(long)((k0) + sr) * LDK + sc]); sr_[i].vs1 = *(const bf16x8*)(&Vh[(long)((k0) + 32 + sr) * LDK + sc]); \
    sr_[i].ks0 = *(const bf16x8*)(&Kh[(long)((k0) + sr) * LDK + sc]); sr_[i].ks1 = *(const bf16x8*)(&Kh[(long)((k0) + 32 + sr) * LDK + sc]); } while (0)
#define SWRITE(b, i) do { *(LAS bf16x8*)(V_lds + (b) * SHM_V + vst0) = sr_[i].vs0;          \
    *(LAS bf16x8*)(V_lds + (b) * SHM_V + vst1) = sr_[i].vs1; int kc = sc * 2;               \
    *(LAS bf16x8*)(K_lds + (b) * SHM_K + KSWZ(sr, kc)) = sr_[i].ks0;                       \
    *(LAS bf16x8*)(K_lds + (b) * SHM_K + KSWZ(32 + sr, kc)) = sr_[i].ks1; } while (0)
#define SWAIT() do { asm volatile("s_waitcnt vmcnt(4)" ::: "memory"); } while (0)
#define RESC(a) do { if (__any((a) < 1.f)) { if (hi == 0) al_l[r32] = (a); asm volatile("s_waitcnt lgkmcnt(0)" ::: "memory"); \
    for (int d = 0; d < 4; ++d) for (int r = 0; r < 16; ++r) o[d][r] *= al_l[crow(r, hi)]; } } while (0)
  f32x16 pA0, pA1, pB0, pB1; float mnA, mnB, alA, alB; bf16x8 pa0, pa1, pa2, pa3; const int NT = seq / KVBLK;
  constexpr int SE = 0, SO = SDEPTH - 1;
  SLOAD(SE, 0); asm volatile("s_waitcnt vmcnt(0)" ::: "memory"); SWRITE(0, SE); __syncthreads();
  qkt(pA0, pA1, K_lds, qr, r32, hi); partialSM(pA0, pA1, m_reg, mnA, alA);
  SLOAD(SO, KVBLK); if (2 < NT) SLOAD(SE, 2 * KVBLK);
  SWAIT(); SWRITE(1, SO); __syncthreads();
  for (int j = 1; j + 1 < NT; j += 2) {
    SBAR(); qkt(pB0, pB1, K_lds + SHM_K, qr, r32, hi);
    finishSM(pA0, pA1, alA, l_reg, pa0, pa1, pa2, pa3); SBAR();
    SLOAD(SO, (j + SDEPTH) * KVBLK); SBAR();
    pv_d0(o, vb0, pa0, pa1, pa2, pa3); partialSM(pB0, pB1, m_reg, mnB, alB);
    __syncthreads(); SWAIT(); SWRITE(0, SE);
    RESC(alB); __syncthreads();
    SBAR(); qkt(pA0, pA1, K_lds, qr, r32, hi);
    finishSM(pB0, pB1, alB, l_reg, pa0, pa1, pa2, pa3); SBAR();
    if (j + 3 < NT) SLOAD(SE, (j + 1 + SDEPTH) * KVBLK); SBAR();
    pv_d0(o, vb0 + (int)SHM_V, pa0, pa1, pa2, pa3); partialSM(pA0, pA1, m_reg, mnA, alA);
    __syncthreads(); SWAIT(); SWRITE(1, SO);
    RESC(alA); __syncthreads();
  }
  SBAR(); qkt(pB0, pB1, K_lds + SHM_K, qr, r32, hi);
  finishSM(pA0, pA1, alA, l_reg, pa0, pa1, pa2, pa3); SBAR();
  pv_d0(o, vb0, pa0, pa1, pa2, pa3); partialSM(pB0, pB1, m_reg, mnB, alB);
  __syncthreads(); RESC(alB);
  finishSM(pB0, pB1, alB, l_reg, pa0, pa1, pa2, pa3); SBAR();
  pv_d0(o, vb0 + (int)SHM_V, pa0, pa1, pa2, pa3);
  if (hi == 0) li_l[r32] = l_reg; asm volatile("s_waitcnt lgkmcnt(0)" ::: "memory");
  float rli[16];
#pragma unroll
  for (int r = 0; r < 16; ++r) rli[r] = __builtin_amdgcn_rcpf(li_l[crow(r, hi)]);
  float* Ow = Ob + (long)(wid * QBLK) * LDO;
#pragma unroll
  for (int r = 0; r < 16; ++r) { int orow = crow(r, hi);
#pragma unroll
    for (int d0 = 0; d0 < 4; ++d0) Ow[(long)orow * LDO + d0 * 32 + r32] = o[d0][r] * rli[r]; }
  asm volatile("s_waitcnt vmcnt(0) lgkmcnt(0)" ::: "memory"); __syncthreads();
#undef SLOAD
#undef SWRITE
#undef SWAIT
#undef RESC
}
constexpr int SHM_V2 = KVBLK * 256 * 2, SHM_K2 = KVBLK * AD * 2, SHM_ATTN256 = 2 * SHM_V2 + 2 * SHM_K2 + NW * 64 * 4;
__device__ __forceinline__ int v_st256(int k, int c) { const int kk = (k & ~0xC) | ((k & 4) << 1) | ((k & 8) >> 1); return ((kk >> 3) * 8 + (c >> 5)) * 512 + ((kk & 7) * 32 + (c & 31)) * 2; }
constexpr int v_rd_off256(int d0, int ks, int half) { return d0 * 512 + ks * 8192 + half * 4096; }
template <int D0> __device__ __forceinline__ void pv_one256(f32x16& od, int vb, bf16x8 pa0, bf16x8 pa1, bf16x8 pa2, bf16x8 pa3) {
  const s16x4 l0 = tr_read<v_rd_off256(D0, 0, 0)>(vb), h0 = tr_read<v_rd_off256(D0, 0, 1)>(vb), l1 = tr_read<v_rd_off256(D0, 1, 0)>(vb), h1 = tr_read<v_rd_off256(D0, 1, 1)>(vb);
  const s16x4 l2 = tr_read<v_rd_off256(D0, 2, 0)>(vb), h2 = tr_read<v_rd_off256(D0, 2, 1)>(vb), l3 = tr_read<v_rd_off256(D0, 3, 0)>(vb), h3 = tr_read<v_rd_off256(D0, 3, 1)>(vb);
  asm volatile("s_waitcnt lgkmcnt(0)" ::: "memory"); SBAR();
#define PK(L, H) (bf16x8){L[0], L[1], L[2], L[3], H[0], H[1], H[2], H[3]}
  od = __builtin_amdgcn_mfma_f32_32x32x16_bf16(pa0, PK(l0, h0), od, 0, 0, 0);
  od = __builtin_amdgcn_mfma_f32_32x32x16_bf16(pa1, PK(l1, h1), od, 0, 0, 0);
  od = __builtin_amdgcn_mfma_f32_32x32x16_bf16(pa2, PK(l2, h2), od, 0, 0, 0);
  od = __builtin_amdgcn_mfma_f32_32x32x16_bf16(pa3, PK(l3, h3), od, 0, 0, 0);
#undef PK
}
template <int LDQ, int LDK, int LDO>
__device__ __forceinline__ void attn_body256(const bf16_t* __restrict__ Qb, const bf16_t* __restrict__ Kh, const bf16_t* __restrict__ Vh, float* __restrict__ Ob, int seq, LAS char* lds) {
  const int tid = opaque_tid(), wid = tid >> 6, lane = tid & 63, r32 = lane & 31, hi = lane >> 5;
  LAS char* V_lds = lds; LAS char* K_lds = lds + 2 * SHM_V2;
  LAS float* wsl = (LAS float*)(lds + 2 * SHM_V2 + 2 * SHM_K2) + wid * 64; LAS float* li_l = wsl; LAS float* al_l = wsl + 32;
  float m_reg = -1e30f, l_reg = 0; f32x16 o[8] = {}; bf16x8 qr[8];
  const bf16_t* Qw = Qb + (long)(wid * QBLK + r32) * LDQ + hi * 8;
#pragma unroll
  for (int d0 = 0; d0 < 8; ++d0) qr[d0] = *(const bf16x8*)(Qw + d0 * 16);
  const int sr = tid >> 4, sc = (tid & 15) * 8;
  const int vst00 = v_st256(sr, sc), kst0 = KSWZ(sr, sc * 2);
  const unsigned toff = (unsigned)(sr * LDK + sc);
  const int vb0 = (int)(uintptr_t)V_lds + v_rd_base(lane);
  bf16x8 sa0, sa1, sa2, sa3;
#define SLOAD_A(k0) do { const bf16_t* vp_ = Vh + (long)(k0) * LDK + toff; const bf16_t* kp_ = Kh + (long)(k0) * LDK + toff; \
    sa0 = *(const bf16x8*)kp_; sa1 = *(const bf16x8*)(kp_ + 32L * LDK); sa2 = *(const bf16x8*)vp_; sa3 = *(const bf16x8*)(vp_ + 128); } while (0)
#define SWRITE_A(b) do { LAS char* vb_ = V_lds + (b) * SHM_V2 + vst00; LAS char* kb_ = K_lds + (b) * SHM_K2 + kst0; \
    *(LAS bf16x8*)(kb_) = sa0; *(LAS bf16x8*)(kb_ + 8192) = sa1; *(LAS bf16x8*)(vb_) = sa2; *(LAS bf16x8*)(vb_ + 2048) = sa3; } while (0)
#define SLOAD_B(k0) do { const bf16_t* vp_ = Vh + (long)((k0) + 32) * LDK + toff; sa0 = *(const bf16x8*)vp_; sa1 = *(const bf16x8*)(vp_ + 128); } while (0)
#define SWRITE_B(b) do { LAS char* vb_ = V_lds + (b) * SHM_V2 + vst00; *(LAS bf16x8*)(vb_ + 16384) = sa0; *(LAS bf16x8*)(vb_ + 18432) = sa1; } while (0)
  f32x16 p0, p1; float mn, al; bf16x8 pa0, pa1, pa2, pa3; const int NT = seq / KVBLK;
  SLOAD_A(0); asm volatile("s_waitcnt vmcnt(0)" ::: "memory"); SWRITE_A(0); SLOAD_B(0); asm volatile("s_waitcnt vmcnt(0)" ::: "memory"); SWRITE_B(0); __syncthreads();
#pragma unroll 1
  for (int j = 0; j < NT; ++j) {
    if (j + 1 < NT) SLOAD_A((j + 1) * KVBLK);
    SBAR(); qkt(p0, p1, K_lds + (j & 1) * SHM_K2, qr, r32, hi);
    partialSM(p0, p1, m_reg, mn, al);
    finishSM(p0, p1, al, l_reg, pa0, pa1, pa2, pa3); SBAR();
    if (j + 1 < NT) { asm volatile("s_waitcnt vmcnt(0)" ::: "memory"); SWRITE_A((j + 1) & 1); SLOAD_B((j + 1) * KVBLK); }
    SBAR();
    if (__any(al < 1.f)) { if (hi == 0) al_l[r32] = al; asm volatile("s_waitcnt lgkmcnt(0)" ::: "memory");
#pragma unroll
      for (int d = 0; d < 8; ++d)
#pragma unroll
        for (int r = 0; r < 16; ++r) o[d][r] *= al_l[crow(r, hi)]; }
    { const int vb = vb0 + (j & 1) * SHM_V2;
      pv_one256<0>(o[0], vb, pa0, pa1, pa2, pa3); pv_one256<1>(o[1], vb, pa0, pa1, pa2, pa3); pv_one256<2>(o[2], vb, pa0, pa1, pa2, pa3); pv_one256<3>(o[3], vb, pa0, pa1, pa2, pa3);
      pv_one256<4>(o[4], vb, pa0, pa1, pa2, pa3); pv_one256<5>(o[5], vb, pa0, pa1, pa2, pa3); pv_one256<6>(o[6], vb, pa0, pa1, pa2, pa3); pv_one256<7>(o[7], vb, pa0, pa1, pa2, pa3); }
    if (j + 1 < NT) { asm volatile("s_waitcnt vmcnt(0)" ::: "memory"); SWRITE_B((j + 1) & 1); }
    __syncthreads();
  }
  if (hi == 0) li_l[r32] = l_reg; asm volatile("s_waitcnt lgkmcnt(0)" ::: "memory");
  float* Ow = Ob + (long)(wid * QBLK) * LDO;
#pragma unroll
  for (int r = 0; r < 16; ++r) { const int orow = crow(r, hi); const float rli = __builtin_amdgcn_rcpf(li_l[orow]);
#pragma unroll
    for (int d0 = 0; d0 < 8; ++d0) Ow[(long)orow * LDO + d0 * 32 + r32] = o[d0][r] * rli; }
  asm volatile("s_waitcnt vmcnt(0) lgkmcnt(0)" ::: "memory"); __syncthreads();
#undef SLOAD_A
#undef SWRITE_A
#undef SLOAD_B
#undef SWRITE_B
}
#undef KSWZ
#undef SBAR
}

__device__ __forceinline__ void diffattn_units(const Params& p, LAS unsigned char* lds, float* O0, float* O1) {
    const bf16_t* proj = (const bf16_t*)(p.wp[IX_PROJ]);
    bf16_t* ao = (bf16_t*)(p.wp[IX_ACT]);
    const float* dl = p.in[17]; const float* dn = p.in[18];
    const int G = gridDim.x, bx = blockIdx.x; const int vcu = (G % 8 == 0) ? (bx % 8) * (G / 8) + bx / 8 : bx;
    int slot_k = 0; const int slot_me = (bx >> 3) & 3;
    for (int u = vcu; u < NB * 8 * 8; u += G) {
        const int qb = u & 7, h = (u >> 3) & 7, b = u >> 6;
        const size_t row0 = (size_t)b * T;
#pragma unroll 1
        for (int i = 0; i < 2; ++i) {
            if (slot_k == slot_me) convert_late(p, lds);
            ++slot_k;
            const bf16_t* Q = proj + (row0 + qb * 256) * LD1 + h * 256 + i * 128;
            const bf16_t* K = proj + row0 * LD1 + 2048 + h * 256 + i * 128;
            const bf16_t* V = proj + row0 * LD1 + 4096 + h * 256;
            float* O = (i ? O1 : O0) + (row0 + qb * 256) * D + h * 256;
            att::attn_body256<LD1, LD1, D>(Q, K, V, O, T, (LAS char*)lds);
        }
    }
    if (slot_k <= slot_me) convert_late(p, lds);
    const int tid_ = opaque_tid(), wave = tid_ >> 6, lane = tid_ & 63;
    float la = dl[lane] * dl[128 + lane] + dl[64 + lane] * dl[192 + lane], lb2 = dl[256 + lane] * dl[384 + lane] + dl[320 + lane] * dl[448 + lane];
    la = wave_sum(la); lb2 = wave_sum(lb2);
    const float lam = expf(la) - expf(lb2) + LAM_INIT;
    const f32x4 gv = *(const f32x4*)(dn + 4 * lane);
    for (int u = vcu; u < NB * 8 * 8; u += G) {
        const int qb = u & 7, h = (u >> 3) & 7, b = u >> 6;
        const size_t row0 = (size_t)b * T;
#pragma unroll 1
        for (int rr = 0; rr < 32; rr += 4) {
            f32x4 a[4], bb[4];
#pragma unroll
            for (int k = 0; k < 4; ++k) { const size_t off = (row0 + qb * 256 + wave * 32 + rr + k) * D + h * 256 + 4 * lane; a[k] = *(const f32x4*)(O0 + off); bb[k] = *(const f32x4*)(O1 + off); }
#pragma unroll
            for (int k = 0; k < 4; ++k) { const size_t off = (row0 + qb * 256 + wave * 32 + rr + k) * D + h * 256 + 4 * lane;
                const f32x4 o = a[k] - lam * bb[k];
                const float ss = wave_sum(o.x * o.x + o.y * o.y + o.z * o.z + o.w * o.w);
                const float rstd = (1.f - LAM_INIT) / sqrtf(ss * (1.f / 256.f) + EPS);
                if (OUT_F8) *(unsigned*)((unsigned char*)ao + off) = pk4_fp8(o.x * rstd * gv.x * F8_SM, o.y * rstd * gv.y * F8_SM, o.z * rstd * gv.z * F8_SM, o.w * rstd * gv.w * F8_SM);
                else { u32x2 ov; ov.x = pk2(o.x * rstd * gv.x, o.y * rstd * gv.y); ov.y = pk2(o.z * rstd * gv.z, o.w * rstd * gv.w); *(u32x2*)(ao + off) = ov; } }
        }
    }
}

namespace hg {
typedef short bf16x8 __attribute__((ext_vector_type(8)));
typedef short bf16x4 __attribute__((ext_vector_type(4)));
constexpr int SET_BYTES = 8192 * 3 + 512;
__device__ __forceinline__ int rm_byte(int c, int d) { return c * 256 + ((2 * d) ^ ((c & 7) << 4)); }
__device__ __forceinline__ bf16x8 pack8(const f32x4& a, const f32x4& b) { u32x4 w; w.x = pk2(a.x, a.y); w.y = pk2(a.z, a.w); w.z = pk2(b.x, b.y); w.w = pk2(b.z, b.w); return __builtin_bit_cast(bf16x8, w); }
}
__device__ __forceinline__ void hgrn_mfma(const Params& p, LAS unsigned char* lds) {
    using namespace hg;
    const bf16_t* proj = (const bf16_t*)(p.wp[IX_PROJ]);
    bf16_t* oscr = (bf16_t*)(p.wp[IX_XB]);
    const float* lbl = p.in[24];
    const int tid = opaque_tid(), w = __builtin_amdgcn_readfirstlane(tid >> 6), lane = tid & 63, fr = lane & 15, fq = lane >> 4;
    for (int u = blockIdx.x; u < 128; u += gridDim.x) {
        const int b = u >> 4, h = (u >> 1) & 7, dir = u & 1;
        const int d = 16 * w + fr;
        float lb; { const float l0 = lbl[h * 128 + d], l1 = lbl[1024 + h * 128 + d], l2 = lbl[2048 + h * 128 + d];
            const float mx = fmaxf(l0, fmaxf(l1, l2)); const float e0 = expf(l0 - mx), e1 = expf(l1 - mx), e2 = expf(l2 - mx); lb = e0 / (e0 + e1 + e2); }
        f32x4 S[8];
#pragma unroll
        for (int mi = 0; mi < 8; ++mi) S[mi] = (f32x4){0.f, 0.f, 0.f, 0.f};
        const bf16_t* pb = proj + (size_t)b * T * LD0 + h * 128 + d;
        const int zoff = dir ? 3072 : 2048;
        bf16_t rq[8], rz[8], rv[8], rp[8];
#define HG_LOAD(nn) do { _Pragma("unroll") for (int i = 0; i < 8; ++i) { \
                const int c_ = 8 * fq + i, tt_ = dir ? (T - 1 - (32 * (nn) + c_)) : (32 * (nn) + c_); const bf16_t* pr_ = pb + (size_t)tt_ * LD0; \
                rq[i] = pr_[0]; rv[i] = pr_[1024]; rz[i] = pr_[zoff]; \
                const int cp_ = (i < 4) ? (4 * fq + i) : (16 + 4 * fq + (i - 4)), tp_ = dir ? (T - 1 - (32 * (nn) + cp_)) : (32 * (nn) + cp_); \
                rp[i] = pb[(size_t)tp_ * LD0 + 1024]; } } while (0)
        HG_LOAD(0);
        for (int n = 0; n < T / 32; ++n) {
            LAS unsigned char* set = lds + (n & 1) * SET_BYTES;
            LAS unsigned char* QG = set; LAS unsigned char* KG = set + 8192; LAS unsigned char* KDT = set + 16384; LAS float* DEC = (LAS float*)(set + 24576);
            float qv[8], fv[8], vv[8], vp[8];
#pragma unroll
            for (int i = 0; i < 8; ++i) { qv[i] = bf2f(rq[i]); vv[i] = bf2f(rv[i]); fv[i] = bf2f(rz[i]); vp[i] = bf2f(rp[i]); }
            if (n + 1 < T / 32) HG_LOAD(n + 1);
            float Pl[8]; float P = 1.f;
#pragma unroll
            for (int i = 0; i < 8; ++i) { fv[i] = lb + (1.f - lb) * sigm(fv[i]); P *= fv[i]; Pl[i] = P; }
            const float p0 = __shfl(P, fr), p1 = __shfl(P, fr + 16), p2 = __shfl(P, fr + 32), p3 = __shfl(P, fr + 48);
            const float pre = (fq > 0 ? p0 : 1.f) * (fq > 1 ? p1 : 1.f) * (fq > 2 ? p2 : 1.f), tot = (p0 * p1) * (p2 * p3);
            float kd[8];
#pragma unroll
            for (int i = 0; i < 8; ++i) {
                const int c = 8 * fq + i; const float E = pre * Pl[i], rE = frcp(E), k = 1.f - fv[i];
                *(LAS bf16_t*)(QG + rm_byte(c, d)) = f2bf(silu(qv[i]) * E);
                *(LAS bf16_t*)(KG + rm_byte(c, d)) = f2bf(k * rE);
                kd[i] = k * tot * rE;
            }
            { u32x4 wv; wv.x = pk2(kd[0], kd[1]); wv.y = pk2(kd[2], kd[3]); wv.z = pk2(kd[4], kd[5]); wv.w = pk2(kd[6], kd[7]);
              *(LAS u32x4*)(KDT + d * 64 + ((fq ^ ((d >> 2) & 3)) << 4)) = wv; }
            if (fq == 0) DEC[d] = tot;
            const bf16x8 vB = pack8((f32x4){vv[0], vv[1], vv[2], vv[3]}, (f32x4){vv[4], vv[5], vv[6], vv[7]});
            const bf16x8 vP = pack8((f32x4){vp[0], vp[1], vp[2], vp[3]}, (f32x4){vp[4], vp[5], vp[6], vp[7]});
            __syncthreads();
            f32x4 at00 = {0.f, 0.f, 0.f, 0.f}, at01 = at00, at11 = at00;
#pragma unroll
            for (int ks = 0; ks < 4; ++ks) {
                const int d0 = 32 * ks + 8 * fq;
                const bf16x8 kg0 = *(const LAS bf16x8*)(KG + rm_byte(fr, d0)), kg1 = *(const LAS bf16x8*)(KG + rm_byte(16 + fr, d0));
                const bf16x8 qg0 = *(const LAS bf16x8*)(QG + rm_byte(fr, d0)), qg1 = *(const LAS bf16x8*)(QG + rm_byte(16 + fr, d0));
                at00 = __builtin_amdgcn_mfma_f32_16x16x32_bf16(kg0, qg0, at00, 0, 0, 0);
                at01 = __builtin_amdgcn_mfma_f32_16x16x32_bf16(kg0, qg1, at01, 0, 0, 0);
                at11 = __builtin_amdgcn_mfma_f32_16x16x32_bf16(kg1, qg1, at11, 0, 0, 0);
            }
#pragma unroll
            for (int j = 0; j < 4; ++j) { const bool ok = (4 * fq + j) <= fr; at00[j] = ok ? at00[j] : 0.f; at11[j] = ok ? at11[j] : 0.f; }
            const bf16x8 bi0 = pack8(at00, (f32x4){0.f, 0.f, 0.f, 0.f}), bi1 = pack8(at01, at11);
            f32x4 o0 = {0.f, 0.f, 0.f, 0.f}, o1 = o0;
            o0 = __builtin_amdgcn_mfma_f32_16x16x32_bf16(vP, bi0, o0, 0, 0, 0);
            o1 = __builtin_amdgcn_mfma_f32_16x16x32_bf16(vP, bi1, o1, 0, 0, 0);
#pragma unroll
            for (int ks = 0; ks < 4; ++ks) {
                const bf16x8 sb = pack8(S[2 * ks], S[2 * ks + 1]);
                const int da = 32 * ks + 4 * fq, db = da + 16;
                const bf16x4 q0a = *(const LAS bf16x4*)(QG + rm_byte(fr, da)), q0b = *(const LAS bf16x4*)(QG + rm_byte(fr, db));
                const bf16x4 q1a = *(const LAS bf16x4*)(QG + rm_byte(16 + fr, da)), q1b = *(const LAS bf16x4*)(QG + rm_byte(16 + fr, db));
                const bf16x8 qp0 = {q0a[0], q0a[1], q0a[2], q0a[3], q0b[0], q0b[1], q0b[2], q0b[3]}, qp1 = {q1a[0], q1a[1], q1a[2], q1a[3], q1b[0], q1b[1], q1b[2], q1b[3]};
                o0 = __builtin_amdgcn_mfma_f32_16x16x32_bf16(sb, qp0, o0, 0, 0, 0);
                o1 = __builtin_amdgcn_mfma_f32_16x16x32_bf16(sb, qp1, o1, 0, 0, 0);
            }
            { const int c0 = fr, c1 = 16 + fr; const int t0 = dir ? (T - 1 - (32 * n + c0)) : (32 * n + c0), t1 = dir ? (T - 1 - (32 * n + c1)) : (32 * n + c1);
              bf16_t* ob = oscr + ((size_t)dir * M + (size_t)b * T) * 1024 + h * 128 + 16 * w + 4 * fq;
              u32x2 w0; w0.x = pk2(o0[0], o0[1]); w0.y = pk2(o0[2], o0[3]); u32x2 w1; w1.x = pk2(o1[0], o1[1]); w1.y = pk2(o1[2], o1[3]);
              *(u32x2*)(ob + (size_t)t0 * 1024) = w0; *(u32x2*)(ob + (size_t)t1 * 1024) = w1; }
#pragma unroll
            for (int mi = 0; mi < 8; ++mi) {
                const int dr = 16 * mi + fr;
                const bf16x8 ka = *(const LAS bf16x8*)(KDT + dr * 64 + ((fq ^ ((dr >> 2) & 3)) << 4));
                const f32x4 dc = *(const LAS f32x4*)(DEC + 16 * mi + 4 * fq);
                S[mi] = __builtin_amdgcn_mfma_f32_16x16x32_bf16(ka, vB, S[mi] * dc, 0, 0, 0);
            }
        }
        __syncthreads();
    }
#undef HG_LOAD
}

__device__ __forceinline__ void na_task(const bf16_t* proj, const bf16_t* VT, const float* rpb, bf16_t* mix, LAS float* btab, int b, int r, int h, int qb, int lane) {
    typedef short bf16x8 __attribute__((ext_vector_type(8)));
    const int fr = lane & 15, fq = lane >> 4;
    const int r0 = min(max(r - 4, 0), 24), cb0 = (qb <= 1) ? 0 : 1;
    constexpr float LOG2E = 1.4426950408889634f, C = 0.125f * LOG2E;
    for (int i = lane; i < 8 * 31; i += 64) { const int kr = i / 31, dc = i % 31; btab[kr * 32 + dc] = rpb[(h * 15 + (r0 + kr - r + 7)) * 31 + dc] * LOG2E; }
    const size_t qtok = (size_t)b * T + r * 64 + 16 * qb + fr;
    bf16x8 qf[2];
#pragma unroll
    for (int ks = 0; ks < 2; ++ks) qf[ks] = *(const bf16x8*)(proj + qtok * LD0 + 5120 + h * 64 + 32 * ks + 8 * fq);
    f32x4 sc[24];
#pragma unroll
    for (int g = 0; g < 2; ++g) {
        bf16x8 kf[12][2];
#pragma unroll
        for (int t = 0; t < 12; ++t) { const int tile = 12 * g + t, kr = tile / 3, cbi = tile % 3;
            const size_t ktok = (size_t)b * T + (r0 + kr) * 64 + 16 * (cb0 + cbi) + fr;
            const bf16_t* kp = proj + ktok * LD0 + 6144 + h * 64 + 8 * fq;
            kf[t][0] = *(const bf16x8*)kp; kf[t][1] = *(const bf16x8*)(kp + 32); }
        __builtin_amdgcn_sched_barrier(0);
#pragma unroll
        for (int t = 0; t < 12; ++t) { f32x4 a = {0.f, 0.f, 0.f, 0.f};
            a = __builtin_amdgcn_mfma_f32_16x16x32_bf16(kf[t][0], qf[0], a, 0, 0, 0);
            a = __builtin_amdgcn_mfma_f32_16x16x32_bf16(kf[t][1], qf[1], a, 0, 0, 0);
            sc[12 * g + t] = a; }
        __builtin_amdgcn_sched_barrier(0);
    }
    const bf16_t* vbase = VT + (size_t)(h * 64 + fr) * VTLD + (size_t)b * T + 4 * fq;
    u32x2 vbuf[2][24];
#define NA_VLOAD(buf, nd) do { const bf16_t* vp_ = vbase + (size_t)(16 * (nd)) * VTLD; _Pragma("unroll") for (int t = 0; t < 24; ++t) vbuf[buf][t] = *(const u32x2*)(vp_ + (r0 + t / 3) * 64 + 16 * (cb0 + t % 3)); } while (0)
    NA_VLOAD(0, 0);
    asm volatile("s_waitcnt lgkmcnt(0)" ::: "memory");
    const int c = 16 * qb + fr, cs = min(max(c - 8, 0), 48);
    float mx = -1e30f;
#pragma unroll
    for (int kr = 0; kr < 8; ++kr)
#pragma unroll
        for (int cbi = 0; cbi < 3; ++cbi)
#pragma unroll
            for (int j = 0; j < 4; ++j) {
                const int sidx = 16 * (cb0 + cbi) + 4 * fq + j; const bool ok = (sidx >= cs) && (sidx < cs + 16);
                const int dc = min(max(sidx - c + 15, 0), 30);
                const float v = fmaf(sc[kr * 3 + cbi][j], C, btab[kr * 32 + dc]) + (ok ? 0.f : -1e30f);
                sc[kr * 3 + cbi][j] = v; mx = fmaxf(mx, v);
            }
    mx = fmaxf(mx, __shfl_xor(mx, 16)); mx = fmaxf(mx, __shfl_xor(mx, 32));
    float sum = 0.f;
#pragma unroll
    for (int t = 0; t < 24; ++t)
#pragma unroll
        for (int j = 0; j < 4; ++j) { const float e = __builtin_amdgcn_exp2f(sc[t][j] - mx); sc[t][j] = e; sum += e; }
    sum += __shfl_xor(sum, 16); sum += __shfl_xor(sum, 32);
    const float rs = 1.f / sum;
    f32x4 o[4];
#pragma unroll
    for (int nd = 0; nd < 4; ++nd) o[nd] = (f32x4){0.f, 0.f, 0.f, 0.f};
    bf16x8 pB[12];
#pragma unroll
    for (int kk = 0; kk < 12; ++kk) { const int t0 = 2 * kk, t1 = 2 * kk + 1;
        u32x4 w; w.x = pk2(sc[t0][0], sc[t0][1]); w.y = pk2(sc[t0][2], sc[t0][3]); w.z = pk2(sc[t1][0], sc[t1][1]); w.w = pk2(sc[t1][2], sc[t1][3]);
        pB[kk] = __builtin_bit_cast(bf16x8, w); }
#pragma unroll
    for (int nd = 0; nd < 4; ++nd) {
        if (nd + 1 < 4) NA_VLOAD((nd + 1) & 1, nd + 1);
#pragma unroll
        for (int kk = 0; kk < 12; ++kk) {
            const u32x2 va = vbuf[nd & 1][2 * kk], vb = vbuf[nd & 1][2 * kk + 1];
            u32x4 vw; vw.x = va.x; vw.y = va.y; vw.z = vb.x; vw.w = vb.y;
            o[nd] = __builtin_amdgcn_mfma_f32_16x16x32_bf16(__builtin_bit_cast(bf16x8, vw), pB[kk], o[nd], 0, 0, 0);
        }
    }
#undef NA_VLOAD
#pragma unroll
    for (int nd = 0; nd < 4; ++nd) { u32x2 ov; ov.x = pk2(o[nd][0] * rs, o[nd][1] * rs); ov.y = pk2(o[nd][2] * rs, o[nd][3] * rs);
        *(u32x2*)(mix + qtok * D + 1024 + h * 64 + 16 * nd + 4 * fq) = ov; }
}
constexpr int NA_UNITS = NB * 32 * 8, NA_FIRST = 1024;
__device__ __forceinline__ void na_mfma(const Params& p, LAS unsigned char* lds, int first, int stride, int lo, int hi) {
    const bf16_t* proj = (const bf16_t*)(p.wp[IX_PROJ]); const bf16_t* VT = (const bf16_t*)(p.wp[IX_VT]);
    bf16_t* mix = (bf16_t*)(p.wp[IX_ACT]);
    const int tid = opaque_tid(), w = __builtin_amdgcn_readfirstlane(tid >> 6), lane = tid & 63;
    LAS float* btab = (LAS float*)(lds + 65536) + w * 256;
    for (int u = lo + first; u < hi; u += stride) {
        const int hp = u & 7, r = (u >> 3) & 31, b = u >> 8;
        na_task(proj, VT, p.in[7], mix, btab, b, r, 2 * hp + (w >> 2), w & 3, lane);
    }
}

namespace na2 { constexpr int KRING = 0, VRING = 73728, MERGE = 147456, BIAS = 157696; }
__device__ __forceinline__ void na_ring(const Params& p, LAS unsigned char* lds, int unit) {
    using namespace na2;
    typedef short bf16x8 __attribute__((ext_vector_type(8)));
    const bf16_t* proj = (const bf16_t*)(p.wp[IX_PROJ]); const bf16_t* VT = (const bf16_t*)(p.wp[IX_VT]);
    bf16_t* mix = (bf16_t*)(p.wp[IX_ACT]); const float* rpb = p.in[7];
    const int tid = opaque_tid(), w = __builtin_amdgcn_readfirstlane(tid >> 6), lane = tid & 63, fr = lane & 15, fq = lane >> 4;
    const int b = unit >> 4, h = unit & 15, qb = w & 3, hf = w >> 2, cb0 = (qb <= 1) ? 0 : 1;
    constexpr float LOG2E = 1.4426950408889634f, C = 0.125f * LOG2E;
    LAS float* btab = (LAS float*)(lds + BIAS);
    for (int i = tid; i < 15 * 31; i += 512) btab[(i / 31) * 32 + (i % 31)] = rpb[h * 465 + i] * LOG2E;
    const int st_row = tid >> 3, st_pc = tid & 7, st_off = st_row * 128 + ((st_pc ^ (st_row & 7)) << 4);
    const bf16_t* kg = proj + ((size_t)b * T + st_row) * LD0 + 6144 + h * 64 + st_pc * 8;
    const bf16_t* vg = VT + (size_t)(h * 64 + st_row) * VTLD + (size_t)b * T + st_pc * 8;
    { u32x4 kk[8], vv[8];
#pragma unroll
      for (int g = 0; g < 8; ++g) { kk[g] = *(const u32x4*)(kg + (size_t)g * 64 * LD0); vv[g] = *(const u32x4*)(vg + g * 64); }
#pragma unroll
      for (int g = 0; g < 8; ++g) { *(LAS u32x4*)(lds + KRING + g * 8192 + st_off) = kk[g]; *(LAS u32x4*)(lds + VRING + g * 8192 + st_off) = vv[g]; } }
    const bf16_t* qg = proj + ((size_t)b * T + 16 * qb + fr) * LD0 + 5120 + h * 64 + 8 * fq;
    bf16x8 qf[2]; qf[0] = *(const bf16x8*)qg; qf[1] = *(const bf16x8*)(qg + 32);
    const int c = 16 * qb + fr, cs = min(max(c - 8, 0), 48);
    LAS unsigned* mb = (LAS unsigned*)(lds + MERGE) + qb * 640 + lane;
    __syncthreads();
    for (int r = 0; r < 32; ++r) {
        const int r0 = min(max(r - 4, 0), 24);
        const bool pf = (r >= 4) && (r < 28);
        u32x4 pk_ = {0u, 0u, 0u, 0u}, pv_ = {0u, 0u, 0u, 0u};
        if (pf) { pk_ = *(const u32x4*)(kg + (size_t)(r + 4) * 64 * LD0); pv_ = *(const u32x4*)(vg + (r + 4) * 64); }
        bf16x8 qn0 = qf[0], qn1 = qf[1];
        if (r + 1 < 32) { qn0 = *(const bf16x8*)(qg + (size_t)(r + 1) * 64 * LD0); qn1 = *(const bf16x8*)(qg + (size_t)(r + 1) * 64 * LD0 + 32); }
        f32x4 sc[12];
        int slot[4];
#pragma unroll
        for (int k4 = 0; k4 < 4; ++k4) { slot[k4] = (r0 + 4 * hf + k4) % 9;
            const LAS unsigned char* ks = lds + KRING + slot[k4] * 8192;
#pragma unroll
            for (int cbi = 0; cbi < 3; ++cbi) { const int tok = 16 * (cb0 + cbi) + fr;
                const bf16x8 a0 = *(const LAS bf16x8*)(ks + tok * 128 + ((fq ^ (tok & 7)) << 4)), a1 = *(const LAS bf16x8*)(ks + tok * 128 + (((4 + fq) ^ (tok & 7)) << 4));
                f32x4 a = {0.f, 0.f, 0.f, 0.f};
                a = __builtin_amdgcn_mfma_f32_16x16x32_bf16(a0, qf[0], a, 0, 0, 0);
                a = __builtin_amdgcn_mfma_f32_16x16x32_bf16(a1, qf[1], a, 0, 0, 0);
                sc[k4 * 3 + cbi] = a; } }
        float mx = -1e30f;
#pragma unroll
        for (int k4 = 0; k4 < 4; ++k4) { const LAS float* bt = btab + (r0 + 4 * hf + k4 - r + 7) * 32;
#pragma unroll
            for (int cbi = 0; cbi < 3; ++cbi)
#pragma unroll
                for (int j = 0; j < 4; ++j) { const int sidx = 16 * (cb0 + cbi) + 4 * fq + j; const bool ok = (sidx >= cs) && (sidx < cs + 16);
                    const int dc = min(max(sidx - c + 15, 0), 30);
                    const float v = fmaf(sc[k4 * 3 + cbi][j], C, bt[dc]) + (ok ? 0.f : -1e30f);
                    sc[k4 * 3 + cbi][j] = v; mx = fmaxf(mx, v); } }
        mx = fmaxf(mx, __shfl_xor(mx, 16)); mx = fmaxf(mx, __shfl_xor(mx, 32));
        float sum = 0.f;
#pragma unroll
        for (int t = 0; t < 12; ++t)
#pragma unroll
            for (int j = 0; j < 4; ++j) { const float e = __builtin_amdgcn_exp2f(sc[t][j] - mx); sc[t][j] = e; sum += e; }
        sum += __shfl_xor(sum, 16); sum += __shfl_xor(sum, 32);
        bf16x8 pB[6];
#pragma unroll
        for (int kk = 0; kk < 6; ++kk) { const int t0 = 2 * kk, t1 = 2 * kk + 1;
            u32x4 wv; wv.x = pk2(sc[t0][0], sc[t0][1]); wv.y = pk2(sc[t0][2], sc[t0][3]); wv.z = pk2(sc[t1][0], sc[t1][1]); wv.w = pk2(sc[t1][2], sc[t1][3]);
            pB[kk] = __builtin_bit_cast(bf16x8, wv); }
        f32x4 o[4];
#pragma unroll
        for (int nd = 0; nd < 4; ++nd) { o[nd] = (f32x4){0.f, 0.f, 0.f, 0.f}; const int d = 16 * nd + fr;
#pragma unroll
            for (int kk = 0; kk < 6; ++kk) { const int t0 = 2 * kk, t1 = 2 * kk + 1;
                const int tc0 = 16 * (cb0 + t0 % 3) + 4 * fq, tc1 = 16 * (cb0 + t1 % 3) + 4 * fq;
                const u32x2 va = *(const LAS u32x2*)(lds + VRING + slot[t0 / 3] * 8192 + d * 128 + (((tc0 >> 3) ^ (d & 7)) << 4) + (tc0 & 7) * 2);
                const u32x2 vb = *(const LAS u32x2*)(lds + VRING + slot[t1 / 3] * 8192 + d * 128 + (((tc1 >> 3) ^ (d & 7)) << 4) + (tc1 & 7) * 2);
                u32x4 vw; vw.x = va.x; vw.y = va.y; vw.z = vb.x; vw.w = vb.y;
                o[nd] = __builtin_amdgcn_mfma_f32_16x16x32_bf16(__builtin_bit_cast(bf16x8, vw), pB[kk], o[nd], 0, 0, 0); } }
        const bool merger = (hf == (r & 1));
        if (!merger) { mb[0] = __float_as_uint(mx); mb[64] = __float_as_uint(sum);
#pragma unroll
            for (int nd = 0; nd < 4; ++nd) { mb[(2 + 2 * nd) * 64] = pk2(o[nd][0], o[nd][1]); mb[(3 + 2 * nd) * 64] = pk2(o[nd][2], o[nd][3]); } }
        if (pf) { const int sl = (r + 4) % 9; *(LAS u32x4*)(lds + KRING + sl * 8192 + st_off) = pk_; *(LAS u32x4*)(lds + VRING + sl * 8192 + st_off) = pv_; }
        __syncthreads();
        if (merger) {
            const float m2 = __uint_as_float(mb[0]), l2 = __uint_as_float(mb[64]);
            const float mN = fmaxf(mx, m2), a1 = __builtin_amdgcn_exp2f(mx - mN), a2 = __builtin_amdgcn_exp2f(m2 - mN);
            const float rl = frcp(sum * a1 + l2 * a2);
            bf16_t* op = mix + ((size_t)b * T + r * 64 + 16 * qb + fr) * D + 1024 + h * 64 + 4 * fq;
            unsigned char* op8 = (unsigned char*)mix + ((size_t)b * T + r * 64 + 16 * qb + fr) * D + 1024 + h * 64 + 4 * fq;
#pragma unroll
            for (int nd = 0; nd < 4; ++nd) { const unsigned w0 = mb[(2 + 2 * nd) * 64], w1 = mb[(3 + 2 * nd) * 64];
                const float x0 = (o[nd][0] * a1 + __uint_as_float(w0 << 16) * a2) * rl, x1 = (o[nd][1] * a1 + __uint_as_float(w0 & 0xffff0000u) * a2) * rl;
                const float x2 = (o[nd][2] * a1 + __uint_as_float(w1 << 16) * a2) * rl, x3 = (o[nd][3] * a1 + __uint_as_float(w1 & 0xffff0000u) * a2) * rl;
                if (OUT_F8) *(unsigned*)(op8 + 16 * nd) = pk4_fp8(x0 * F8_SM, x1 * F8_SM, x2 * F8_SM, x3 * F8_SM);
                else { u32x2 ov; ov.x = pk2(x0, x1); ov.y = pk2(x2, x3); *(u32x2*)(op + 16 * nd) = ov; } }
        }
        qf[0] = qn0; qf[1] = qn1;
    }
    __syncthreads();
}

#ifndef PROBE
#define PROBE 0
#endif
#define PH(k, ...) do { __VA_ARGS__ if constexpr (PROBE == (k)) { xcd_barrier(bar); __VA_ARGS__ } } while (0)
__global__ void __launch_bounds__(512, 2) fwd_kernel(Params p) {
    extern __shared__ __attribute__((aligned(16))) unsigned char lds_raw[];
    LAS unsigned char* lds = (LAS unsigned char*)lds_raw;
    volatile LAS unsigned* xbw = (volatile LAS unsigned*)(lds + LDS_BYTES - 16);
    if (threadIdx.x < 4) xbw[threadIdx.x] = 0u;
    __syncthreads();
    unsigned* ctl = (unsigned*)(p.wp[IX_CTL]);
    XcdBarrier bar = xcd_barrier_post(ctl + CW_BAR, xbw);
    float* mod = (float*)(p.wp[IX_MOD]);
    float* xb = (float*)(p.wp[IX_XB]);
    bf16_t* act = (bf16_t*)(p.wp[IX_ACT]);
    bf16_t* proj = (bf16_t*)(p.wp[IX_PROJ]);
    bf16_t* hid = (bf16_t*)(p.wp[IX_HID]);
    bf16_t* ybuf = (bf16_t*)(p.wp[IX_Y]);
    bf16_t* mres = (bf16_t*)(p.wp[IX_O1]);
    unsigned* cnt0 = ctl + CW_CNT; unsigned* cnt1 = ctl + CW_CNT + 64;
    LAS int* base = (LAS int*)(lds + LDS_BASE_OFF);
    const int G = gridDim.x, cid = blockIdx.x;
    if constexpr (PROBE == 20) { for (int i = 0; i < 10; ++i) xcd_barrier(bar); }
    if constexpr (PROBE == 22) { xcd_barrier(bar); }

    PH(1, phase_mod(p, lds); __syncthreads(););
    PH(2, phase_convert(p, lds););
    xcd_barrier(bar);
    PH(3, phase_rows<false, false, false, true>(p, lds, p.in[0], nullptr, p.in[2], mod, 0, D, nullptr, act, nullptr, nullptr, nullptr););
    xcd_barrier(bar);
    if constexpr (PROBE == 21) { xcd_barrier(bar); xcd_barrier(bar); xcd_barrier(bar); xcd_barrier(bar); xcd_barrier(bar); xcd_barrier(bar); xcd_barrier(bar); xcd_barrier(bar); xcd_barrier(bar); xcd_barrier(bar); }
    PH(4, { pg8::StaticOrder S; S.init(M, 7168, G, cid); pg8::EpiBf16 E{proj, LD0, 1.f / (F8_SA * F8_SW)};
        pg8::gemm_phase<pg8::EpiBf16, pg8::StaticOrder, true, true, true>(lds, act, p.wp[IX_WIN0], D, S, E);
        pg8::StaticOrder S2; S2.init(1024, M, G, cid); pg8::EpiBf16 E2{(bf16_t*)(p.wp[IX_VT]), VTLD, 1.f / (F8_SA * F8_SW)};
        pg8::gemm_phase<pg8::EpiBf16, pg8::StaticOrder, true, true, true>(lds, p.wp[IX_WIN0] + (size_t)7168 * D, act, D, S2, E2); });
    xcd_barrier(bar);
    PH(5, hgrn_mfma(p, lds););
    if (G >= 256) { if (cid >= 128) for (int u = cid - 128; u < NB * 16; u += G - 128) na_ring(p, lds, u); }
    else for (int u = cid; u < NB * 16; u += G) na_ring(p, lds, u);
    if constexpr (PROBE == 6) { xcd_barrier(bar); for (int u = cid; u < NB * 16; u += G) na_ring(p, lds, u); }
    xcd_barrier(bar);
    PH(7, hgrn_combine(p););
    xcd_barrier(bar);
    PH(8, { pg8::StaticOrder S; S.init(M, D, G, cid); pg8::EpiBf16 E{mres, D, OUT_F8 ? 1.f / (F8_SM * F8_SWD) : 1.f};
        pg8::gemm_phase<pg8::EpiBf16, pg8::StaticOrder, true, true, OUT_F8>(lds, act, p.wp[IX_WOUT0], D, S, E); });
    xcd_barrier(bar);
    phase_rows<false, true, false, true>(p, lds, p.in[0], nullptr, p.in[9], mod, 3 * D, 4 * D, nullptr, act, nullptr, nullptr, cnt0, mres);
    if constexpr (PROBE == 15) { xcd_barrier(bar); phase_rows<false, true, false, true, true>(p, lds, p.in[0], nullptr, p.in[9], mod, 3 * D, 4 * D, nullptr, act, nullptr, nullptr, ctl + CW_CNT + 128, mres); }
    xcd_barrier(bar);
    compute_base(cnt0, base);
    { pg8::MoeOrder<true, 0, true, false> S{base, (const int*)(p.wp[IX_LIST]), cnt0, G, cid, base[NE] / 256, ctl + CW_FLG}; pg8::EpiGluF8 E{(unsigned char*)hid, (const float*)(p.wp[IX_LW]), cnt0, base};
        pg8::gemm_phase<pg8::EpiGluF8, pg8::MoeOrder<true, 0, true, false>, true, true, true>(lds, act, p.wp[IX_WGU0], D, S, E); }
    { pg8::MoeOrder<false, 2, false, true> S{base, nullptr, cnt0, G, cid, base[NE] / 256, ctl + CW_FLG}; pg8::EpiBf16 E{ybuf, D, 1.f / (F8_SH * F8_SWD)};
        pg8::gemm_phase<pg8::EpiBf16, pg8::MoeOrder<false, 2, false, true>, true, true, true>(lds, hid, p.wp[IX_WD0], DFF, S, E); }
    xcd_barrier(bar);
    PH(11, phase_combine<false, true>(p, lds, p.in[0], xb, p.in[13], mod + 8 * 12288, mod, act, nullptr, cnt0, mres););
    xcd_barrier(bar);
    PH(12, { pg8::StaticOrder S; S.init(M, ODW, G, cid); pg8::EpiBf16Rope E{proj, LD1, (const float*)(p.wp[IX_ROPE]), (const float*)(p.wp[IX_ROPE]) + 2048 * 16, 1.f / (F8_SA * F8_SW)};
        pg8::gemm_phase<pg8::EpiBf16Rope, pg8::StaticOrder, true, true, true>(lds, act, p.wp[IX_WIN1], D, S, E); });
    xcd_barrier(bar);
    PH(13, diffattn_units(p, lds, p.out, (float*)(p.wp[IX_O1])););
    xcd_barrier(bar);
    { pg8::StaticOrder S; S.init(M, D, G, cid); pg8::EpiBf16 E{mres, D, OUT_F8 ? 1.f / (F8_SM * F8_SWD) : 1.f};
      pg8::gemm_phase<pg8::EpiBf16, pg8::StaticOrder, true, true, OUT_F8>(lds, act, p.wp[IX_WOUT1], D, S, E); }
    xcd_barrier(bar);
    phase_rows<false, true, false, true>(p, lds, xb, nullptr, p.in[20], mod + 8 * 12288, 3 * D, 4 * D, nullptr, act, nullptr, nullptr, cnt1, mres);
    xcd_barrier(bar);
    compute_base(cnt1, base);
    { pg8::MoeOrder<true, 0, true, false> S{base, (const int*)(p.wp[IX_LIST]), cnt1, G, cid, base[NE] / 256, ctl + CW_FLG + 256}; pg8::EpiGluF8 E{(unsigned char*)hid, (const float*)(p.wp[IX_LW]), cnt1, base};
      pg8::gemm_phase<pg8::EpiGluF8, pg8::MoeOrder<true, 0, true, false>, true, true, true>(lds, act, p.wp[IX_WGU1], D, S, E); }
    { pg8::MoeOrder<false, 2, false, true> S{base, nullptr, cnt1, G, cid, base[NE] / 256, ctl + CW_FLG + 256}; pg8::EpiBf16 E{ybuf, D, 1.f / (F8_SH * F8_SWD)};
      pg8::gemm_phase<pg8::EpiBf16, pg8::MoeOrder<false, 2, false, true>, true, true, true>(lds, hid, p.wp[IX_WD1], DFF, S, E); }
    xcd_barrier(bar);
    PH(16, phase_combine<true, false>(p, lds, xb, nullptr, p.in[27], nullptr, mod + 8 * 12288, nullptr, p.out, cnt1, mres););
}

extern "C" void kernel_launch(void* const* d_in, const int* in_sizes, int n_in, void* d_out, int out_size, void* d_ws, size_t ws_size, hipStream_t stream) {
    static int grid = 0;
    if (grid == 0) {
        if (n_in != 28 || out_size != M * D || ws_size < WS_END) { fprintf(stderr, "kernel_launch: unexpected shapes: n_in %d out %d ws %zu\n", n_in, out_size, ws_size); grid = -1; return; }
        int dev = 0, cus = 0, per_cu = 0;
        if (hipGetDevice(&dev) != hipSuccess || hipDeviceGetAttribute(&cus, hipDeviceAttributeMultiprocessorCount, dev) != hipSuccess) { grid = -1; return; }
        if (hipFuncSetAttribute((const void*)fwd_kernel, hipFuncAttributeMaxDynamicSharedMemorySize, LDS_BYTES) != hipSuccess) { fprintf(stderr, "kernel_launch: hipFuncSetAttribute failed\n"); grid = -1; return; }
        if (hipOccupancyMaxActiveBlocksPerMultiprocessor(&per_cu, (const void*)fwd_kernel, 512, LDS_BYTES) != hipSuccess || per_cu < 1) { fprintf(stderr, "kernel_launch: occupancy query says %d\n", per_cu); grid = -1; return; }
        (void)hipGetLastError();
        grid = cus;
    }
    if (grid < 0) return;
    if (hipMemsetAsync((char*)d_ws + WS_CTL, 0, CTL_BYTES, stream) != hipSuccess) return;
    Params p{};
    for (int i = 0; i < 28; ++i) p.in[i] = (const float*)d_in[i];
    p.out = (float*)d_out;
    p.wp[IX_ACT] = (unsigned char*)d_ws + WS_ACT;
    p.wp[IX_CTL] = (unsigned char*)d_ws + WS_CTL;
    p.wp[IX_HID] = (unsigned char*)d_ws + WS_HID;
    p.wp[IX_LIST] = (unsigned char*)d_ws + WS_LIST;
    p.wp[IX_LW] = (unsigned char*)d_ws + WS_LW;
    p.wp[IX_MOD] = (unsigned char*)d_ws + WS_MOD;
    p.wp[IX_O1] = (unsigned char*)d_ws + WS_O1;
    p.wp[IX_PROJ] = (unsigned char*)d_ws + WS_PROJ;
    p.wp[IX_ROPE] = (unsigned char*)d_ws + WS_ROPE;
    p.wp[IX_TOK] = (unsigned char*)d_ws + WS_TOK;
    p.wp[IX_VT] = (unsigned char*)d_ws + WS_VT;
    p.wp[IX_WD0] = (unsigned char*)d_ws + WS_WD0;
    p.wp[IX_WD1] = (unsigned char*)d_ws + WS_WD1;
    p.wp[IX_WGU0] = (unsigned char*)d_ws + WS_WGU0;
    p.wp[IX_WGU1] = (unsigned char*)d_ws + WS_WGU1;
    p.wp[IX_WIN0] = (unsigned char*)d_ws + WS_WIN0;
    p.wp[IX_WIN1] = (unsigned char*)d_ws + WS_WIN1;
    p.wp[IX_WOUT0] = (unsigned char*)d_ws + WS_WOUT0;
    p.wp[IX_WOUT1] = (unsigned char*)d_ws + WS_WOUT1;
    p.wp[IX_XB] = (unsigned char*)d_ws + WS_XB;
    p.wp[IX_Y] = (unsigned char*)d_ws + WS_Y;
    for (int j = 0; j < 16; ++j) p.inv[j] = pow(500000.0, -(double)j / 16.0);
    hipLaunchKernelGGL(fwd_kernel, dim3(grid), dim3(512), LDS_BYTES, stream, p);
    const hipError_t le = hipPeekAtLastError();
    if (le != hipSuccess) fprintf(stderr, "kernel_launch: launch failed: %s\n", hipGetErrorName(le));
}
```

```cpp
#include <hip/hip_runtime.h>
#include <cstdio>
#include <cstdint>
#include <cmath>

#define LAS __attribute__((address_space(3)))
typedef unsigned short bf16_t;
typedef float f32x4 __attribute__((ext_vector_type(4)));
typedef float f32x2 __attribute__((ext_vector_type(2)));
typedef __bf16 bf16x2_t __attribute__((ext_vector_type(2)));
typedef unsigned u32x4 __attribute__((ext_vector_type(4)));
typedef unsigned u32x2 __attribute__((ext_vector_type(2)));

constexpr int NB = 8, T = 2048, D = 2048, M = NB * T;
constexpr int EVW = 8192, ODW = 6144, NE = 16, DFF = 1024;
constexpr int LD0 = EVW + 64, LD1 = ODW + 64, VTLD = M + 64;
constexpr int PMAX = 2 * M + NE * 256;
constexpr float EPS = 1e-6f;
constexpr float LAM_INIT = 0.35550906759f;

constexpr size_t MiB = 1u << 20;
constexpr size_t WS_CTL = 0, CTL_BYTES = 1 * MiB;
constexpr size_t WS_MOD = 1 * MiB;
constexpr size_t WS_ROPE = 2 * MiB;
constexpr size_t WS_TOK = 3 * MiB;
constexpr size_t WS_LIST = 4 * MiB;
constexpr size_t WS_LW = 5 * MiB;
constexpr size_t WS_XB = 8 * MiB;
constexpr size_t WS_ACT = 136 * MiB;
constexpr size_t WS_PROJ = 200 * MiB;
constexpr size_t WS_HID = WS_PROJ, WS_Y = WS_PROJ + 72 * MiB;
constexpr size_t WS_W = 464 * MiB;
constexpr size_t WS_WIN0 = WS_W, WS_WOUT0 = WS_WIN0 + 32 * MiB, WS_WGU0 = WS_WOUT0 + 8 * MiB, WS_WD0 = WS_WGU0 + 128 * MiB;
constexpr size_t WS_WIN1 = WS_WD0 + 64 * MiB, WS_WOUT1 = WS_WIN1 + 24 * MiB, WS_WGU1 = WS_WOUT1 + 8 * MiB, WS_WD1 = WS_WGU1 + 128 * MiB;
constexpr size_t WS_VT = WS_WD1 + 64 * MiB;
constexpr size_t WS_O1 = WS_WD1 + 64 * MiB;
constexpr size_t WS_END = WS_O1 + 128 * MiB;
constexpr int CW_BAR = 4096, CW_CNT = 8192, CW_NAQ = 8448, CW_FLG = 12288;
constexpr int LDS_BYTES = 163840;
constexpr int LDS_BASE_OFF = 131072 + 1024;
constexpr int LDS_UCNT_OFF = LDS_BASE_OFF + 128;

#define XB_TMO      128
#define XB_XCNT(j)  (256  + 64 * (j))
#define XB_XSUB(j)  (1280 + 64 * (j))
#define XB_XGEN(j)  (2304 + 64 * (j))
#define XB_TOP      3328
#define XB_TOPGEN   3392
#define XCD_BAR_WORDS 3456
#define XB_SPIN_CAP (1u << 20)
__device__ __forceinline__ unsigned xb_ld(unsigned* p)              { return __hip_atomic_load(p, __ATOMIC_RELAXED, __HIP_MEMORY_SCOPE_AGENT); }
__device__ __forceinline__ unsigned xb_add(unsigned* p, unsigned v) { return __hip_atomic_fetch_add(p, v, __ATOMIC_RELAXED, __HIP_MEMORY_SCOPE_AGENT); }
__device__ __forceinline__ unsigned xb_xcc_id() { return (unsigned)__builtin_amdgcn_s_getreg((3 << 11) | 20) & 0xFu; }
#define XB_SPIN(cond, bar) do { unsigned _sp = 0; while (cond) { __builtin_amdgcn_s_sleep(1); \
    if ((++_sp & 255u) == 0u) { if (xb_ld(&(bar)[XB_TMO])) break; if (_sp > XB_SPIN_CAP) { atomicAdd(&(bar)[XB_TMO], 1u); break; } } } } while (0)
struct XcdBarrier { unsigned* bar; unsigned x; volatile LAS unsigned* st; };
__device__ __forceinline__ XcdBarrier xcd_barrier_post(unsigned* bar, volatile LAS unsigned* st) {
    XcdBarrier b; b.bar = bar; b.x = xb_xcc_id(); b.st = st;
    if (threadIdx.x == 0) (void)xb_add(&bar[XB_XCNT(b.x)], 1u);
    return b;
}
__device__ __forceinline__ void xcd_barrier_complete(unsigned* bar, unsigned x, unsigned& nloc, unsigned& nx) {
    const unsigned G = gridDim.x * gridDim.y * gridDim.z;
    unsigned sum, cnt, mine, sp = 0u;
    for (;;) {
        sum = 0u; cnt = 0u; mine = 0u;
#pragma unroll
        for (unsigned j = 0; j < 16; ++j) { const unsigned c = xb_ld(&bar[XB_XCNT(j)]); sum += c; cnt += (c > 0u) ? 1u : 0u; mine = (j == x) ? c : mine; }
        if (sum == G) break;
        __builtin_amdgcn_s_sleep(1);
        if ((++sp & 255u) == 0u) { if (xb_ld(&bar[XB_TMO])) break; if (sp > XB_SPIN_CAP) { atomicAdd(&bar[XB_TMO], 1u); break; } }
    }
    nloc = mine > 0u ? mine : 1u; nx = cnt > 0u ? cnt : 1u;
}
__device__ __forceinline__ void xcd_barrier(const XcdBarrier& b) {
    asm volatile("s_waitcnt vmcnt(0)" ::: "memory");
    __syncthreads();
    if (threadIdx.x == 0) {
        unsigned* bar = b.bar;
        __builtin_amdgcn_s_waitcnt(0);
        unsigned nloc = b.st[0], nx = b.st[1];
        if (nloc == 0u) { xcd_barrier_complete(bar, b.x, nloc, nx); b.st[0] = nloc; b.st[1] = nx; }
        const unsigned old = xb_add(&bar[XB_XSUB(b.x)], 1u);
        const unsigned gen = old / nloc;
        if (old + 1u == (gen + 1u) * nloc) {
            __builtin_amdgcn_fence(__ATOMIC_RELEASE, "agent");
            asm volatile("s_waitcnt vmcnt(0)" ::: "memory");
            const unsigned og = xb_add(&bar[XB_TOP], 1u);
            const unsigned tg = og / nx;
            if (og + 1u == (tg + 1u) * nx) xb_add(&bar[XB_TOPGEN], 1u);
            else XB_SPIN(xb_ld(&bar[XB_TOPGEN]) == tg, bar);
            __builtin_amdgcn_fence(__ATOMIC_ACQUIRE, "agent");
            xb_add(&bar[XB_XGEN(b.x)], 1u);
            asm volatile("s_waitcnt vmcnt(0)" ::: "memory");
        } else {
            XB_SPIN(xb_ld(&bar[XB_XGEN(b.x)]) == gen, bar);
            __builtin_amdgcn_fence(__ATOMIC_ACQUIRE, "agent");
            asm volatile("s_waitcnt vmcnt(0)" ::: "memory");
        }
    }
    __syncthreads();
}

__device__ __forceinline__ int opaque_tid() { int t = threadIdx.x; asm volatile("" : "+v"(t)); return t; }
__device__ __forceinline__ float bf2f(bf16_t v) { return __uint_as_float((unsigned)v << 16); }
__device__ __forceinline__ unsigned pk2(float a, float b) { f32x2 v = {a, b}; bf16x2_t r = __builtin_convertvector(v, bf16x2_t); return __builtin_bit_cast(unsigned, r); }
__device__ __forceinline__ bf16_t f2bf(float a) { return (bf16_t)(pk2(a, 0.f) & 0xffffu); }
__device__ __forceinline__ float frcp(float x) { return __builtin_amdgcn_rcpf(x); }
__device__ __forceinline__ float sigm(float x) { return frcp(1.f + __expf(-x)); }
__device__ __forceinline__ float silu(float x) { return x * frcp(1.f + __expf(-x)); }
constexpr bool OUT_F8 = true;
constexpr float F8_SM = 8.f;
constexpr float F8_SA = 16.f, F8_SW = 256.f, F8_SH = 8.f, F8_SWD = 256.f;
__device__ __forceinline__ unsigned pk4_fp8(float a, float b, float c, float d) { unsigned w = 0u; w = __builtin_amdgcn_cvt_pk_fp8_f32(a, b, w, false); w = __builtin_amdgcn_cvt_pk_fp8_f32(c, d, w, true); return w; }
__device__ __forceinline__ float wave_sum(float v) {
#pragma unroll
    for (int o = 1; o < 64; o <<= 1) v += __shfl_xor(v, o);
    return v;
}
__device__ __forceinline__ float wave_max(float v) {
#pragma unroll
    for (int o = 1; o < 64; o <<= 1) v = fmaxf(v, __shfl_xor(v, o));
    return v;
}

enum WsIx { IX_ACT, IX_CTL, IX_HID, IX_LIST, IX_LW, IX_MOD, IX_O1, IX_PROJ, IX_ROPE, IX_TOK, IX_VT, IX_WD0, IX_WD1, IX_WGU0, IX_WGU1, IX_WIN0, IX_WIN1, IX_WOUT0, IX_WOUT1, IX_XB, IX_Y, IX_N };
struct Params {
    const float* in[28];
    float* out;
    unsigned char* wp[IX_N];
    double inv[16];
};

__device__ __forceinline__ void phase_mod(const Params& p, LAS unsigned char* lds) {
    LAS float* cact = (LAS float*)lds;
    LAS float* red = (LAS float*)(lds + 65536);
    const int tid = opaque_tid(), wave = tid >> 6, lane = tid & 63;
    const float* c = p.in[1];
    float* mod = (float*)(p.wp[IX_MOD]);
    for (int i = tid; i < 8 * 2048; i += 512) { const int b = i / 2048, k = i % 2048; cact[k * 8 + b] = silu(c[i]); }
    __syncthreads();
    for (int u = blockIdx.x; u < 192; u += gridDim.x) {
        const int l = u / 96, cb = u % 96;
        const float* W = p.in[l ? 14 : 3]; const float* bias = p.in[l ? 15 : 4];
        float acc[8][2];
#pragma unroll
        for (int b = 0; b < 8; ++b) { acc[b][0] = 0.f; acc[b][1] = 0.f; }
        const float* wp = W + (size_t)(wave * 256) * 12288 + cb * 128 + 2 * lane;
#pragma unroll 16
        for (int k = 0; k < 256; ++k) {
            const f32x2 w = __builtin_nontemporal_load((const f32x2*)(wp + (size_t)k * 12288));
            const f32x4 c0 = *(LAS f32x4*)(cact + (wave * 256 + k) * 8), c1 = *(LAS f32x4*)(cact + (wave * 256 + k) * 8 + 4);
            acc[0][0] += c0.x * w.x; acc[0][1] += c0.x * w.y; acc[1][0] += c0.y * w.x; acc[1][1] += c0.y * w.y;
            acc[2][0] += c0.z * w.x; acc[2][1] += c0.z * w.y; acc[3][0] += c0.w * w.x; acc[3][1] += c0.w * w.y;
            acc[4][0] += c1.x * w.x; acc[4][1] += c1.x * w.y; acc[5][0] += c1.y * w.x; acc[5][1] += c1.y * w.y;
            acc[6][0] += c1.z * w.x; acc[6][1] += c1.z * w.y; acc[7][0] += c1.w * w.x; acc[7][1] += c1.w * w.y;
        }
#pragma unroll
        for (int b = 0; b < 8; ++b) { red[(wave * 8 + b) * 128 + 2 * lane] = acc[b][0]; red[(wave * 8 + b) * 128 + 2 * lane + 1] = acc[b][1]; }
        __syncthreads();
        for (int o = tid; o < 1024; o += 512) {
            const int b = o / 128, j = o % 128; float s = 0.f;
#pragma unroll
            for (int w = 0; w < 8; ++w) s += red[(w * 8 + b) * 128 + j];
            mod[(size_t)(l * 8 + b) * 12288 + cb * 128 + j] = s + bias[cb * 128 + j];
        }
        __syncthreads();
    }
    float* rc = (float*)(p.wp[IX_ROPE]); float* rs = rc + 2048 * 16;
    for (int i = blockIdx.x * 512 + tid; i < 2048 * 16; i += gridDim.x * 512) {
        const int pos = i / 16, j = i % 16;
        const double ang = (double)pos * p.inv[j];
        const double n = rint(ang * 0.15915494309189535);
        double r = fma(-n, 6.283185307179586, ang); r = fma(-n, 2.4492935982947064e-16, r);
        rc[i] = cosf((float)r); rs[i] = sinf((float)r);
    }
}

__device__ __forceinline__ void compute_base(const unsigned* cnt, LAS int* base) {
    if (threadIdx.x == 0) { int s = 0; for (int e = 0; e < NE; ++e) { base[e] = s; s += ((int)cnt[e] + 255) / 256 * 256; } base[NE] = s; *(LAS unsigned*)((LAS unsigned char*)base + 128) = 0u; }
    __syncthreads();
}
template <bool COMBINE, bool ROUTE, bool FINAL, bool OUT8 = false, bool DUMMY = false>
__device__ __forceinline__ void phase_rows(const Params& p, LAS unsigned char* lds, const float* xin, float* xnew, const float* g, const float* modl  ,
                                           int sh_off, int sc_off, const float* modprev  , bf16_t* hout, float* fout,
                                           const unsigned* cnt_prev, unsigned* cnt_cur, const bf16_t* mres = nullptr  ) {
    const int tid = opaque_tid(), wave = tid >> 6, lane = tid & 63;
    LAS int* base = (LAS int*)(lds + LDS_BASE_OFF);
    if (COMBINE) compute_base(cnt_prev, base);
    const int* tok_e = (const int*)(p.wp[IX_TOK]); const int* tok_pos = tok_e + 2 * M;
    int* tok_e_w = DUMMY ? (int*)(p.wp[IX_Y] + 4 * MiB) : (int*)(p.wp[IX_TOK]); int* tok_pos_w = tok_e_w + 2 * M;
    const bf16_t* Y = (const bf16_t*)(p.wp[IX_Y]);
    int* list = DUMMY ? (int*)(p.wp[IX_Y]) : (int*)(p.wp[IX_LIST]); float* lw = DUMMY ? (float*)(p.wp[IX_Y] + 2 * MiB) : (float*)(p.wp[IX_LW]);
    const float* rw = p.in[25]; const float* rb = p.in[26];
    LAS f32x4* WT = (LAS f32x4*)lds;
    LAS unsigned* rt_cnt = (LAS unsigned*)(lds + 131072 + 2048);
    LAS int* rt_sel = (LAS int*)(lds + 131072 + 4096);
    int rslot = 0;
    if (ROUTE) { if (tid < 32) rt_cnt[tid] = 0u;
        for (int i = tid; i < 8192; i += 512) { const int k = i >> 2, eg = i & 3; WT[(((k >> 8) * 4 + (k & 3)) * 4 + eg) * 64 + ((k & 255) >> 2)] = *(const f32x4*)(rw + k * 16 + eg * 4); }
        __syncthreads(); }
    for (int m = blockIdx.x * 8 + wave; m < M; m += gridDim.x * 8) {
        const int b = m / T;
        f32x4 xv[8];
#pragma unroll
        for (int j = 0; j < 8; ++j) xv[j] = *(const f32x4*)(xin + (size_t)m * D + 4 * lane + 256 * j);
        if (mres) { const float* gta = modl + (size_t)b * 12288 + 2 * D;
#pragma unroll
            for (int j = 0; j < 8; ++j) { const int c = 4 * lane + 256 * j; const u32x2 mm = *(const u32x2*)(mres + (size_t)m * D + c); const f32x4 gv = *(const f32x4*)(gta + c);
                xv[j].x += gv.x * __uint_as_float(mm.x << 16); xv[j].y += gv.y * __uint_as_float(mm.x & 0xffff0000u); xv[j].z += gv.z * __uint_as_float(mm.y << 16); xv[j].w += gv.w * __uint_as_float(mm.y & 0xffff0000u); } }
        if (COMBINE) {
            const int e0 = tok_e[2 * m], e1 = tok_e[2 * m + 1];
            const size_t r0 = (size_t)(base[e0] + tok_pos[2 * m]), r1 = (size_t)(base[e1] + tok_pos[2 * m + 1]);
            const float* gt = modprev + (size_t)b * 12288 + 5 * D;
#pragma unroll
            for (int j = 0; j < 8; ++j) {
                const int c = 4 * lane + 256 * j;
                const u32x2 a = *(const u32x2*)(Y + r0 * D + c), bb = *(const u32x2*)(Y + r1 * D + c);
                const f32x4 gv = *(const f32x4*)(gt + c);
                xv[j].x += gv.x * (__uint_as_float(a.x << 16) + __uint_as_float(bb.x << 16));
                xv[j].y += gv.y * (__uint_as_float(a.x & 0xffff0000u) + __uint_as_float(bb.x & 0xffff0000u));
                xv[j].z += gv.z * (__uint_as_float(a.y << 16) + __uint_as_float(bb.y << 16));
                xv[j].w += gv.w * (__uint_as_float(a.y & 0xffff0000u) + __uint_as_float(bb.y & 0xffff0000u));
                if (!FINAL) *(f32x4*)(xnew + (size_t)m * D + c) = xv[j];
            }
        }
        float ss = 0.f;
#pragma unroll
        for (int j = 0; j < 8; ++j) ss += xv[j].x * xv[j].x + xv[j].y * xv[j].y + xv[j].z * xv[j].z + xv[j].w * xv[j].w;
        ss = wave_sum(ss);
        const float rstd = 1.0f / sqrtf(ss * (1.f / D) + EPS);
        if (FINAL) {
#pragma unroll
            for (int j = 0; j < 8; ++j) { const int c = 4 * lane + 256 * j; const f32x4 gv = *(const f32x4*)(g + c); *(f32x4*)(fout + (size_t)m * D + c) = xv[j] * rstd * gv; }
        } else {
            const float* sh = modl + (size_t)b * 12288 + sh_off; const float* sc = modl + (size_t)b * 12288 + sc_off;
#pragma unroll
            for (int j = 0; j < 8; ++j) {
                const int c = 4 * lane + 256 * j;
                const f32x4 gv = *(const f32x4*)(g + c), shv = *(const f32x4*)(sh + c), scv = *(const f32x4*)(sc + c);
                xv[j] = xv[j] * rstd * gv * (1.f + scv) + shv;
                if (OUT8) *(unsigned*)((unsigned char*)hout + (size_t)m * D + c) = pk4_fp8(xv[j].x * F8_SA, xv[j].y * F8_SA, xv[j].z * F8_SA, xv[j].w * F8_SA);
                else { u32x2 o; o.x = pk2(xv[j].x, xv[j].y); o.y = pk2(xv[j].z, xv[j].w); *(u32x2*)(hout + (size_t)m * D + c) = o; }
            }
            if (ROUTE) {
                float lg[16];
#pragma unroll
                for (int e = 0; e < 16; ++e) lg[e] = 0.f;
#pragma unroll
                for (int j = 0; j < 8; ++j) {
#pragma unroll
                    for (int cc = 0; cc < 4; ++cc) {
                        const float hv = xv[j][cc];
                        const f32x4 w0 = WT[((j * 4 + cc) * 4 + 0) * 64 + lane], w1 = WT[((j * 4 + cc) * 4 + 1) * 64 + lane], w2 = WT[((j * 4 + cc) * 4 + 2) * 64 + lane], w3 = WT[((j * 4 + cc) * 4 + 3) * 64 + lane];
                        lg[0] += hv * w0.x; lg[1] += hv * w0.y; lg[2] += hv * w0.z; lg[3] += hv * w0.w;
                        lg[4] += hv * w1.x; lg[5] += hv * w1.y; lg[6] += hv * w1.z; lg[7] += hv * w1.w;
                        lg[8] += hv * w2.x; lg[9] += hv * w2.y; lg[10] += hv * w2.z; lg[11] += hv * w2.w;
                        lg[12] += hv * w3.x; lg[13] += hv * w3.y; lg[14] += hv * w3.z; lg[15] += hv * w3.w;
                    }
                    __builtin_amdgcn_sched_barrier(0);
                }
                float sc_[16], sel[16];
#pragma unroll
                for (int e = 0; e < 16; ++e) { lg[e] = wave_sum(lg[e]); sc_[e] = 1.f / (1.f + expf(-lg[e])); sel[e] = sc_[e] + rb[e]; }
                float gsv[4], gw1[4], gw2[4]; int gi1[4], gi2[4];
#pragma unroll
                for (int gq = 0; gq < 4; ++gq) {
                    float m1 = sel[4 * gq]; int i1 = 0; float s1 = sc_[4 * gq];
#pragma unroll
                    for (int i = 1; i < 4; ++i) if (sel[4 * gq + i] > m1) { m1 = sel[4 * gq + i]; i1 = i; s1 = sc_[4 * gq + i]; }
                    float m2 = -INFINITY; int i2 = 0; float s2 = 0.f;
#pragma unroll
                    for (int i = 0; i < 4; ++i) if (i != i1 && sel[4 * gq + i] > m2) { m2 = sel[4 * gq + i]; i2 = i; s2 = sc_[4 * gq + i]; }
                    gsv[gq] = m1 + m2; gi1[gq] = 4 * gq + i1; gi2[gq] = 4 * gq + i2; gw1[gq] = s1; gw2[gq] = s2;
                }
                float bv = gsv[0]; int e0 = gi1[0], e1 = gi2[0]; float w0 = gw1[0], w1 = gw2[0];
#pragma unroll
                for (int gq = 1; gq < 4; ++gq) if (gsv[gq] > bv) { bv = gsv[gq]; e0 = gi1[gq]; e1 = gi2[gq]; w0 = gw1[gq]; w1 = gw2[gq]; }
                const float wsum = w0 + w1; w0 /= wsum; w1 /= wsum;
                if (lane == 0) {
                    const int k = rslot++;
                    const int l0 = (int)__hip_atomic_fetch_add(rt_cnt + e0, 1u, __ATOMIC_RELAXED, __HIP_MEMORY_SCOPE_WORKGROUP), l1 = (int)__hip_atomic_fetch_add(rt_cnt + e1, 1u, __ATOMIC_RELAXED, __HIP_MEMORY_SCOPE_WORKGROUP);
                    LAS int* rr = rt_sel + (k * 8 + wave) * 8;
                    rr[0] = m; rr[1] = e0; rr[2] = e1; rr[3] = l0; rr[4] = l1; ((LAS float*)rr)[5] = w0; ((LAS float*)rr)[6] = w1;
                }
            }
        }
    }
    if (ROUTE) {
        __syncthreads();
        if (tid < NE) rt_cnt[16 + tid] = atomicAdd(cnt_cur + tid, rt_cnt[tid]);
        __syncthreads();
        const int nrow = (M - (int)blockIdx.x * 8 + (int)gridDim.x * 8 - 1) / ((int)gridDim.x * 8);
        for (int i = tid; i < nrow * 8; i += 512) {
            const LAS int* rr = rt_sel + i * 8; const int m = rr[0], e0 = rr[1], e1 = rr[2];
            const int p0 = (int)rt_cnt[16 + e0] + rr[3], p1 = (int)rt_cnt[16 + e1] + rr[4];
            list[e0 * M + p0] = m; lw[e0 * M + p0] = ((const LAS float*)rr)[5]; list[e1 * M + p1] = m; lw[e1 * M + p1] = ((const LAS float*)rr)[6];
            tok_e_w[2 * m] = e0; tok_e_w[2 * m + 1] = e1; tok_pos_w[2 * m] = p0; tok_pos_w[2 * m + 1] = p1;
        }
    }
}

__device__ __forceinline__ void hgrn_combine(const Params& p) {
    const bf16_t* proj = (const bf16_t*)(p.wp[IX_PROJ]);
    const bf16_t* oscr = (const bf16_t*)(p.wp[IX_XB]);
    unsigned char* mix8 = p.wp[IX_ACT]; bf16_t* mix = (bf16_t*)(p.wp[IX_ACT]);
    const float* ng = p.in[6];
    const int tid_ = opaque_tid(), wave = tid_ >> 6, lane = tid_ & 63, c = 16 * lane;
    f32x4 gn[4];
#pragma unroll
    for (int q = 0; q < 4; ++q) gn[q] = *(const f32x4*)(ng + c + 4 * q);
    const int stride = gridDim.x * 8;
    u32x4 na[2][2], nb[2][2], ng_[2][2];
#define HC_LOAD(r0_) do { _Pragma("unroll") for (int r = 0; r < 2; ++r) { const int rw = ((r0_) + r * stride < M) ? (r0_) + r * stride : (r0_); \
        _Pragma("unroll") for (int hq = 0; hq < 2; ++hq) { na[r][hq] = *(const u32x4*)(oscr + (size_t)rw * 1024 + c + 8 * hq); nb[r][hq] = *(const u32x4*)(oscr + ((size_t)M + rw) * 1024 + c + 8 * hq); \
            ng_[r][hq] = *(const u32x4*)(proj + (size_t)rw * LD0 + 4096 + c + 8 * hq); } } } while (0)
    int row = blockIdx.x * 8 + wave;
    if (row < M) HC_LOAD(row);
    for (; row < M; row += 2 * stride) {
        u32x4 a[2][2], bb[2][2], gg[2][2];
#pragma unroll
        for (int r = 0; r < 2; ++r)
#pragma unroll
            for (int hq = 0; hq < 2; ++hq) { a[r][hq] = na[r][hq]; bb[r][hq] = nb[r][hq]; gg[r][hq] = ng_[r][hq]; }
        if (row + 2 * stride < M) HC_LOAD(row + 2 * stride);
#pragma unroll
        for (int r = 0; r < 2; ++r) { const int rw = row + r * stride; if (rw >= M) break;
            float o[16]; float ss = 0.f;
#pragma unroll
            for (int hq = 0; hq < 2; ++hq)
#pragma unroll
                for (int k = 0; k < 4; ++k) { const unsigned x = a[r][hq][k], y = bb[r][hq][k];
                    const float v0 = __uint_as_float(x << 16) + __uint_as_float(y << 16), v1 = __uint_as_float(x & 0xffff0000u) + __uint_as_float(y & 0xffff0000u);
                    o[8 * hq + 2 * k] = v0; o[8 * hq + 2 * k + 1] = v1; ss += v0 * v0 + v1 * v1; }
            ss += __shfl_xor(ss, 1); ss += __shfl_xor(ss, 2); ss += __shfl_xor(ss, 4);
            const float rstd = 1.0f / sqrtf(ss * (1.f / 128.f) + EPS);
            float res[16];
#pragma unroll
            for (int hq = 0; hq < 2; ++hq)
#pragma unroll
                for (int k = 0; k < 4; ++k) { const unsigned g = gg[r][hq][k]; const int i0 = 8 * hq + 2 * k;
                    res[i0] = o[i0] * rstd * gn[i0 >> 2][i0 & 3] * silu(__uint_as_float(g << 16)); res[i0 + 1] = o[i0 + 1] * rstd * gn[(i0 + 1) >> 2][(i0 + 1) & 3] * silu(__uint_as_float(g & 0xffff0000u)); }
            if (OUT_F8) { u32x4 w; w.x = pk4_fp8(res[0] * F8_SM, res[1] * F8_SM, res[2] * F8_SM, res[3] * F8_SM); w.y = pk4_fp8(res[4] * F8_SM, res[5] * F8_SM, res[6] * F8_SM, res[7] * F8_SM);
                w.z = pk4_fp8(res[8] * F8_SM, res[9] * F8_SM, res[10] * F8_SM, res[11] * F8_SM); w.w = pk4_fp8(res[12] * F8_SM, res[13] * F8_SM, res[14] * F8_SM, res[15] * F8_SM);
                *(u32x4*)(mix8 + (size_t)rw * D + c) = w; }
            else { u32x4 w0, w1; w0.x = pk2(res[0], res[1]); w0.y = pk2(res[2], res[3]); w0.z = pk2(res[4], res[5]); w0.w = pk2(res[6], res[7]);
                w1.x = pk2(res[8], res[9]); w1.y = pk2(res[10], res[11]); w1.z = pk2(res[12], res[13]); w1.w = pk2(res[14], res[15]);
                *(u32x4*)(mix + (size_t)rw * D + c) = w0; *(u32x4*)(mix + (size_t)rw * D + c + 8) = w1; }
        }
    }
#undef HC_LOAD
}
__device__ __forceinline__ void rope_pass(const Params& p) {
    bf16_t* proj = (bf16_t*)(p.wp[IX_PROJ]);
    const float* rc = (const float*)(p.wp[IX_ROPE]); const float* rs = rc + 2048 * 16;
    for (size_t i = (size_t)blockIdx.x * 512 + opaque_tid(); i < (size_t)M * 32 * 16; i += (size_t)gridDim.x * 512) {
        const int j = (int)(i & 15), hh = (int)((i >> 4) & 31); const size_t row = i >> 9; const int pos = (int)(row % T);
        bf16_t* a = proj + row * LD1 + hh * 128 + j;
        const float x1 = bf2f(a[0]), x2 = bf2f(a[16]), cc = rc[pos * 16 + j], sn = rs[pos * 16 + j];
        a[0] = f2bf(x1 * cc - x2 * sn); a[16] = f2bf(x1 * sn + x2 * cc);
    }
}
template <bool FINAL, bool OUT8>
__device__ __forceinline__ void phase_combine(const Params& p, LAS unsigned char* lds, const float* xin, float* xnew, const float* g, const float* modl, const float* modprev, bf16_t* hout, float* fout, const unsigned* cnt_prev, const bf16_t* mres) {
    const int tid = opaque_tid(), wave = tid >> 6, lane = tid & 63;
    LAS int* base = (LAS int*)(lds + LDS_BASE_OFF);
    compute_base(cnt_prev, base);
    const int* tok_e = (const int*)(p.wp[IX_TOK]); const int* tok_pos = tok_e + 2 * M;
    const bf16_t* Y = (const bf16_t*)(p.wp[IX_Y]);
    const int stride = gridDim.x * 8;
    int m = blockIdx.x * 8 + wave;
    f32x4 xn[8]; u32x2 mn_[8]; int en0 = 0, en1 = 0, pn0 = 0, pn1 = 0;
    if (m < M) {
#pragma unroll
        for (int j = 0; j < 8; ++j) { xn[j] = *(const f32x4*)(xin + (size_t)m * D + 4 * lane + 256 * j); mn_[j] = *(const u32x2*)(mres + (size_t)m * D + 4 * lane + 256 * j); }
        en0 = tok_e[2 * m]; en1 = tok_e[2 * m + 1]; pn0 = tok_pos[2 * m]; pn1 = tok_pos[2 * m + 1]; }
    for (; m < M; m += stride) {
        const int b = m / T;
        f32x4 xv[8]; u32x2 mv[8];
#pragma unroll
        for (int j = 0; j < 8; ++j) { xv[j] = xn[j]; mv[j] = mn_[j]; }
        const size_t r0 = (size_t)(base[en0] + pn0), r1 = (size_t)(base[en1] + pn1);
        u32x2 ya[8], yb[8];
#pragma unroll
        for (int j = 0; j < 8; ++j) { const int c = 4 * lane + 256 * j; ya[j] = *(const u32x2*)(Y + r0 * D + c); yb[j] = *(const u32x2*)(Y + r1 * D + c); }
        const int mn = m + stride;
        if (mn < M) {
#pragma unroll
            for (int j = 0; j < 8; ++j) { xn[j] = *(const f32x4*)(xin + (size_t)mn * D + 4 * lane + 256 * j); mn_[j] = *(const u32x2*)(mres + (size_t)mn * D + 4 * lane + 256 * j); }
            en0 = tok_e[2 * mn]; en1 = tok_e[2 * mn + 1]; pn0 = tok_pos[2 * mn]; pn1 = tok_pos[2 * mn + 1]; }
        const float* gt = modprev + (size_t)b * 12288 + 5 * D; const float* gta = modprev + (size_t)b * 12288 + 2 * D;
        float ss = 0.f;
#pragma unroll
        for (int j = 0; j < 8; ++j) { const int c = 4 * lane + 256 * j; const f32x4 gv = *(const f32x4*)(gt + c), ga = *(const f32x4*)(gta + c); const u32x2 a = ya[j], bb = yb[j], mm = mv[j];
            xv[j].x += ga.x * __uint_as_float(mm.x << 16); xv[j].y += ga.y * __uint_as_float(mm.x & 0xffff0000u); xv[j].z += ga.z * __uint_as_float(mm.y << 16); xv[j].w += ga.w * __uint_as_float(mm.y & 0xffff0000u);
            xv[j].x += gv.x * (__uint_as_float(a.x << 16) + __uint_as_float(bb.x << 16)); xv[j].y += gv.y * (__uint_as_float(a.x & 0xffff0000u) + __uint_as_float(bb.x & 0xffff0000u));
            xv[j].z += gv.z * (__uint_as_float(a.y << 16) + __uint_as_float(bb.y << 16)); xv[j].w += gv.w * (__uint_as_float(a.y & 0xffff0000u) + __uint_as_float(bb.y & 0xffff0000u));
            if (!FINAL) *(f32x4*)(xnew + (size_t)m * D + c) = xv[j];
            ss += xv[j].x * xv[j].x + xv[j].y * xv[j].y + xv[j].z * xv[j].z + xv[j].w * xv[j].w; }
        ss = wave_sum(ss);
        const float rstd = 1.0f / sqrtf(ss * (1.f / D) + EPS);
        if (FINAL) {
#pragma unroll
            for (int j = 0; j < 8; ++j) { const int c = 4 * lane + 256 * j; const f32x4 gv = *(const f32x4*)(g + c); *(f32x4*)(fout + (size_t)m * D + c) = xv[j] * rstd * gv; }
        } else {
            const float* sh = modl + (size_t)b * 12288; const float* sc = modl + (size_t)b * 12288 + D;
#pragma unroll
            for (int j = 0; j < 8; ++j) { const int c = 4 * lane + 256 * j;
                const f32x4 gv = *(const f32x4*)(g + c), shv = *(const f32x4*)(sh + c), scv = *(const f32x4*)(sc + c);
                const f32x4 hv = xv[j] * rstd * gv * (1.f + scv) + shv;
                if (OUT8) *(unsigned*)((unsigned char*)hout + (size_t)m * D + c) = pk4_fp8(hv.x * F8_SA, hv.y * F8_SA, hv.z * F8_SA, hv.w * F8_SA);
                else { u32x2 o; o.x = pk2(hv.x, hv.y); o.y = pk2(hv.z, hv.w); *(u32x2*)(hout + (size_t)m * D + c) = o; } }
        }
    }
}

__device__ __forceinline__ void conv_item(const float* W, int K, int N, bf16_t* WT, int k0, int n0, int drow0, LAS unsigned* scr, int lane, bool rperm = false) {
    const int q = lane >> 4, n4 = lane & 15;
    f32x4 va[8], vb[8];
#pragma unroll
    for (int i = 0; i < 8; ++i) { const int rp = 4 * i + q;
        va[i] = *(const f32x4*)(W + (size_t)(k0 + 2 * rp) * N + n0 + 4 * n4); vb[i] = *(const f32x4*)(W + (size_t)(k0 + 2 * rp + 1) * N + n0 + 4 * n4); }
#pragma unroll
    for (int i = 0; i < 8; ++i) { const int rp = 4 * i + q; LAS unsigned* sp = scr + (4 * n4) * 33 + rp;
        sp[0] = pk2(va[i].x, vb[i].x); sp[33] = pk2(va[i].y, vb[i].y); sp[66] = pk2(va[i].z, vb[i].z); sp[99] = pk2(va[i].w, vb[i].w); }
    asm volatile("s_waitcnt lgkmcnt(0)" ::: "memory");
    const int c = lane & 7;
#pragma unroll
    for (int j = 0; j < 8; ++j) {
        const int n = (lane >> 3) + 8 * j; const LAS unsigned* sp = scr + n * 33 + 4 * c;
        u32x4 o; o.x = sp[0]; o.y = sp[1]; o.z = sp[2]; o.w = sp[3];
        const int nr = (rperm && n < 32) ? ((n < 16) ? 2 * n : 2 * (n - 16) + 1) : n;
        *(u32x4*)(WT + (size_t)(drow0 + nr) * K + k0 + 8 * c) = o;
    }
    asm volatile("s_waitcnt lgkmcnt(0)" ::: "memory");
}
__device__ __forceinline__ void conv_item8(const float* W, int K, int N, unsigned char* WT, int k0, int n0, int drow0, LAS unsigned* scr, int lane, float sc, bool rperm = false) {
    const int q = lane >> 4, n4 = lane & 15;
    f32x4 v[4][4];
#pragma unroll
    for (int i = 0; i < 4; ++i)
#pragma unroll
        for (int t = 0; t < 4; ++t) v[i][t] = __builtin_nontemporal_load((const f32x4*)(W + (size_t)(k0 + 4 * (4 * i + q) + t) * N + n0 + 4 * n4));
#pragma unroll
    for (int i = 0; i < 4; ++i) { const int rp = 4 * i + q; LAS unsigned* sp = scr + (4 * n4) * 17 + rp;
        sp[0]  = pk4_fp8(v[i][0].x * sc, v[i][1].x * sc, v[i][2].x * sc, v[i][3].x * sc);
        sp[17] = pk4_fp8(v[i][0].y * sc, v[i][1].y * sc, v[i][2].y * sc, v[i][3].y * sc);
        sp[34] = pk4_fp8(v[i][0].z * sc, v[i][1].z * sc, v[i][2].z * sc, v[i][3].z * sc);
        sp[51] = pk4_fp8(v[i][0].w * sc, v[i][1].w * sc, v[i][2].w * sc, v[i][3].w * sc); }
    asm volatile("s_waitcnt lgkmcnt(0)" ::: "memory");
    const int c = lane & 3;
#pragma unroll
    for (int j = 0; j < 4; ++j) {
        const int n = (lane >> 2) + 16 * j; const LAS unsigned* sp = scr + n * 17 + 4 * c;
        u32x4 o; o.x = sp[0]; o.y = sp[1]; o.z = sp[2]; o.w = sp[3];
        const int nr = (rperm && n < 32) ? ((n < 16) ? 2 * n : 2 * (n - 16) + 1) : n;
        *(u32x4*)(WT + (size_t)(drow0 + nr) * K + k0 + 16 * c) = o;
    }
    asm volatile("s_waitcnt lgkmcnt(0)" ::: "memory");
}
namespace cv {
constexpr int I_IN0 = 32 * 128, I_OUT = 32 * 32, I_G = 16 * 32 * 16, I_D = 16 * 16 * 32, I_IN1 = 32 * 96;
constexpr int I_L0 = I_IN0 + I_OUT + 2 * I_G + I_D, I_L1 = I_IN1 + I_OUT + 2 * I_G + I_D, NIT = I_L0 + I_L1;
constexpr int NIT_P0 = NIT - (2 * I_G + I_D);
constexpr int N_P0 = NIT_P0 - (2 * I_G + I_D), N_GW = 2 * I_G + I_D;
__device__ __forceinline__ int it_p0(int v) { return v < I_IN0 + I_OUT ? v : v + N_GW; }
}
__device__ __forceinline__ void conv_dispatch(const Params& p, int it, LAS unsigned* scr, int lane) {
    using namespace cv;
    int r = it; const int l = (r >= I_L0) ? 1 : 0; if (l) r -= I_L0;
    const int i_in = l ? I_IN1 : I_IN0;
    if (r < i_in) { const int N = l ? ODW : EVW, nb = N / 64;
        conv_item8(p.in[l ? 16 : 5], D, N, l ? p.wp[IX_WIN1] : p.wp[IX_WIN0], (r / nb) * 64, (r % nb) * 64, (r % nb) * 64, scr, lane, F8_SW, l == 1 && (r % nb) < 64 && ((r % nb) & 1) == 0);
        return; } r -= i_in;
    if (r < I_OUT) { if (OUT_F8) conv_item8(p.in[l ? 19 : 8], D, D, l ? p.wp[IX_WOUT1] : p.wp[IX_WOUT0], (r / 32) * 64, (r % 32) * 64, (r % 32) * 64, scr, lane, F8_SWD);
        else conv_item(p.in[l ? 19 : 8], D, D, (bf16_t*)(l ? p.wp[IX_WOUT1] : p.wp[IX_WOUT0]), (r / 32) * 64, (r % 32) * 64, (r % 32) * 64, scr, lane); return; } r -= I_OUT;
    if (r < 2 * I_G) { const int up = r >= I_G; if (up) r -= I_G; const int e = r / 512, rr = r % 512, kb = rr / 16, nb = rr % 16, n0 = nb * 64;
        conv_item8(p.in[(l ? 21 : 10) + up] + (size_t)e * D * DFF, D, DFF, (l ? p.wp[IX_WGU1] : p.wp[IX_WGU0]) + (size_t)e * 2048 * D, kb * 64, n0, (n0 >> 7) * 256 + (n0 & 127) + up * 128, scr, lane, F8_SW);
        return; } r -= 2 * I_G;
    { const int e = r / 512, rr = r % 512, kb = rr / 32, nb = rr % 32;
        conv_item8(p.in[l ? 23 : 12] + (size_t)e * DFF * D, DFF, D, (l ? p.wp[IX_WD1] : p.wp[IX_WD0]) + (size_t)e * D * DFF, kb * 64, nb * 64, nb * 64, scr, lane, F8_SWD); }
}
__device__ __forceinline__ void phase_convert(const Params& p, LAS unsigned char* lds) {
    const int tid_ = opaque_tid(), wave = tid_ >> 6, lane = tid_ & 63;
    LAS unsigned* scr = (LAS unsigned*)lds + wave * (64 * 33);
    constexpr int HEAD = 4096; const int nfree = (int)gridDim.x - 192;
    const int NIT = cv::N_P0, nhead = (nfree > 0) ? HEAD : 0;
    for (int pass = 0; pass < 2; ++pass)
    for (int it = (pass == 0) ? (((int)blockIdx.x - 192) * 8 + wave) : (nhead + (int)blockIdx.x * 8 + wave); (pass == 0) ? (nfree > 0 && (int)blockIdx.x >= 192 && it < nhead) : (it < NIT); it += ((pass == 0) ? nfree : (int)gridDim.x) * 8)
        conv_dispatch(p, cv::it_p0(it), scr, lane);
}
struct ConvHook { const Params* p; LAS unsigned char* lds; int slot; bool done;
    __device__ __forceinline__ void run() { done = true;
        const int tid_ = opaque_tid(), wave = tid_ >> 6, lane = tid_ & 63;
        if (wave < 7) { LAS unsigned* scr = (LAS unsigned*)(lds + 131072) + wave * (64 * 17);
            for (int v = (int)blockIdx.x * 7 + wave; v < cv::N_GW; v += (int)gridDim.x * 7) conv_dispatch(*p, cv::I_IN0 + cv::I_OUT + v, scr, lane); } }
    __device__ __forceinline__ void operator()(int ui) { if (ui == slot) run(); }
};
struct NoHook { __device__ __forceinline__ void operator()(int) {} };
__device__ __forceinline__ void convert_late(const Params& p, LAS unsigned char* lds) {
    const int tid_ = opaque_tid(), wave = tid_ >> 6, lane = tid_ & 63;
    LAS unsigned* scr = (LAS unsigned*)lds + wave * (64 * 33);
    for (int it = cv::NIT_P0 + (int)blockIdx.x * 8 + wave; it < cv::NIT; it += (int)gridDim.x * 8) conv_dispatch(p, it, scr, lane);
    __syncthreads();
}
namespace pg8 {
typedef short bf16x8 __attribute__((ext_vector_type(8)));
typedef int v4i_t __attribute__((ext_vector_type(4)));
typedef int v8i_t __attribute__((ext_vector_type(8)));
constexpr int BM = 256, BK = 64, HALF = 128, HTB = HALF * BK * 2, STAGE_BYTES = 8 * HTB, NXCD = 8, WGM = 8;
__host__ __device__ __forceinline__ int lds_byte(int r, int c) { const int st = (r >> 4) * 2 + (c >> 5), rr = r & 15, cc = c & 31, ob = rr * 64 + cc * 2; return st * 1024 + (ob ^ (((ob >> 9) & 1) << 5)); }
__host__ __device__ __forceinline__ void stage_rc(int b, int& R, int& C) { const int st = b / 1024, sb = b % 1024, swz = sb ^ (((sb >> 9) & 1) << 5); R = (st >> 1) * 16 + swz / 64; C = (st & 1) * 32 + (swz % 64) / 2; }
__host__ __device__ __forceinline__ int perm32(int rho) { const int n = rho >> 4, i = rho & 15; return 8 * (i >> 2) + 4 * n + (i & 3); }
struct Unit { int pm, pn, e; };
struct StaticOrder {
    static constexpr bool GATHER = false, SIGF = false, WAITF = false;
    int nM, nN, nwg, G, c;
    __device__ void init(int M_, int N_, int G_, int c_) { nM = M_ / BM; nN = N_ / BM; nwg = nM * nN; G = G_; c = c_; }
    __device__ __forceinline__ bool next(int i, Unit& u) const {
        const long L = (long)i * G + c; if (L >= nwg) return false;
        int wgid = (int)L; { const int q = nwg / NXCD, r = nwg % NXCD, xcd = wgid % NXCD, off = wgid / NXCD; wgid = (xcd < r ? xcd * (q + 1) : r * (q + 1) + (xcd - r) * q) + off; }
        const int nig = WGM * nN, gid = wgid / nig, fm = gid * WGM, gsz = (nM - fm) < WGM ? (nM - fm) : WGM;
        u.pm = fm + ((wgid % nig) % gsz); u.pn = (wgid % nig) / gsz; u.e = 0; return true;
    }
    __device__ __forceinline__ size_t brow(const Unit& u) const { return (size_t)u.pn * BM; }
    __device__ __forceinline__ unsigned arow(const Unit&, int) const { return 0u; }
};
template <bool GATHER_, int TG = 0, bool SIGF_ = false, bool WAITF_ = false>
struct MoeOrder {
    static constexpr bool GATHER = GATHER_, SIGF = SIGF_, WAITF = WAITF_;
    const LAS int* base; const int* list; const unsigned* cnt; int G, c, nT; unsigned* flg;
    __device__ __forceinline__ bool next(int i, Unit& u) const {
        int pm, pn;
        if ((G & 63) == 0) { const int xcd = (c + (WAITF ? 3 : 0)) & 7, j = c >> 3, rt = G >> 6;
            const int nfull = nT / (8 * rt);
            if (i < nfull) pm = (i * 8 + xcd) * rt + (j >> 3);
            else { const int s = (i - nfull) * rt + (((j >> 3) + TG) % rt); pm = nfull * 8 * rt + s * 8 + xcd; }
            pn = j & 7; }
        else { const int L = i * G + c; pm = L >> 3; pn = L & 7; }
        if (pm >= nT) return false;
        u.pm = pm; u.pn = pn; int e = 0;
#pragma unroll
        for (int q = 1; q < NE; ++q) e += (pm * BM >= base[q]) ? 1 : 0;
        u.e = e; return true;
    }
    __device__ __forceinline__ void wait(const Unit& u) const {
        while (__hip_atomic_load(flg + u.pm, __ATOMIC_RELAXED, __HIP_MEMORY_SCOPE_AGENT) < 8u) __builtin_amdgcn_s_sleep(2);
        asm volatile("" ::: "memory");
    }
    __device__ __forceinline__ size_t brow(const Unit& u) const { return (size_t)u.e * 2048 + (size_t)u.pn * BM; }
    __device__ __forceinline__ unsigned arow(const Unit& u, int r) const { const int pos = u.pm * BM + r - base[u.e]; const unsigned t = (unsigned)list[u.e * M + pos]; return (pos < (int)cnt[u.e]) ? t : 0u; }
};

struct EpiBf16 { static constexpr bool PERM = true; bf16_t* O; int ldc; float sc = 1.f;
    __device__ __forceinline__ void operator()(const f32x4 (&acc)[2][2][4][2], const Unit& u, int wr, int wc, int fr, int fq) const {
        const int row0 = u.pm * BM + wr * 64 + fr, col0 = u.pn * BM + wc * 32 + 8 * fq;
#pragma unroll
        for (int ai = 0; ai < 2; ++ai)
#pragma unroll
            for (int m = 0; m < 4; ++m) { bf16_t* rowp = O + (size_t)(row0 + ai * HALF + m * 16) * ldc + col0;
#pragma unroll
                for (int bj = 0; bj < 2; ++bj) { const f32x4 v0 = acc[ai][bj][m][0] * sc, v1 = acc[ai][bj][m][1] * sc;
                    u32x4 w; w.x = pk2(v0[0], v0[1]); w.y = pk2(v0[2], v0[3]); w.z = pk2(v1[0], v1[1]); w.w = pk2(v1[2], v1[3]);
                    *(u32x4*)(rowp + bj * HALF) = w; } }
    }
};
struct EpiProj0 { static constexpr bool PERM = true; bf16_t* O; int ldc; float sc;
    __device__ __forceinline__ void operator()(const f32x4 (&acc)[2][2][4][2], const Unit& u, int wr, int wc, int fr, int fq) const {
        const int row0 = u.pm * BM + wr * 64 + fr, col0 = u.pn * BM + wc * 32 + 8 * fq; const int mode = (u.pn < 4 || (u.pn >= 16 && u.pn < 20)) ? 1 : ((u.pn >= 8 && u.pn < 16) ? 2 : 0);
#pragma unroll
        for (int ai = 0; ai < 2; ++ai)
#pragma unroll
            for (int m = 0; m < 4; ++m) { bf16_t* rowp = O + (size_t)(row0 + ai * HALF + m * 16) * ldc + col0;
#pragma unroll
                for (int bj = 0; bj < 2; ++bj) { f32x4 v0 = acc[ai][bj][m][0] * sc, v1 = acc[ai][bj][m][1] * sc;
                    if (mode == 1) {
#pragma unroll
                        for (int e = 0; e < 4; ++e) { v0[e] = silu(v0[e]); v1[e] = silu(v1[e]); } }
                    else if (mode == 2) {
#pragma unroll
                        for (int e = 0; e < 4; ++e) { v0[e] = frcp(1.f + __expf(v0[e])); v1[e] = frcp(1.f + __expf(v1[e])); } }
                    u32x4 w; w.x = pk2(v0[0], v0[1]); w.y = pk2(v0[2], v0[3]); w.z = pk2(v1[0], v1[1]); w.w = pk2(v1[2], v1[3]);
                    *(u32x4*)(rowp + bj * HALF) = w; } }
    }
};
struct EpiBf16Rope { static constexpr bool PERM = true; bf16_t* O; int ldc; const float* rc; const float* rs; float sc;
    __device__ __forceinline__ void operator()(const f32x4 (&acc)[2][2][4][2], const Unit& u, int wr, int wc, int fr, int fq) const {
        const int row0 = u.pm * BM + wr * 64 + fr, col0 = u.pn * BM + wc * 32 + 8 * fq; const bool rot = (u.pn < 16) && (wc == 0);
#pragma unroll
        for (int ai = 0; ai < 2; ++ai)
#pragma unroll
            for (int m = 0; m < 4; ++m) { const int row = row0 + ai * HALF + m * 16; bf16_t* rowp = O + (size_t)row * ldc + col0;
                f32x4 cv = {1.f, 1.f, 1.f, 1.f}, sv = {0.f, 0.f, 0.f, 0.f};
                if (rot) { const int pos = row & (T - 1); cv = *(const f32x4*)(rc + pos * 16 + 4 * fq); sv = *(const f32x4*)(rs + pos * 16 + 4 * fq); }
#pragma unroll
                for (int bj = 0; bj < 2; ++bj) { f32x4 v0 = acc[ai][bj][m][0] * sc, v1 = acc[ai][bj][m][1] * sc;
                    if (rot) { const f32x4 a = v0, b = v1;
                        v0[0] = a[0] * cv[0] - a[1] * sv[0]; v0[1] = a[0] * sv[0] + a[1] * cv[0]; v0[2] = a[2] * cv[1] - a[3] * sv[1]; v0[3] = a[2] * sv[1] + a[3] * cv[1];
                        v1[0] = b[0] * cv[2] - b[1] * sv[2]; v1[1] = b[0] * sv[2] + b[1] * cv[2]; v1[2] = b[2] * cv[3] - b[3] * sv[3]; v1[3] = b[2] * sv[3] + b[3] * cv[3]; }
                    u32x4 w; w.x = pk2(v0[0], v0[1]); w.y = pk2(v0[2], v0[3]); w.z = pk2(v1[0], v1[1]); w.w = pk2(v1[2], v1[3]);
                    *(u32x4*)(rowp + bj * HALF) = w; } }
    }
};
struct EpiResF32 { static constexpr bool PERM = false; const float* xin; float* xout; const float* gt; float sc = 1.f;
    __device__ __forceinline__ void operator()(const f32x4 (&acc)[2][2][4][2], const Unit& u, int wr, int wc, int fr, int fq) const {
        const int row0 = u.pm * BM + wr * 64 + fr, col0 = u.pn * BM + wc * 32 + 4 * fq; const int b = (u.pm * BM) / T;
        f32x4 gv[2][2];
#pragma unroll
        for (int bj = 0; bj < 2; ++bj)
#pragma unroll
            for (int n = 0; n < 2; ++n) gv[bj][n] = *(const f32x4*)(gt + (size_t)b * 12288 + col0 + bj * HALF + n * 16);
        f32x4 xi[2][2][2];
#pragma unroll
        for (int bj = 0; bj < 2; ++bj)
#pragma unroll
            for (int n = 0; n < 2; ++n) xi[0][bj][n] = *(const f32x4*)(xin + (size_t)row0 * D + col0 + bj * HALF + n * 16);
#pragma unroll
        for (int g = 0; g < 8; ++g) { const int ai = g >> 2, m = g & 3; const size_t off = (size_t)(row0 + ai * HALF + m * 16) * D + col0;
            if (g + 1 < 8) { const int ai2 = (g + 1) >> 2, m2 = (g + 1) & 3; const size_t off2 = (size_t)(row0 + ai2 * HALF + m2 * 16) * D + col0;
#pragma unroll
                for (int bj = 0; bj < 2; ++bj)
#pragma unroll
                    for (int n = 0; n < 2; ++n) xi[(g + 1) & 1][bj][n] = *(const f32x4*)(xin + off2 + bj * HALF + n * 16); }
            __builtin_amdgcn_sched_barrier(0);
#pragma unroll
            for (int bj = 0; bj < 2; ++bj)
#pragma unroll
                for (int n = 0; n < 2; ++n) *(f32x4*)(xout + off + bj * HALF + n * 16) = xi[g & 1][bj][n] + gv[bj][n] * (acc[ai][bj][m][n] * sc);
            __builtin_amdgcn_sched_barrier(0); }
    }
};
struct EpiGluBf16 { static constexpr bool PERM = true; bf16_t* H; const float* lw; const unsigned* cnt; const LAS int* base;
    __device__ __forceinline__ void operator()(const f32x4 (&acc)[2][2][4][2], const Unit& u, int wr, int wc, int fr, int fq) const {
        const int row0 = u.pm * BM + wr * 64 + fr, col0 = u.pn * HALF + wc * 32 + 8 * fq; const int eb = base[u.e], ec = (int)cnt[u.e];
#pragma unroll
        for (int ai = 0; ai < 2; ++ai)
#pragma unroll
            for (int m = 0; m < 4; ++m) { const int row = row0 + ai * HALF + m * 16, pos = row - eb; const float w = (pos < ec) ? lw[u.e * M + pos] : 0.f;
                const f32x4 g0 = acc[ai][0][m][0], g1 = acc[ai][0][m][1], u0 = acc[ai][1][m][0], u1 = acc[ai][1][m][1];
                u32x4 o; o.x = pk2(silu(g0[0]) * u0[0] * w, silu(g0[1]) * u0[1] * w); o.y = pk2(silu(g0[2]) * u0[2] * w, silu(g0[3]) * u0[3] * w);
                o.z = pk2(silu(g1[0]) * u1[0] * w, silu(g1[1]) * u1[1] * w); o.w = pk2(silu(g1[2]) * u1[2] * w, silu(g1[3]) * u1[3] * w);
                *(u32x4*)(H + (size_t)row * DFF + col0) = o; }
    }
};

struct EpiGluF8 { static constexpr bool PERM = true; unsigned char* H; const float* lw; const unsigned* cnt; const LAS int* base;
    __device__ __forceinline__ void operator()(const f32x4 (&acc)[2][2][4][2], const Unit& u, int wr, int wc, int fr, int fq) const {
        const int row0 = u.pm * BM + wr * 64 + fr, col0 = u.pn * HALF + wc * 32 + 8 * fq; const int eb = base[u.e], ec = (int)cnt[u.e];
        constexpr float DQ = 1.f / (F8_SA * F8_SW);
        float wrow[8];
#pragma unroll
        for (int g = 0; g < 8; ++g) { const int pos = row0 + (g >> 2) * HALF + (g & 3) * 16 - eb; wrow[g] = lw[u.e * M + pos]; wrow[g] = (pos < ec) ? wrow[g] * (F8_SH * DQ) : 0.f; }
#pragma unroll
        for (int ai = 0; ai < 2; ++ai)
#pragma unroll
            for (int m = 0; m < 4; ++m) { const int row = row0 + ai * HALF + m * 16; const float w = wrow[ai * 4 + m];
                const f32x4 g0 = acc[ai][0][m][0] * DQ, g1 = acc[ai][0][m][1] * DQ, u0 = acc[ai][1][m][0], u1 = acc[ai][1][m][1];
                u32x2 o; o.x = pk4_fp8(silu(g0[0]) * u0[0] * w, silu(g0[1]) * u0[1] * w, silu(g0[2]) * u0[2] * w, silu(g0[3]) * u0[3] * w);
                o.y = pk4_fp8(silu(g1[0]) * u1[0] * w, silu(g1[1]) * u1[1] * w, silu(g1[2]) * u1[2] * w, silu(g1[3]) * u1[3] * w);
                __hip_atomic_store((unsigned long long*)(H + (size_t)row * DFF + col0), ((unsigned long long)o.y << 32) | (unsigned long long)o.x, __ATOMIC_RELAXED, __HIP_MEMORY_SCOPE_AGENT); }
    }
};
template <class Epi, class Sched, bool ALIGN_EPI, bool SP2, bool F8 = false, class Hook = NoHook>
__device__ __forceinline__ void gemm_phase(LAS unsigned char* lds, const void* Ap, const void* Btp, const int K, const Sched& S, const Epi& E, Hook&& hook = Hook{}) {
    constexpr bool GATHER = Sched::GATHER; constexpr int ESZ = F8 ? 1 : 2;
    const int tid = opaque_tid(), wid = __builtin_amdgcn_readfirstlane(tid >> 6), lane = tid & 63, wr = wid >> 2, wc = wid & 3, fr = lane & 15, fq = lane >> 4;
    const int nt = K * ESZ / (BK * 2);
    unsigned voffA[2], voffB[2]; int sR[2], sC[2];
#pragma unroll
    for (int i = 0; i < 2; ++i) { int R, C; stage_rc(tid * 16 + i * 8192, R, C); const int Rb = Epi::PERM ? ((R & ~31) + perm32(R & 31)) : R; sR[i] = R; sC[i] = C;
        voffA[i] = (unsigned)(R * K * ESZ + C * 2); voffB[i] = (unsigned)(Rb * K * ESZ + C * 2); }
    const size_t kstep = (size_t)(BK * 2);
    const size_t hstep = (size_t)HALF * K * ESZ;
    const size_t tstep = 2 * hstep;
    const unsigned ldsw = (unsigned)wid * 1024u;
    const int aoff = lds_byte(wr * 64 + fr, fq * 8), boff = lds_byte(wc * 32 + fr, fq * 8);
#define PG8_SA(b, h) (((b) * 2 + (h)) * HTB)
#define PG8_SB(b, h) ((4 + (b) * 2 + (h)) * HTB)
#define PG8_ST2X(bufoff, gbase, o0, o1, AUX) do { unsigned _a = (o0), _b = (o1); asm volatile("" : "+v"(_a), "+v"(_b));   \
        __builtin_amdgcn_global_load_lds((const unsigned*)((const char*)(gbase) + _a), (LAS unsigned*)(lds + (bufoff) + ldsw), 16, 0, AUX); \
        __builtin_amdgcn_global_load_lds((const unsigned*)((const char*)(gbase) + _b), (LAS unsigned*)(lds + (bufoff) + ldsw + 8192), 16, 0, AUX); } while (0)
#define PG8_ST2(bufoff, gbase, o0, o1) PG8_ST2X(bufoff, gbase, o0, o1, 0)
#define PG8_STAGEB(bufoff, gbase) PG8_ST2(bufoff, gbase, voffB[0], voffB[1])
#define PG8_STAGEA(bufoff, P, KB, OV, h) do { if constexpr (GATHER) PG8_ST2(bufoff, (const char*)Ap + (KB), OV[h][0], OV[h][1]); else if constexpr (Sched::WAITF) PG8_ST2X(bufoff, (P) + (h) * hstep, voffA[0], voffA[1], 16);   else PG8_ST2(bufoff, (P) + (h) * hstep, voffA[0], voffA[1]); } while (0)
#define PG8_LDA(dst, b, h) do { _Pragma("unroll") for (int m = 0; m < 4; ++m) { if constexpr (F8) dst##8[m] = __builtin_shufflevector(*(const LAS v4i_t*)(lds + PG8_SA(b, h) + aoff + m * 2048), *(const LAS v4i_t*)(lds + PG8_SA(b, h) + aoff + m * 2048 + 1024), 0, 1, 2, 3, 4, 5, 6, 7); \
        else { _Pragma("unroll") for (int k = 0; k < 2; ++k) dst[m][k] = *(const LAS bf16x8*)(lds + PG8_SA(b, h) + aoff + m * 2048 + k * 1024); } } } while (0)
#define PG8_LDB(dst, b, h) do { _Pragma("unroll") for (int n = 0; n < 2; ++n) { if constexpr (F8) dst##8[n] = __builtin_shufflevector(*(const LAS v4i_t*)(lds + PG8_SB(b, h) + boff + n * 2048), *(const LAS v4i_t*)(lds + PG8_SB(b, h) + boff + n * 2048 + 1024), 0, 1, 2, 3, 4, 5, 6, 7); \
        else { _Pragma("unroll") for (int k = 0; k < 2; ++k) dst[n][k] = *(const LAS bf16x8*)(lds + PG8_SB(b, h) + boff + n * 2048 + k * 1024); } } } while (0)
#define PG8_CAT(x) __builtin_shufflevector(__builtin_bit_cast(v4i_t, (x)[0]), __builtin_bit_cast(v4i_t, (x)[1]), 0, 1, 2, 3, 4, 5, 6, 7)
#define PG8_MMA(ai, bj, At, Bt) do { __builtin_amdgcn_s_setprio(1); _Pragma("unroll") for (int m = 0; m < 4; ++m) _Pragma("unroll") for (int n = 0; n < 2; ++n) { \
        if constexpr (F8) asm volatile("v_mfma_scale_f32_16x16x128_f8f6f4 %0, %1, %2, %0, %3, %3 op_sel_hi:[0,0,0]" : "+v"(acc[ai][bj][m][n]) : "v"(Bt##8[n]), "v"(At##8[m]), "v"(sc127));   \
        else { _Pragma("unroll") for (int k = 0; k < 2; ++k) acc[ai][bj][m][n] = __builtin_amdgcn_mfma_f32_16x16x32_bf16(Bt[n][k], At[m][k], acc[ai][bj][m][n], 0, 0, 0); } } __builtin_amdgcn_s_setprio(0); } while (0)
#define PG8_WAIT_V(n) asm volatile("s_waitcnt vmcnt(" #n ")" ::: "memory")
#define PG8_WAIT_L(n) asm volatile("s_waitcnt lgkmcnt(" #n ")" ::: "memory")
#define PG8_BAR __builtin_amdgcn_s_barrier()
#define PG8_SCHED __builtin_amdgcn_sched_barrier(0)
    Unit cur, nxt; int ui = 0;
    if (!S.next(0, cur)) return;
    if constexpr (Sched::WAITF) S.wait(cur);
    f32x4 acc[2][2][4][2];
#pragma unroll
    for (int a = 0; a < 2; ++a)
#pragma unroll
        for (int b = 0; b < 2; ++b)
#pragma unroll
            for (int m = 0; m < 4; ++m)
#pragma unroll
                for (int n = 0; n < 2; ++n) acc[a][b][m][n] = (f32x4){0.f, 0.f, 0.f, 0.f};
    const int sc127 = 0x7F7F7F7F;
    bf16x8 At[4][2], B0[2][2], B1[2][2]; v8i_t At8[4], B08[2], B18[2];
    unsigned vc[2][2] = {{0u, 0u}, {0u, 0u}}, vn[2][2] = {{0u, 0u}, {0u, 0u}};
    if constexpr (GATHER) {
#pragma unroll
        for (int h = 0; h < 2; ++h)
#pragma unroll
            for (int i = 0; i < 2; ++i) vc[h][i] = S.arow(cur, h * HALF + sR[i]) * (unsigned)(K * ESZ) + (unsigned)sC[i] * 2u;
    }
    const char* cA = (const char*)Ap + (GATHER ? (size_t)0 : (size_t)cur.pm * tstep); const char* cB = (const char*)Btp + S.brow(cur) * (size_t)K * ESZ;
    if constexpr (SP2) {
        PG8_STAGEB(PG8_SB(0, 0), cB); PG8_STAGEB(PG8_SB(0, 1), cB + hstep); PG8_STAGEA(PG8_SA(0, 0), cA, 0, vc, 0); PG8_STAGEA(PG8_SA(0, 1), cA, 0, vc, 1);
        if (wr == 1) PG8_BAR;
        PG8_WAIT_V(2); PG8_BAR;
        PG8_STAGEB(PG8_SB(1, 0), cB + kstep); PG8_STAGEA(PG8_SA(1, 0), cA + kstep, kstep, vc, 0); PG8_STAGEB(PG8_SB(1, 1), cB + hstep + kstep);
        PG8_WAIT_V(6); PG8_BAR;
    } else {
        PG8_STAGEB(PG8_SB(0, 0), cB); PG8_STAGEA(PG8_SA(0, 0), cA, 0, vc, 0); PG8_STAGEB(PG8_SB(0, 1), cB + hstep); PG8_STAGEA(PG8_SA(0, 1), cA, 0, vc, 1);
        if (wr == 1) PG8_BAR;
        PG8_WAIT_V(4); PG8_BAR;
        PG8_STAGEB(PG8_SB(1, 0), cB + kstep); PG8_STAGEA(PG8_SA(1, 0), cA + kstep, kstep, vc, 0); PG8_STAGEB(PG8_SB(1, 1), cB + hstep + kstep);
        PG8_WAIT_V(6); PG8_BAR;
    }
    for (;;) {
        const bool has_next = S.next(ui + 1, nxt);
        if constexpr (Sched::WAITF) { if (has_next) S.wait(nxt); }
        const char* nA = (has_next && !GATHER) ? (const char*)Ap + (size_t)nxt.pm * tstep : cA; const char* nB = has_next ? (const char*)Btp + S.brow(nxt) * (size_t)K * ESZ : cB;
        if constexpr (GATHER) {
#pragma unroll
            for (int h = 0; h < 2; ++h)
#pragma unroll
                for (int i = 0; i < 2; ++i) vn[h][i] = has_next ? S.arow(nxt, h * HALF + sR[i]) * (unsigned)(K * ESZ) + (unsigned)sC[i] * 2u : vc[h][i];
        }
#pragma unroll 1
        for (int t = 0; t < nt; t += 2) {
            const bool last = (t == nt - 2);
            const char* a1 = cA + (size_t)(t + 1) * kstep; const size_t kb1 = (size_t)(t + 1) * kstep;
            const char* a2 = last ? nA : cA + (size_t)(t + 2) * kstep; const char* b2 = last ? nB : cB + (size_t)(t + 2) * kstep;
            const char* a3 = a2 + kstep; const char* b3 = b2 + kstep;
            const size_t kb2 = last ? (size_t)0 : (size_t)(t + 2) * kstep, kb3 = kb2 + kstep;
            unsigned v2[2][2];
#pragma unroll
            for (int h = 0; h < 2; ++h)
#pragma unroll
                for (int i = 0; i < 2; ++i) v2[h][i] = last ? vn[h][i] : vc[h][i];
            if constexpr (SP2) {
            PG8_LDB(B0, 0, 0); PG8_LDB(B1, 0, 1); PG8_SCHED; PG8_LDA(At, 0, 0); PG8_STAGEA(PG8_SA(1, 1), a1, kb1, vc, 1);
            PG8_WAIT_V(8); PG8_WAIT_L(0); PG8_BAR; PG8_MMA(0, 0, At, B0); PG8_MMA(0, 1, At, B1); PG8_BAR; PG8_SCHED;
            PG8_LDA(At, 0, 1); PG8_STAGEB(PG8_SB(0, 0), b2); PG8_STAGEB(PG8_SB(0, 1), b2 + hstep); PG8_STAGEA(PG8_SA(0, 0), a2, kb2, v2, 0);
            PG8_WAIT_V(8); PG8_WAIT_L(0); PG8_BAR; PG8_MMA(1, 0, At, B0); PG8_MMA(1, 1, At, B1); PG8_BAR; PG8_SCHED;
            PG8_LDB(B0, 1, 0); PG8_LDB(B1, 1, 1); PG8_SCHED; PG8_LDA(At, 1, 0); PG8_STAGEA(PG8_SA(0, 1), a2, kb2, v2, 1);
            PG8_WAIT_V(8); PG8_WAIT_L(0); PG8_BAR; PG8_MMA(0, 0, At, B0); PG8_MMA(0, 1, At, B1); PG8_BAR; PG8_SCHED;
            PG8_LDA(At, 1, 1); PG8_STAGEB(PG8_SB(1, 0), b3); PG8_STAGEB(PG8_SB(1, 1), b3 + hstep); PG8_STAGEA(PG8_SA(1, 0), a3, kb3, v2, 0);
            PG8_WAIT_V(8); PG8_WAIT_L(0); PG8_BAR; PG8_MMA(1, 0, At, B0); PG8_MMA(1, 1, At, B1); PG8_BAR; PG8_SCHED;
            } else {
            PG8_LDB(B0, 0, 0); PG8_SCHED; PG8_LDA(At, 0, 0); PG8_STAGEA(PG8_SA(1, 1), a1, kb1, vc, 1);
            PG8_WAIT_L(8); PG8_BAR; PG8_WAIT_L(0); PG8_MMA(0, 0, At, B0); PG8_BAR; PG8_SCHED;
            PG8_LDB(B1, 0, 1); PG8_STAGEB(PG8_SB(0, 0), b2);
            PG8_BAR; PG8_WAIT_L(0); PG8_MMA(0, 1, At, B1); PG8_BAR;
            PG8_LDA(At, 0, 1); PG8_STAGEA(PG8_SA(0, 0), a2, kb2, v2, 0);
            PG8_BAR; PG8_WAIT_L(0); PG8_MMA(1, 0, At, B0); PG8_BAR; PG8_SCHED;
            PG8_STAGEB(PG8_SB(0, 1), b2 + hstep);
            PG8_WAIT_V(6); PG8_BAR; PG8_MMA(1, 1, At, B1); PG8_BAR;
            PG8_LDB(B0, 1, 0); PG8_SCHED; PG8_LDA(At, 1, 0); PG8_STAGEA(PG8_SA(0, 1), a2, kb2, v2, 1);
            PG8_WAIT_L(8); PG8_BAR; PG8_WAIT_L(0); PG8_MMA(0, 0, At, B0); PG8_BAR; PG8_SCHED;
            PG8_LDB(B1, 1, 1); PG8_STAGEB(PG8_SB(1, 0), b3);
            PG8_BAR; PG8_WAIT_L(0); PG8_MMA(0, 1, At, B1); PG8_BAR;
            PG8_LDA(At, 1, 1); PG8_STAGEA(PG8_SA(1, 0), a3, kb3, v2, 0);
            PG8_BAR; PG8_WAIT_L(0); PG8_MMA(1, 0, At, B0); PG8_BAR; PG8_SCHED;
            PG8_STAGEB(PG8_SB(1, 1), b3 + hstep);
            PG8_WAIT_V(6); PG8_BAR; PG8_MMA(1, 1, At, B1); PG8_BAR;
            }
        }
        if constexpr (ALIGN_EPI) { if (wr == 0) PG8_BAR; }
        if constexpr (F8) { asm volatile("s_nop 15\n\ts_nop 7" ::: "memory");
#pragma unroll
            for (int a = 0; a < 2; ++a)
#pragma unroll
                for (int b = 0; b < 2; ++b)
#pragma unroll
                    for (int m = 0; m < 4; ++m)
#pragma unroll
                        for (int n = 0; n < 2; ++n) asm volatile("" : "+v"(acc[a][b][m][n])); }
        { const int tz = opaque_tid(), wz = __builtin_amdgcn_readfirstlane(tz >> 6), lz = tz & 63; E(acc, cur, wz >> 2, wz & 3, lz & 15, lz >> 4);
          if constexpr (Sched::SIGF) { asm volatile("s_waitcnt vmcnt(0)" ::: "memory");
              if (lz == 0) { const unsigned old = __hip_atomic_fetch_add((LAS unsigned*)(lds + LDS_UCNT_OFF), 1u, __ATOMIC_ACQ_REL, __HIP_MEMORY_SCOPE_WORKGROUP);
                  if ((old & 7u) == 7u) {   __hip_atomic_fetch_add(S.flg + cur.pm, 1u, __ATOMIC_RELAXED, __HIP_MEMORY_SCOPE_AGENT); } } } }
        hook(ui);
        if (!has_next) break;
#pragma unroll
        for (int a = 0; a < 2; ++a)
#pragma unroll
            for (int b = 0; b < 2; ++b)
#pragma unroll
                for (int m = 0; m < 4; ++m)
#pragma unroll
                    for (int n = 0; n < 2; ++n) acc[a][b][m][n] = (f32x4){0.f, 0.f, 0.f, 0.f};
        cur = nxt; cA = nA; cB = nB; ++ui;
        if constexpr (GATHER) {
#pragma unroll
            for (int h = 0; h < 2; ++h)
#pragma unroll
                for (int i = 0; i < 2; ++i) vc[h][i] = vn[h][i];
        }
        if constexpr (ALIGN_EPI) { if (wr == 1) PG8_BAR; }
    }
    PG8_WAIT_V(0);
    if constexpr (!ALIGN_EPI) { if (wr == 0) PG8_BAR; }
    PG8_BAR;
#undef PG8_SA
#undef PG8_SB
#undef PG8_ST2
#undef PG8_ST2X
#undef PG8_STAGEA
#undef PG8_STAGEB
#undef PG8_LDA
#undef PG8_LDB
#undef PG8_MMA
#undef PG8_CAT
#undef PG8_WAIT_V
#undef PG8_WAIT_L
#undef PG8_BAR
#undef PG8_SCHED
}
}

namespace att {
constexpr int AD = 128, NW = 8, QBLK = 32, KVBLK = 64;
constexpr float SCALE = 0.088388347648318440f;
constexpr float THR = 8.f;
constexpr int SDEPTH = 2;
constexpr int SHM_V = KVBLK * AD * 2, SHM_K = KVBLK * AD * 2, SHM_ATTN = 2 * SHM_V + 2 * SHM_K + NW * 64 * 4;
using bf16x8 = __attribute__((ext_vector_type(8))) short;
using s16x4  = __attribute__((ext_vector_type(4))) short;
using f32x16 = __attribute__((ext_vector_type(16))) float;
#define KSWZ(row, colB) ((row) * 256 + ((colB) ^ (((row) & 7) << 4)))
#define SBAR() __builtin_amdgcn_sched_barrier(0)
__device__ __forceinline__ int crow(int r, int hi) { return (r & 3) + 8 * (r >> 2) + 4 * hi; }
__device__ __forceinline__ unsigned cvtpk(float lo, float hi) { unsigned r; asm volatile("v_cvt_pk_bf16_f32 %0, %1, %2" : "=v"(r) : "v"(lo), "v"(hi)); return r; }
__device__ __forceinline__ void partialSM(f32x16& p0, f32x16& p1, float& m_reg, float& mn, float& alpha) {
  constexpr float C = SCALE * 1.4426950408889634f;
  float pmax = p0[0]; for (int r = 1; r < 16; ++r) pmax = fmaxf(pmax, p0[r]); for (int r = 0; r < 16; ++r) pmax = fmaxf(pmax, p1[r]);
  { auto rr = __builtin_amdgcn_permlane32_swap(__float_as_uint(pmax), __float_as_uint(pmax), false, false);
    pmax = fmaxf(__uint_as_float(rr[0]), __uint_as_float(rr[1])); }
  if (__builtin_expect(__all(pmax - m_reg <= THR / SCALE), 1)) { mn = m_reg; alpha = 1.f; }
  else { mn = fmaxf(m_reg, pmax); alpha = __builtin_amdgcn_exp2f((m_reg - mn) * C); m_reg = mn; }
  float mnC = -mn * C;
  for (int r = 0; r < 16; ++r) p0[r] = fmaf(p0[r], C, mnC); for (int r = 0; r < 16; ++r) p1[r] = fmaf(p1[r], C, mnC);
  for (int r = 0; r < 16; ++r) p0[r] = __builtin_amdgcn_exp2f(p0[r]);
}
__device__ __forceinline__ void finishSM(f32x16& p0, f32x16& p1, float alpha, float& l_reg, bf16x8& pa0, bf16x8& pa1, bf16x8& pa2, bf16x8& pa3) {
  for (int r = 0; r < 16; ++r) p1[r] = __builtin_amdgcn_exp2f(p1[r]);
  float ps = 0; for (int r = 0; r < 16; ++r) ps += p0[r]; for (int r = 0; r < 16; ++r) ps += p1[r];
  { auto rr = __builtin_amdgcn_permlane32_swap(__float_as_uint(ps), __float_as_uint(ps), false, false);
    ps = __uint_as_float(rr[0]) + __uint_as_float(rr[1]); }
  l_reg = l_reg * alpha + ps;
#define PK4(P, BASE, OUT) do { unsigned a0 = cvtpk(P[BASE + 0], P[BASE + 1]), a1 = cvtpk(P[BASE + 2], P[BASE + 3]);   \
    unsigned b0 = cvtpk(P[BASE + 4], P[BASE + 5]), b1 = cvtpk(P[BASE + 6], P[BASE + 7]);                              \
    auto r0 = __builtin_amdgcn_permlane32_swap(a0, b0, false, false); auto r1 = __builtin_amdgcn_permlane32_swap(a1, b1, false, false); \
    u32x4 w = {r0[0], r1[0], r0[1], r1[1]}; OUT = __builtin_bit_cast(bf16x8, w); } while (0)
  PK4(p0, 0, pa0); PK4(p0, 8, pa1); PK4(p1, 0, pa2); PK4(p1, 8, pa3);
#undef PK4
}
__device__ __forceinline__ void qkt(f32x16& p0, f32x16& p1, const LAS char* Ks, const bf16x8* qr, int r32, int hi) {
  p0 = f32x16{}; p1 = f32x16{};
#pragma unroll
  for (int d0 = 0; d0 < 8; ++d0) { int cb = (d0 * 16 + hi * 8) * 2;
    bf16x8 b0 = *(const LAS bf16x8*)(Ks + KSWZ(r32, cb));
    bf16x8 b1 = *(const LAS bf16x8*)(Ks + KSWZ(32 + r32, cb));
    p0 = __builtin_amdgcn_mfma_f32_32x32x16_bf16(b0, qr[d0], p0, 0, 0, 0);
    p1 = __builtin_amdgcn_mfma_f32_32x32x16_bf16(b1, qr[d0], p1, 0, 0, 0); }
}
__device__ __forceinline__ int v_st(int k, int c) { const int kk = (k & ~0xC) | ((k & 4) << 1) | ((k & 8) >> 1); return ((kk >> 3) * 4 + (c >> 5)) * 512 + ((kk & 7) * 32 + (c & 31)) * 2; }
__device__ __forceinline__ int v_rd_base(int lane) { return ((lane & 3) << 3) | (((lane >> 2) & 3) << 6) | (((lane >> 4) & 1) << 5) | (((lane >> 5) & 1) << 8); }
constexpr int v_rd_off(int d0, int ks, int half) { return d0 * 512 + ks * 4096 + half * 2048; }
template <int OFF> __device__ __forceinline__ s16x4 tr_read(int vb) {
  s16x4 r; asm volatile("ds_read_b64_tr_b16 %0, %1 offset:%2" : "=&v"(r) : "v"(vb), "i"(OFF) : "memory"); return r;
}
template <int D0> __device__ __forceinline__ void pv_one(f32x16& od, int vb, bf16x8 pa0, bf16x8 pa1, bf16x8 pa2, bf16x8 pa3) {
  const s16x4 l0 = tr_read<v_rd_off(D0, 0, 0)>(vb), h0 = tr_read<v_rd_off(D0, 0, 1)>(vb), l1 = tr_read<v_rd_off(D0, 1, 0)>(vb), h1 = tr_read<v_rd_off(D0, 1, 1)>(vb);
  const s16x4 l2 = tr_read<v_rd_off(D0, 2, 0)>(vb), h2 = tr_read<v_rd_off(D0, 2, 1)>(vb), l3 = tr_read<v_rd_off(D0, 3, 0)>(vb), h3 = tr_read<v_rd_off(D0, 3, 1)>(vb);
  asm volatile("s_waitcnt lgkmcnt(0)" ::: "memory"); SBAR();
#define PK(L, H) (bf16x8){L[0], L[1], L[2], L[3], H[0], H[1], H[2], H[3]}
  od = __builtin_amdgcn_mfma_f32_32x32x16_bf16(pa0, PK(l0, h0), od, 0, 0, 0);
  od = __builtin_amdgcn_mfma_f32_32x32x16_bf16(pa1, PK(l1, h1), od, 0, 0, 0);
  od = __builtin_amdgcn_mfma_f32_32x32x16_bf16(pa2, PK(l2, h2), od, 0, 0, 0);
  od = __builtin_amdgcn_mfma_f32_32x32x16_bf16(pa3, PK(l3, h3), od, 0, 0, 0);
#undef PK
}
__device__ __forceinline__ void pv_d0(f32x16* o, int vb, bf16x8 pa0, bf16x8 pa1, bf16x8 pa2, bf16x8 pa3) {
  pv_one<0>(o[0], vb, pa0, pa1, pa2, pa3); pv_one<1>(o[1], vb, pa0, pa1, pa2, pa3); pv_one<2>(o[2], vb, pa0, pa1, pa2, pa3); pv_one<3>(o[3], vb, pa0, pa1, pa2, pa3);
}
template <int LDQ, int LDK, int LDO>
__device__ __forceinline__ void attn_dense_body(const bf16_t* __restrict__ Qb, const bf16_t* __restrict__ Kh, const bf16_t* __restrict__ Vh, float* __restrict__ Ob, int seq, LAS char* lds) {
  const int tid = opaque_tid(), wid = tid >> 6, lane = tid & 63, r32 = lane & 31, hi = lane >> 5;
  LAS char* V_lds = lds; LAS char* K_lds = lds + 2 * SHM_V;
  LAS float* wsl = (LAS float*)(lds + 2 * SHM_V + 2 * SHM_K) + wid * 64; LAS float* li_l = wsl; LAS float* al_l = wsl + 32;
  float m_reg = -1e30f, l_reg = 0; f32x16 o[4] = {}; bf16x8 qr[8];
  const bf16_t* Qw = Qb + (long)(wid * QBLK + r32) * LDQ + hi * 8;
#pragma unroll
  for (int d0 = 0; d0 < 8; ++d0) qr[d0] = *(const bf16x8*)(Qw + d0 * 16);
  const int sr = tid >> 4, sc = (tid & 15) * 8, vst0 = v_st(sr, sc), vst1 = v_st(32 + sr, sc);
  const int vb0 = (int)(uintptr_t)V_lds + v_rd_base(lane);
  struct { bf16x8 vs0, vs1, ks0, ks1; } sr_[SDEPTH];
#define SLOAD(i, k0) do { sr_[i].vs0 = *(const bf16x8*)(&Vh[(long)((k0) + sr) * LDK + sc]); sr_[i].vs1 = *(const bf16x8*)(&Vh[(long)((k0) + 32 + sr) * LDK + sc]); \
    sr_[i].ks0 = *(const bf16x8*)(&Kh[(long)((k0) + sr) * LDK + sc]); sr_[i].ks1 = *(const bf16x8*)(&Kh[(long)((k0) + 32 + sr) * LDK + sc]); } while (0)
#define SWRITE(b, i) do { *(LAS bf16x8*)(V_lds + (b) * SHM_V + vst0) = sr_[i].vs0;          \
    *(LAS bf16x8*)(V_lds + (b) * SHM_V + vst1) = sr_[i].vs1; int kc = sc * 2;               \
    *(LAS bf16x8*)(K_lds + (b) * SHM_K + KSWZ(sr, kc)) = sr_[i].ks0;                       \
    *(LAS bf16x8*)(K_lds + (b) * SHM_K + KSWZ(32 + sr, kc)) = sr_[i].ks1; } while (0)
#define SWAIT() do { asm volatile("s_waitcnt vmcnt(4)" ::: "memory"); } while (0)
#define RESC(a) do { if (__any((a) < 1.f)) { if (hi == 0) al_l[r32] = (a); asm volatile("s_waitcnt lgkmcnt(0)" ::: "memory"); \
    for (int d = 0; d < 4; ++d) for (int r = 0; r < 16; ++r) o[d][r] *= al_l[crow(r, hi)]; } } while (0)
  f32x16 pA0, pA1, pB0, pB1; float mnA, mnB, alA, alB; bf16x8 pa0, pa1, pa2, pa3; const int NT = seq / KVBLK;
  constexpr int SE = 0, SO = SDEPTH - 1;
  SLOAD(SE, 0); asm volatile("s_waitcnt vmcnt(0)" ::: "memory"); SWRITE(0, SE); __syncthreads();
  qkt(pA0, pA1, K_lds, qr, r32, hi); partialSM(pA0, pA1, m_reg, mnA, alA);
  SLOAD(SO, KVBLK); if (2 < NT) SLOAD(SE, 2 * KVBLK);
  SWAIT(); SWRITE(1, SO); __syncthreads();
  for (int j = 1; j + 1 < NT; j += 2) {
    SBAR(); qkt(pB0, pB1, K_lds + SHM_K, qr, r32, hi);
    finishSM(pA0, pA1, alA, l_reg, pa0, pa1, pa2, pa3); SBAR();
    SLOAD(SO, (j + SDEPTH) * KVBLK); SBAR();
    pv_d0(o, vb0, pa0, pa1, pa2, pa3); partialSM(pB0, pB1, m_reg, mnB, alB);
    __syncthreads(); SWAIT(); SWRITE(0, SE);
    RESC(alB); __syncthreads();
    SBAR(); qkt(pA0, pA1, K_lds, qr, r32, hi);
    finishSM(pB0, pB1, alB, l_reg, pa0, pa1, pa2, pa3); SBAR();
    if (j + 3 < NT) SLOAD(SE, (j + 1 + SDEPTH) * KVBLK); SBAR();
    pv_d0(o, vb0 + (int)SHM_V, pa0, pa1, pa2, pa3); partialSM(pA0, pA1, m_reg, mnA, alA);
    __syncthreads(); SWAIT(); SWRITE(1, SO);
    RESC(alA); __syncthreads();
  }
  SBAR(); qkt(pB0, pB1, K_lds + SHM_K, qr, r32, hi);
  finishSM(pA0, pA1, alA, l_reg, pa0, pa1, pa2, pa3); SBAR();
  pv_d0(o, vb0, pa0, pa1, pa2, pa3); partialSM(pB0, pB1, m_reg, mnB, alB);
  __syncthreads(); RESC(alB);
  finishSM(pB0, pB1, alB, l_reg, pa0, pa1, pa2, pa3); SBAR();
  pv_d0(o, vb0 + (int)SHM_V, pa0, pa1, pa2, pa3);
  if (hi == 0) li_l[r32] = l_reg; asm volatile("s_waitcnt lgkmcnt(0)" ::: "memory");
  float rli[16];
#pragma unroll
  for (int r = 0; r < 16; ++r) rli[r] = __builtin_amdgcn_rcpf(li_l[crow(r, hi)]);
  float* Ow = Ob + (long)(wid * QBLK) * LDO;
#pragma unroll
  for (int r = 0; r < 16; ++r) { int orow = crow(r, hi);
#pragma unroll
    for (int d0 = 0; d0 < 4; ++d0) Ow[(long)orow * LDO + d0 * 32 + r32] = o[d0][r] * rli[r]; }
  asm volatile("s_waitcnt vmcnt(0) lgkmcnt(0)" ::: "memory"); __syncthreads();
#undef SLOAD
#undef SWRITE
#undef SWAIT
#undef RESC
}
constexpr int SHM_V2 = KVBLK * 256 * 2, SHM_K2 = KVBLK * AD * 2, SHM_ATTN256 = 2 * SHM_V2 + 2 * SHM_K2 + NW * 64 * 4;
__device__ __forceinline__ int v_st256(int k, int c) { const int kk = (k & ~0xC) | ((k & 4) << 1) | ((k & 8) >> 1); return ((kk >> 3) * 8 + (c >> 5)) * 512 + ((kk & 7) * 32 + (c & 31)) * 2; }
constexpr int v_rd_off256(int d0, int ks, int half) { return d0 * 512 + ks * 8192 + half * 4096; }
template <int D0> __device__ __forceinline__ void pv_one256(f32x16& od, int vb, bf16x8 pa0, bf16x8 pa1, bf16x8 pa2, bf16x8 pa3) {
  const s16x4 l0 = tr_read<v_rd_off256(D0, 0, 0)>(vb), h0 = tr_read<v_rd_off256(D0, 0, 1)>(vb), l1 = tr_read<v_rd_off256(D0, 1, 0)>(vb), h1 = tr_read<v_rd_off256(D0, 1, 1)>(vb);
  const s16x4 l2 = tr_read<v_rd_off256(D0, 2, 0)>(vb), h2 = tr_read<v_rd_off256(D0, 2, 1)>(vb), l3 = tr_read<v_rd_off256(D0, 3, 0)>(vb), h3 = tr_read<v_rd_off256(D0, 3, 1)>(vb);
  asm volatile("s_waitcnt lgkmcnt(0)" ::: "memory"); SBAR();
#define PK(L, H) (bf16x8){L[0], L[1], L[2], L[3], H[0], H[1], H[2], H[3]}
  od = __builtin_amdgcn_mfma_f32_32x32x16_bf16(pa0, PK(l0, h0), od, 0, 0, 0);
  od = __builtin_amdgcn_mfma_f32_32x32x16_bf16(pa1, PK(l1, h1), od, 0, 0, 0);
  od = __builtin_amdgcn_mfma_f32_32x32x16_bf16(pa2, PK(l2, h2), od, 0, 0, 0);
  od = __builtin_amdgcn_mfma_f32_32x32x16_bf16(pa3, PK(l3, h3), od, 0, 0, 0);
#undef PK
}
template <int LDQ, int LDK, int LDO>
__device__ __forceinline__ void attn_body256(const bf16_t* __restrict__ Qb, const bf16_t* __restrict__ Kh, const bf16_t* __restrict__ Vh, float* __restrict__ Ob, int seq, LAS char* lds) {
  const int tid = opaque_tid(), wid = tid >> 6, lane = tid & 63, r32 = lane & 31, hi = lane >> 5;
  LAS char* V_lds = lds; LAS char* K_lds = lds + 2 * SHM_V2;
  LAS float* wsl = (LAS float*)(lds + 2 * SHM_V2 + 2 * SHM_K2) + wid * 64; LAS float* li_l = wsl; LAS float* al_l = wsl + 32;
  float m_reg = -1e30f, l_reg = 0; f32x16 o[8] = {}; bf16x8 qr[8];
  const bf16_t* Qw = Qb + (long)(wid * QBLK + r32) * LDQ + hi * 8;
#pragma unroll
  for (int d0 = 0; d0 < 8; ++d0) qr[d0] = *(const bf16x8*)(Qw + d0 * 16);
  const int sr = tid >> 4, sc = (tid & 15) * 8;
  const int vst00 = v_st256(sr, sc), kst0 = KSWZ(sr, sc * 2);
  const unsigned toff = (unsigned)(sr * LDK + sc);
  const int vb0 = (int)(uintptr_t)V_lds + v_rd_base(lane);
  bf16x8 sa0, sa1, sa2, sa3;
#define SLOAD_A(k0) do { const bf16_t* vp_ = Vh + (long)(k0) * LDK + toff; const bf16_t* kp_ = Kh + (long)(k0) * LDK + toff; \
    sa0 = *(const bf16x8*)kp_; sa1 = *(const bf16x8*)(kp_ + 32L * LDK); sa2 = *(const bf16x8*)vp_; sa3 = *(const bf16x8*)(vp_ + 128); } while (0)
#define SWRITE_A(b) do { LAS char* vb_ = V_lds + (b) * SHM_V2 + vst00; LAS char* kb_ = K_lds + (b) * SHM_K2 + kst0; \
    *(LAS bf16x8*)(kb_) = sa0; *(LAS bf16x8*)(kb_ + 8192) = sa1; *(LAS bf16x8*)(vb_) = sa2; *(LAS bf16x8*)(vb_ + 2048) = sa3; } while (0)
#define SLOAD_B(k0) do { const bf16_t* vp_ = Vh + (long)((k0) + 32) * LDK + toff; sa0 = *(const bf16x8*)vp_; sa1 = *(const bf16x8*)(vp_ + 128); } while (0)
#define SWRITE_B(b) do { LAS char* vb_ = V_lds + (b) * SHM_V2 + vst00; *(LAS bf16x8*)(vb_ + 16384) = sa0; *(LAS bf16x8*)(vb_ + 18432) = sa1; } while (0)
  f32x16 p0, p1; float mn, al; bf16x8 pa0, pa1, pa2, pa3; const int NT = seq / KVBLK;
  SLOAD_A(0); asm volatile("s_waitcnt vmcnt(0)" ::: "memory"); SWRITE_A(0); SLOAD_B(0); asm volatile("s_waitcnt vmcnt(0)" ::: "memory"); SWRITE_B(0); __syncthreads();
#pragma unroll 1
  for (int j = 0; j < NT; ++j) {
    if (j + 1 < NT) SLOAD_A((j + 1) * KVBLK);
    SBAR(); qkt(p0, p1, K_lds + (j & 1) * SHM_K2, qr, r32, hi);
    partialSM(p0, p1, m_reg, mn, al);
    finishSM(p0, p1, al, l_reg, pa0, pa1, pa2, pa3); SBAR();
    if (j + 1 < NT) { asm volatile("s_waitcnt vmcnt(0)" ::: "memory"); SWRITE_A((j + 1) & 1); SLOAD_B((j + 1) * KVBLK); }
    SBAR();
    if (__any(al < 1.f)) { if (hi == 0) al_l[r32] = al; asm volatile("s_waitcnt lgkmcnt(0)" ::: "memory");
#pragma unroll
      for (int d = 0; d < 8; ++d)
#pragma unroll
        for (int r = 0; r < 16; ++r) o[d][r] *= al_l[crow(r, hi)]; }
    { const int vb = vb0 + (j & 1) * SHM_V2;
      pv_one256<0>(o[0], vb, pa0, pa1, pa2, pa3); pv_one256<1>(o[1], vb, pa0, pa1, pa2, pa3); pv_one256<2>(o[2], vb, pa0, pa1, pa2, pa3); pv_one256<3>(o[3], vb, pa0, pa1, pa2, pa3);
      pv_one256<4>(o[4], vb, pa0, pa1, pa2, pa3); pv_one256<5>(o[5], vb, pa0, pa1, pa2, pa3); pv_one256<6>(o[6], vb, pa0, pa1, pa2, pa3); pv_one256<7>(o[7], vb, pa0, pa1, pa2, pa3); }
    if (j + 1 < NT) { asm volatile("s_waitcnt vmcnt(0)" ::: "memory"); SWRITE_B((j + 1) & 1); }
    __syncthreads();
  }
  if (hi == 0) li_l[r32] = l_reg; asm volatile("s_waitcnt lgkmcnt(0)" ::: "memory");
  float* Ow = Ob + (long)(wid * QBLK) * LDO;
#pragma unroll
  for (int r = 0; r < 16; ++r) { const int orow = crow(r, hi); const float rli = __builtin_amdgcn_rcpf(li_l[orow]);
#pragma unroll
    for (int d0 = 0; d0 < 8; ++d0) Ow[(long)orow * LDO + d0 * 32 + r32] = o[d0][r] * rli; }
  asm volatile("s_waitcnt vmcnt(0) lgkmcnt(0)" ::: "memory"); __syncthreads();
#undef SLOAD_A
#undef SWRITE_A
#undef SLOAD_B
#undef SWRITE_B
}
#undef KSWZ
#undef SBAR
}

__device__ __forceinline__ void diffattn_units(const Params& p, LAS unsigned char* lds, float* O0, float* O1) {
    const bf16_t* proj = (const bf16_t*)(p.wp[IX_PROJ]);
    bf16_t* ao = (bf16_t*)(p.wp[IX_ACT]);
    const float* dl = p.in[17]; const float* dn = p.in[18];
    const int G = gridDim.x, bx = blockIdx.x; const int vcu = (G % 8 == 0) ? (bx % 8) * (G / 8) + bx / 8 : bx;
    int slot_k = 0; const int slot_me = (bx >> 3) & 3;
    for (int u = vcu; u < NB * 8 * 8; u += G) {
        const int qb = u & 7, h = (u >> 3) & 7, b = u >> 6;
        const size_t row0 = (size_t)b * T;
#pragma unroll 1
        for (int i = 0; i < 2; ++i) {
            if (slot_k == slot_me) convert_late(p, lds);
            ++slot_k;
            const bf16_t* Q = proj + (row0 + qb * 256) * LD1 + h * 256 + i * 128;
            const bf16_t* K = proj + row0 * LD1 + 2048 + h * 256 + i * 128;
            const bf16_t* V = proj + row0 * LD1 + 4096 + h * 256;
            float* O = (i ? O1 : O0) + (row0 + qb * 256) * D + h * 256;
            att::attn_body256<LD1, LD1, D>(Q, K, V, O, T, (LAS char*)lds);
        }
    }
    if (slot_k <= slot_me) convert_late(p, lds);
    const int tid_ = opaque_tid(), wave = tid_ >> 6, lane = tid_ & 63;
    float la = dl[lane] * dl[128 + lane] + dl[64 + lane] * dl[192 + lane], lb2 = dl[256 + lane] * dl[384 + lane] + dl[320 + lane] * dl[448 + lane];
    la = wave_sum(la); lb2 = wave_sum(lb2);
    const float lam = expf(la) - expf(lb2) + LAM_INIT;
    const f32x4 gv = *(const f32x4*)(dn + 4 * lane);
    for (int u = vcu; u < NB * 8 * 8; u += G) {
        const int qb = u & 7, h = (u >> 3) & 7, b = u >> 6;
        const size_t row0 = (size_t)b * T;
#pragma unroll 1
        for (int rr = 0; rr < 32; rr += 4) {
            f32x4 a[4], bb[4];
#pragma unroll
            for (int k = 0; k < 4; ++k) { const size_t off = (row0 + qb * 256 + wave * 32 + rr + k) * D + h * 256 + 4 * lane; a[k] = *(const f32x4*)(O0 + off); bb[k] = *(const f32x4*)(O1 + off); }
#pragma unroll
            for (int k = 0; k < 4; ++k) { const size_t off = (row0 + qb * 256 + wave * 32 + rr + k) * D + h * 256 + 4 * lane;
                const f32x4 o = a[k] - lam * bb[k];
                const float ss = wave_sum(o.x * o.x + o.y * o.y + o.z * o.z + o.w * o.w);
                const float rstd = (1.f - LAM_INIT) / sqrtf(ss * (1.f / 256.f) + EPS);
                if (OUT_F8) *(unsigned*)((unsigned char*)ao + off) = pk4_fp8(o.x * rstd * gv.x * F8_SM, o.y * rstd * gv.y * F8_SM, o.z * rstd * gv.z * F8_SM, o.w * rstd * gv.w * F8_SM);
                else { u32x2 ov; ov.x = pk2(o.x * rstd * gv.x, o.y * rstd * gv.y); ov.y = pk2(o.z * rstd * gv.z, o.w * rstd * gv.w); *(u32x2*)(ao + off) = ov; } }
        }
    }
}

namespace hg {
typedef short bf16x8 __attribute__((ext_vector_type(8)));
typedef short bf16x4 __attribute__((ext_vector_type(4)));
constexpr int SET_BYTES = 8192 * 3 + 512;
__device__ __forceinline__ int rm_byte(int c, int d) { return c * 256 + ((2 * d) ^ ((c & 7) << 4)); }
__device__ __forceinline__ bf16x8 pack8(const f32x4& a, const f32x4& b) { u32x4 w; w.x = pk2(a.x, a.y); w.y = pk2(a.z, a.w); w.z = pk2(b.x, b.y); w.w = pk2(b.z, b.w); return __builtin_bit_cast(bf16x8, w); }
}
__device__ __forceinline__ void hgrn_mfma(const Params& p, LAS unsigned char* lds) {
    using namespace hg;
    const bf16_t* proj = (const bf16_t*)(p.wp[IX_PROJ]);
    bf16_t* oscr = (bf16_t*)(p.wp[IX_XB]);
    const float* lbl = p.in[24];
    const int tid = opaque_tid(), w = __builtin_amdgcn_readfirstlane(tid >> 6), lane = tid & 63, fr = lane & 15, fq = lane >> 4;
    for (int u = blockIdx.x; u < 128; u += gridDim.x) {
        const int b = u >> 4, h = (u >> 1) & 7, dir = u & 1;
        const int d = 16 * w + fr;
        float lb; { const float l0 = lbl[h * 128 + d], l1 = lbl[1024 + h * 128 + d], l2 = lbl[2048 + h * 128 + d];
            const float mx = fmaxf(l0, fmaxf(l1, l2)); const float e0 = expf(l0 - mx), e1 = expf(l1 - mx), e2 = expf(l2 - mx); lb = e0 / (e0 + e1 + e2); }
        f32x4 S[8];
#pragma unroll
        for (int mi = 0; mi < 8; ++mi) S[mi] = (f32x4){0.f, 0.f, 0.f, 0.f};
        const bf16_t* pb = proj + (size_t)b * T * LD0 + h * 128 + d;
        const int zoff = dir ? 3072 : 2048;
        bf16_t rq[8], rz[8], rv[8], rp[8];
#define HG_LOAD(nn) do { _Pragma("unroll") for (int i = 0; i < 8; ++i) { \
                const int c_ = 8 * fq + i, tt_ = dir ? (T - 1 - (32 * (nn) + c_)) : (32 * (nn) + c_); const bf16_t* pr_ = pb + (size_t)tt_ * LD0; \
                rq[i] = pr_[0]; rv[i] = pr_[1024]; rz[i] = pr_[zoff]; \
                const int cp_ = (i < 4) ? (4 * fq + i) : (16 + 4 * fq + (i - 4)), tp_ = dir ? (T - 1 - (32 * (nn) + cp_)) : (32 * (nn) + cp_); \
                rp[i] = pb[(size_t)tp_ * LD0 + 1024]; } } while (0)
        HG_LOAD(0);
        for (int n = 0; n < T / 32; ++n) {
            LAS unsigned char* set = lds + (n & 1) * SET_BYTES;
            LAS unsigned char* QG = set; LAS unsigned char* KG = set + 8192; LAS unsigned char* KDT = set + 16384; LAS float* DEC = (LAS float*)(set + 24576);
            float qv[8], fv[8], vv[8], vp[8];
#pragma unroll
            for (int i = 0; i < 8; ++i) { qv[i] = bf2f(rq[i]); vv[i] = bf2f(rv[i]); fv[i] = bf2f(rz[i]); vp[i] = bf2f(rp[i]); }
            if (n + 1 < T / 32) HG_LOAD(n + 1);
            float Pl[8]; float P = 1.f;
#pragma unroll
            for (int i = 0; i < 8; ++i) { fv[i] = lb + (1.f - lb) * sigm(fv[i]); P *= fv[i]; Pl[i] = P; }
            const float p0 = __shfl(P, fr), p1 = __shfl(P, fr + 16), p2 = __shfl(P, fr + 32), p3 = __shfl(P, fr + 48);
            const float pre = (fq > 0 ? p0 : 1.f) * (fq > 1 ? p1 : 1.f) * (fq > 2 ? p2 : 1.f), tot = (p0 * p1) * (p2 * p3);
            float kd[8];
#pragma unroll
            for (int i = 0; i < 8; ++i) {
                const int c = 8 * fq + i; const float E = pre * Pl[i], rE = frcp(E), k = 1.f - fv[i];
                *(LAS bf16_t*)(QG + rm_byte(c, d)) = f2bf(silu(qv[i]) * E);
                *(LAS bf16_t*)(KG + rm_byte(c, d)) = f2bf(k * rE);
                kd[i] = k * tot * rE;
            }
            { u32x4 wv; wv.x = pk2(kd[0], kd[1]); wv.y = pk2(kd[2], kd[3]); wv.z = pk2(kd[4], kd[5]); wv.w = pk2(kd[6], kd[7]);
              *(LAS u32x4*)(KDT + d * 64 + ((fq ^ ((d >> 2) & 3)) << 4)) = wv; }
            if (fq == 0) DEC[d] = tot;
            const bf16x8 vB = pack8((f32x4){vv[0], vv[1], vv[2], vv[3]}, (f32x4){vv[4], vv[5], vv[6], vv[7]});
            const bf16x8 vP = pack8((f32x4){vp[0], vp[1], vp[2], vp[3]}, (f32x4){vp[4], vp[5], vp[6], vp[7]});
            __syncthreads();
            f32x4 at00 = {0.f, 0.f, 0.f, 0.f}, at01 = at00, at11 = at00;
#pragma unroll
            for (int ks = 0; ks < 4; ++ks) {
                const int d0 = 32 * ks + 8 * fq;
                const bf16x8 kg0 = *(const LAS bf16x8*)(KG + rm_byte(fr, d0)), kg1 = *(const LAS bf16x8*)(KG + rm_byte(16 + fr, d0));
                const bf16x8 qg0 = *(const LAS bf16x8*)(QG + rm_byte(fr, d0)), qg1 = *(const LAS bf16x8*)(QG + rm_byte(16 + fr, d0));
                at00 = __builtin_amdgcn_mfma_f32_16x16x32_bf16(kg0, qg0, at00, 0, 0, 0);
                at01 = __builtin_amdgcn_mfma_f32_16x16x32_bf16(kg0, qg1, at01, 0, 0, 0);
                at11 = __builtin_amdgcn_mfma_f32_16x16x32_bf16(kg1, qg1, at11, 0, 0, 0);
            }
#pragma unroll
            for (int j = 0; j < 4; ++j) { const bool ok = (4 * fq + j) <= fr; at00[j] = ok ? at00[j] : 0.f; at11[j] = ok ? at11[j] : 0.f; }
            const bf16x8 bi0 = pack8(at00, (f32x4){0.f, 0.f, 0.f, 0.f}), bi1 = pack8(at01, at11);
            f32x4 o0 = {0.f, 0.f, 0.f, 0.f}, o1 = o0;
            o0 = __builtin_amdgcn_mfma_f32_16x16x32_bf16(vP, bi0, o0, 0, 0, 0);
            o1 = __builtin_amdgcn_mfma_f32_16x16x32_bf16(vP, bi1, o1, 0, 0, 0);
#pragma unroll
            for (int ks = 0; ks < 4; ++ks) {
                const bf16x8 sb = pack8(S[2 * ks], S[2 * ks + 1]);
                const int da = 32 * ks + 4 * fq, db = da + 16;
                const bf16x4 q0a = *(const LAS bf16x4*)(QG + rm_byte(fr, da)), q0b = *(const LAS bf16x4*)(QG + rm_byte(fr, db));
                const bf16x4 q1a = *(const LAS bf16x4*)(QG + rm_byte(16 + fr, da)), q1b = *(const LAS bf16x4*)(QG + rm_byte(16 + fr, db));
                const bf16x8 qp0 = {q0a[0], q0a[1], q0a[2], q0a[3], q0b[0], q0b[1], q0b[2], q0b[3]}, qp1 = {q1a[0], q1a[1], q1a[2], q1a[3], q1b[0], q1b[1], q1b[2], q1b[3]};
                o0 = __builtin_amdgcn_mfma_f32_16x16x32_bf16(sb, qp0, o0, 0, 0, 0);
                o1 = __builtin_amdgcn_mfma_f32_16x16x32_bf16(sb, qp1, o1, 0, 0, 0);
            }
            { const int c0 = fr, c1 = 16 + fr; const int t0 = dir ? (T - 1 - (32 * n + c0)) : (32 * n + c0), t1 = dir ? (T - 1 - (32 * n + c1)) : (32 * n + c1);
              bf16_t* ob = oscr + ((size_t)dir * M + (size_t)b * T) * 1024 + h * 128 + 16 * w + 4 * fq;
              u32x2 w0; w0.x = pk2(o0[0], o0[1]); w0.y = pk2(o0[2], o0[3]); u32x2 w1; w1.x = pk2(o1[0], o1[1]); w1.y = pk2(o1[2], o1[3]);
              *(u32x2*)(ob + (size_t)t0 * 1024) = w0; *(u32x2*)(ob + (size_t)t1 * 1024) = w1; }
#pragma unroll
            for (int mi = 0; mi < 8; ++mi) {
                const int dr = 16 * mi + fr;
                const bf16x8 ka = *(const LAS bf16x8*)(KDT + dr * 64 + ((fq ^ ((dr >> 2) & 3)) << 4));
                const f32x4 dc = *(const LAS f32x4*)(DEC + 16 * mi + 4 * fq);
                S[mi] = __builtin_amdgcn_mfma_f32_16x16x32_bf16(ka, vB, S[mi] * dc, 0, 0, 0);
            }
        }
        __syncthreads();
    }
#undef HG_LOAD
}

__device__ __forceinline__ void na_task(const bf16_t* proj, const bf16_t* VT, const float* rpb, bf16_t* mix, LAS float* btab, int b, int r, int h, int qb, int lane) {
    typedef short bf16x8 __attribute__((ext_vector_type(8)));
    const int fr = lane & 15, fq = lane >> 4;
    const int r0 = min(max(r - 4, 0), 24), cb0 = (qb <= 1) ? 0 : 1;
    constexpr float LOG2E = 1.4426950408889634f, C = 0.125f * LOG2E;
    for (int i = lane; i < 8 * 31; i += 64) { const int kr = i / 31, dc = i % 31; btab[kr * 32 + dc] = rpb[(h * 15 + (r0 + kr - r + 7)) * 31 + dc] * LOG2E; }
    const size_t qtok = (size_t)b * T + r * 64 + 16 * qb + fr;
    bf16x8 qf[2];
#pragma unroll
    for (int ks = 0; ks < 2; ++ks) qf[ks] = *(const bf16x8*)(proj + qtok * LD0 + 5120 + h * 64 + 32 * ks + 8 * fq);
    f32x4 sc[24];
#pragma unroll
    for (int g = 0; g < 2; ++g) {
        bf16x8 kf[12][2];
#pragma unroll
        for (int t = 0; t < 12; ++t) { const int tile = 12 * g + t, kr = tile / 3, cbi = tile % 3;
            const size_t ktok = (size_t)b * T + (r0 + kr) * 64 + 16 * (cb0 + cbi) + fr;
            const bf16_t* kp = proj + ktok * LD0 + 6144 + h * 64 + 8 * fq;
            kf[t][0] = *(const bf16x8*)kp; kf[t][1] = *(const bf16x8*)(kp + 32); }
        __builtin_amdgcn_sched_barrier(0);
#pragma unroll
        for (int t = 0; t < 12; ++t) { f32x4 a = {0.f, 0.f, 0.f, 0.f};
            a = __builtin_amdgcn_mfma_f32_16x16x32_bf16(kf[t][0], qf[0], a, 0, 0, 0);
            a = __builtin_amdgcn_mfma_f32_16x16x32_bf16(kf[t][1], qf[1], a, 0, 0, 0);
            sc[12 * g + t] = a; }
        __builtin_amdgcn_sched_barrier(0);
    }
    const bf16_t* vbase = VT + (size_t)(h * 64 + fr) * VTLD + (size_t)b * T + 4 * fq;
    u32x2 vbuf[2][24];
#define NA_VLOAD(buf, nd) do { const bf16_t* vp_ = vbase + (size_t)(16 * (nd)) * VTLD; _Pragma("unroll") for (int t = 0; t < 24; ++t) vbuf[buf][t] = *(const u32x2*)(vp_ + (r0 + t / 3) * 64 + 16 * (cb0 + t % 3)); } while (0)
    NA_VLOAD(0, 0);
    asm volatile("s_waitcnt lgkmcnt(0)" ::: "memory");
    const int c = 16 * qb + fr, cs = min(max(c - 8, 0), 48);
    float mx = -1e30f;
#pragma unroll
    for (int kr = 0; kr < 8; ++kr)
#pragma unroll
        for (int cbi = 0; cbi < 3; ++cbi)
#pragma unroll
            for (int j = 0; j < 4; ++j) {
                const int sidx = 16 * (cb0 + cbi) + 4 * fq + j; const bool ok = (sidx >= cs) && (sidx < cs + 16);
                const int dc = min(max(sidx - c + 15, 0), 30);
                const float v = fmaf(sc[kr * 3 + cbi][j], C, btab[kr * 32 + dc]) + (ok ? 0.f : -1e30f);
                sc[kr * 3 + cbi][j] = v; mx = fmaxf(mx, v);
            }
    mx = fmaxf(mx, __shfl_xor(mx, 16)); mx = fmaxf(mx, __shfl_xor(mx, 32));
    float sum = 0.f;
#pragma unroll
    for (int t = 0; t < 24; ++t)
#pragma unroll
        for (int j = 0; j < 4; ++j) { const float e = __builtin_amdgcn_exp2f(sc[t][j] - mx); sc[t][j] = e; sum += e; }
    sum += __shfl_xor(sum, 16); sum += __shfl_xor(sum, 32);
    const float rs = 1.f / sum;
    f32x4 o[4];
#pragma unroll
    for (int nd = 0; nd < 4; ++nd) o[nd] = (f32x4){0.f, 0.f, 0.f, 0.f};
    bf16x8 pB[12];
#pragma unroll
    for (int kk = 0; kk < 12; ++kk) { const int t0 = 2 * kk, t1 = 2 * kk + 1;
        u32x4 w; w.x = pk2(sc[t0][0], sc[t0][1]); w.y = pk2(sc[t0][2], sc[t0][3]); w.z = pk2(sc[t1][0], sc[t1][1]); w.w = pk2(sc[t1][2], sc[t1][3]);
        pB[kk] = __builtin_bit_cast(bf16x8, w); }
#pragma unroll
    for (int nd = 0; nd < 4; ++nd) {
        if (nd + 1 < 4) NA_VLOAD((nd + 1) & 1, nd + 1);
#pragma unroll
        for (int kk = 0; kk < 12; ++kk) {
            const u32x2 va = vbuf[nd & 1][2 * kk], vb = vbuf[nd & 1][2 * kk + 1];
            u32x4 vw; vw.x = va.x; vw.y = va.y; vw.z = vb.x; vw.w = vb.y;
            o[nd] = __builtin_amdgcn_mfma_f32_16x16x32_bf16(__builtin_bit_cast(bf16x8, vw), pB[kk], o[nd], 0, 0, 0);
        }
    }
#undef NA_VLOAD
#pragma unroll
    for (int nd = 0; nd < 4; ++nd) { u32x2 ov; ov.x = pk2(o[nd][0] * rs, o[nd][1] * rs); ov.y = pk2(o[nd][2] * rs, o[nd][3] * rs);
        *(u32x2*)(mix + qtok * D + 1024 + h * 64 + 16 * nd + 4 * fq) = ov; }
}
constexpr int NA_UNITS = NB * 32 * 8, NA_FIRST = 1024;
__device__ __forceinline__ void na_mfma(const Params& p, LAS unsigned char* lds, int first, int stride, int lo, int hi) {
    const bf16_t* proj = (const bf16_t*)(p.wp[IX_PROJ]); const bf16_t* VT = (const bf16_t*)(p.wp[IX_VT]);
    bf16_t* mix = (bf16_t*)(p.wp[IX_ACT]);
    const int tid = opaque_tid(), w = __builtin_amdgcn_readfirstlane(tid >> 6), lane = tid & 63;
    LAS float* btab = (LAS float*)(lds + 65536) + w * 256;
    for (int u = lo + first; u < hi; u += stride) {
        const int hp = u & 7, r = (u >> 3) & 31, b = u >> 8;
        na_task(proj, VT, p.in[7], mix, btab, b, r, 2 * hp + (w >> 2), w & 3, lane);
    }
}

namespace na2 { constexpr int KRING = 0, VRING = 73728, MERGE = 147456, BIAS = 157696; }
__device__ __forceinline__ void na_ring(const Params& p, LAS unsigned char* lds, int unit) {
    using namespace na2;
    typedef short bf16x8 __attribute__((ext_vector_type(8)));
    const bf16_t* proj = (const bf16_t*)(p.wp[IX_PROJ]); const bf16_t* VT = (const bf16_t*)(p.wp[IX_VT]);
    bf16_t* mix = (bf16_t*)(p.wp[IX_ACT]); const float* rpb = p.in[7];
    const int tid = opaque_tid(), w = __builtin_amdgcn_readfirstlane(tid >> 6), lane = tid & 63, fr = lane & 15, fq = lane >> 4;
    const int b = unit >> 4, h = unit & 15, qb = w & 3, hf = w >> 2, cb0 = (qb <= 1) ? 0 : 1;
    constexpr float LOG2E = 1.4426950408889634f, C = 0.125f * LOG2E;
    LAS float* btab = (LAS float*)(lds + BIAS);
    for (int i = tid; i < 15 * 31; i += 512) btab[(i / 31) * 32 + (i % 31)] = rpb[h * 465 + i] * LOG2E;
    const int st_row = tid >> 3, st_pc = tid & 7, st_off = st_row * 128 + ((st_pc ^ (st_row & 7)) << 4);
    const bf16_t* kg = proj + ((size_t)b * T + st_row) * LD0 + 6144 + h * 64 + st_pc * 8;
    const bf16_t* vg = VT + (size_t)(h * 64 + st_row) * VTLD + (size_t)b * T + st_pc * 8;
    { u32x4 kk[8], vv[8];
#pragma unroll
      for (int g = 0; g < 8; ++g) { kk[g] = *(const u32x4*)(kg + (size_t)g * 64 * LD0); vv[g] = *(const u32x4*)(vg + g * 64); }
#pragma unroll
      for (int g = 0; g < 8; ++g) { *(LAS u32x4*)(lds + KRING + g * 8192 + st_off) = kk[g]; *(LAS u32x4*)(lds + VRING + g * 8192 + st_off) = vv[g]; } }
    const bf16_t* qg = proj + ((size_t)b * T + 16 * qb + fr) * LD0 + 5120 + h * 64 + 8 * fq;
    bf16x8 qf[2]; qf[0] = *(const bf16x8*)qg; qf[1] = *(const bf16x8*)(qg + 32);
    const int c = 16 * qb + fr, cs = min(max(c - 8, 0), 48);
    LAS unsigned* mb = (LAS unsigned*)(lds + MERGE) + qb * 640 + lane;
    __syncthreads();
    for (int r = 0; r < 32; ++r) {
        const int r0 = min(max(r - 4, 0), 24);
        const bool pf = (r >= 4) && (r < 28);
        u32x4 pk_ = {0u, 0u, 0u, 0u}, pv_ = {0u, 0u, 0u, 0u};
        if (pf) { pk_ = *(const u32x4*)(kg + (size_t)(r + 4) * 64 * LD0); pv_ = *(const u32x4*)(vg + (r + 4) * 64); }
        bf16x8 qn0 = qf[0], qn1 = qf[1];
        if (r + 1 < 32) { qn0 = *(const bf16x8*)(qg + (size_t)(r + 1) * 64 * LD0); qn1 = *(const bf16x8*)(qg + (size_t)(r + 1) * 64 * LD0 + 32); }
        f32x4 sc[12];
        int slot[4];
#pragma unroll
        for (int k4 = 0; k4 < 4; ++k4) { slot[k4] = (r0 + 4 * hf + k4) % 9;
            const LAS unsigned char* ks = lds + KRING + slot[k4] * 8192;
#pragma unroll
            for (int cbi = 0; cbi < 3; ++cbi) { const int tok = 16 * (cb0 + cbi) + fr;
                const bf16x8 a0 = *(const LAS bf16x8*)(ks + tok * 128 + ((fq ^ (tok & 7)) << 4)), a1 = *(const LAS bf16x8*)(ks + tok * 128 + (((4 + fq) ^ (tok & 7)) << 4));
                f32x4 a = {0.f, 0.f, 0.f, 0.f};
                a = __builtin_amdgcn_mfma_f32_16x16x32_bf16(a0, qf[0], a, 0, 0, 0);
                a = __builtin_amdgcn_mfma_f32_16x16x32_bf16(a1, qf[1], a, 0, 0, 0);
                sc[k4 * 3 + cbi] = a; } }
        float mx = -1e30f;
#pragma unroll
        for (int k4 = 0; k4 < 4; ++k4) { const LAS float* bt = btab + (r0 + 4 * hf + k4 - r + 7) * 32;
#pragma unroll
            for (int cbi = 0; cbi < 3; ++cbi)
#pragma unroll
                for (int j = 0; j < 4; ++j) { const int sidx = 16 * (cb0 + cbi) + 4 * fq + j; const bool ok = (sidx >= cs) && (sidx < cs + 16);
                    const int dc = min(max(sidx - c + 15, 0), 30);
                    const float v = fmaf(sc[k4 * 3 + cbi][j], C, bt[dc]) + (ok ? 0.f : -1e30f);
                    sc[k4 * 3 + cbi][j] = v; mx = fmaxf(mx, v); } }
        mx = fmaxf(mx, __shfl_xor(mx, 16)); mx = fmaxf(mx, __shfl_xor(mx, 32));
        float sum = 0.f;
#pragma unroll
        for (int t = 0; t < 12; ++t)
#pragma unroll
            for (int j = 0; j < 4; ++j) { const float e = __builtin_amdgcn_exp2f(sc[t][j] - mx); sc[t][j] = e; sum += e; }
        sum += __shfl_xor(sum, 16); sum += __shfl_xor(sum, 32);
        bf16x8 pB[6];
#pragma unroll
        for (int kk = 0; kk < 6; ++kk) { const int t0 = 2 * kk, t1 = 2 * kk + 1;
            u32x4 wv; wv.x = pk2(sc[t0][0], sc[t0][1]); wv.y = pk2(sc[t0][2], sc[t0][3]); wv.z = pk2(sc[t1][0], sc[t1][1]); wv.w = pk2(sc[t1][2], sc[t1][3]);
            pB[kk] = __builtin_bit_cast(bf16x8, wv); }
        f32x4 o[4];
#pragma unroll
        for (int nd = 0; nd < 4; ++nd) { o[nd] = (f32x4){0.f, 0.f, 0.f, 0.f}; const int d = 16 * nd + fr;
#pragma unroll
            for (int kk = 0; kk < 6; ++kk) { const int t0 = 2 * kk, t1 = 2 * kk + 1;
                const int tc0 = 16 * (cb0 + t0 % 3) + 4 * fq, tc1 = 16 * (cb0 + t1 % 3) + 4 * fq;
                const u32x2 va = *(const LAS u32x2*)(lds + VRING + slot[t0 / 3] * 8192 + d * 128 + (((tc0 >> 3) ^ (d & 7)) << 4) + (tc0 & 7) * 2);
                const u32x2 vb = *(const LAS u32x2*)(lds + VRING + slot[t1 / 3] * 8192 + d * 128 + (((tc1 >> 3) ^ (d & 7)) << 4) + (tc1 & 7) * 2);
                u32x4 vw; vw.x = va.x; vw.y = va.y; vw.z = vb.x; vw.w = vb.y;
                o[nd] = __builtin_amdgcn_mfma_f32_16x16x32_bf16(__builtin_bit_cast(bf16x8, vw), pB[kk], o[nd], 0, 0, 0); } }
        const bool merger = (hf == (r & 1));
        if (!merger) { mb[0] = __float_as_uint(mx); mb[64] = __float_as_uint(sum);
#pragma unroll
            for (int nd = 0; nd < 4; ++nd) { mb[(2 + 2 * nd) * 64] = pk2(o[nd][0], o[nd][1]); mb[(3 + 2 * nd) * 64] = pk2(o[nd][2], o[nd][3]); } }
        if (pf) { const int sl = (r + 4) % 9; *(LAS u32x4*)(lds + KRING + sl * 8192 + st_off) = pk_; *(LAS u32x4*)(lds + VRING + sl * 8192 + st_off) = pv_; }
        __syncthreads();
        if (merger) {
            const float m2 = __uint_as_float(mb[0]), l2 = __uint_as_float(mb[64]);
            const float mN = fmaxf(mx, m2), a1 = __builtin_amdgcn_exp2f(mx - mN), a2 = __builtin_amdgcn_exp2f(m2 - mN);
            const float rl = frcp(sum * a1 + l2 * a2);
            bf16_t* op = mix + ((size_t)b * T + r * 64 + 16 * qb + fr) * D + 1024 + h * 64 + 4 * fq;
            unsigned char* op8 = (unsigned char*)mix + ((size_t)b * T + r * 64 + 16 * qb + fr) * D + 1024 + h * 64 + 4 * fq;
#pragma unroll
            for (int nd = 0; nd < 4; ++nd) { const unsigned w0 = mb[(2 + 2 * nd) * 64], w1 = mb[(3 + 2 * nd) * 64];
                const float x0 = (o[nd][0] * a1 + __uint_as_float(w0 << 16) * a2) * rl, x1 = (o[nd][1] * a1 + __uint_as_float(w0 & 0xffff0000u) * a2) * rl;
                const float x2 = (o[nd][2] * a1 + __uint_as_float(w1 << 16) * a2) * rl, x3 = (o[nd][3] * a1 + __uint_as_float(w1 & 0xffff0000u) * a2) * rl;
                if (OUT_F8) *(unsigned*)(op8 + 16 * nd) = pk4_fp8(x0 * F8_SM, x1 * F8_SM, x2 * F8_SM, x3 * F8_SM);
                else { u32x2 ov; ov.x = pk2(x0, x1); ov.y = pk2(x2, x3); *(u32x2*)(op + 16 * nd) = ov; } }
        }
        qf[0] = qn0; qf[1] = qn1;
    }
    __syncthreads();
}

#ifndef PROBE
#define PROBE 0
#endif
#define PH(k, ...) do { __VA_ARGS__ if constexpr (PROBE == (k)) { xcd_barrier(bar); __VA_ARGS__ } } while (0)
__global__ void __launch_bounds__(512, 2) fwd_kernel(Params p) {
    extern __shared__ __attribute__((aligned(16))) unsigned char lds_raw[];
    LAS unsigned char* lds = (LAS unsigned char*)lds_raw;
    volatile LAS unsigned* xbw = (volatile LAS unsigned*)(lds + LDS_BYTES - 16);
    if (threadIdx.x < 4) xbw[threadIdx.x] = 0u;
    __syncthreads();
    unsigned* ctl = (unsigned*)(p.wp[IX_CTL]);
    XcdBarrier bar = xcd_barrier_post(ctl + CW_BAR, xbw);
    float* mod = (float*)(p.wp[IX_MOD]);
    float* xb = (float*)(p.wp[IX_XB]);
    bf16_t* act = (bf16_t*)(p.wp[IX_ACT]);
    bf16_t* proj = (bf16_t*)(p.wp[IX_PROJ]);
    bf16_t* hid = (bf16_t*)(p.wp[IX_HID]);
    bf16_t* ybuf = (bf16_t*)(p.wp[IX_Y]);
    bf16_t* mres = (bf16_t*)(p.wp[IX_O1]);
    unsigned* cnt0 = ctl + CW_CNT; unsigned* cnt1 = ctl + CW_CNT + 64;
    LAS int* base = (LAS int*)(lds + LDS_BASE_OFF);
    const int G = gridDim.x, cid = blockIdx.x;
    if constexpr (PROBE == 20) { for (int i = 0; i < 10; ++i) xcd_barrier(bar); }
    if constexpr (PROBE == 22) { xcd_barrier(bar); }

    PH(1, phase_mod(p, lds); __syncthreads(););
    PH(2, phase_convert(p, lds););
    xcd_barrier(bar);
    PH(3, phase_rows<false, false, false, true>(p, lds, p.in[0], nullptr, p.in[2], mod, 0, D, nullptr, act, nullptr, nullptr, nullptr););
    xcd_barrier(bar);
    if constexpr (PROBE == 21) { xcd_barrier(bar); xcd_barrier(bar); xcd_barrier(bar); xcd_barrier(bar); xcd_barrier(bar); xcd_barrier(bar); xcd_barrier(bar); xcd_barrier(bar); xcd_barrier(bar); xcd_barrier(bar); }
    PH(4, { pg8::StaticOrder S; S.init(M, 7168, G, cid); pg8::EpiBf16 E{proj, LD0, 1.f / (F8_SA * F8_SW)};
        ConvHook hk{&p, lds, ((int)blockIdx.x >> 3) % 7, false};
        pg8::gemm_phase<pg8::EpiBf16, pg8::StaticOrder, true, true, true, ConvHook&>(lds, act, p.wp[IX_WIN0], D, S, E, hk);
        if (!hk.done) hk.run();
        pg8::StaticOrder S2; S2.init(1024, M, G, cid); pg8::EpiBf16 E2{(bf16_t*)(p.wp[IX_VT]), VTLD, 1.f / (F8_SA * F8_SW)};
        pg8::gemm_phase<pg8::EpiBf16, pg8::StaticOrder, true, true, true>(lds, p.wp[IX_WIN0] + (size_t)7168 * D, act, D, S2, E2); });
    xcd_barrier(bar);
    PH(5, hgrn_mfma(p, lds););
    if (G >= 256) { if (cid >= 128) for (int u = cid - 128; u < NB * 16; u += G - 128) na_ring(p, lds, u); }
    else for (int u = cid; u < NB * 16; u += G) na_ring(p, lds, u);
    if constexpr (PROBE == 6) { xcd_barrier(bar); for (int u = cid; u < NB * 16; u += G) na_ring(p, lds, u); }
    xcd_barrier(bar);
    PH(7, hgrn_combine(p););
    xcd_barrier(bar);
    PH(8, { pg8::StaticOrder S; S.init(M, D, G, cid); pg8::EpiBf16 E{mres, D, OUT_F8 ? 1.f / (F8_SM * F8_SWD) : 1.f};
        pg8::gemm_phase<pg8::EpiBf16, pg8::StaticOrder, true, true, OUT_F8>(lds, act, p.wp[IX_WOUT0], D, S, E); });
    xcd_barrier(bar);
    phase_rows<false, true, false, true>(p, lds, p.in[0], nullptr, p.in[9], mod, 3 * D, 4 * D, nullptr, act, nullptr, nullptr, cnt0, mres);
    if constexpr (PROBE == 15) { xcd_barrier(bar); phase_rows<false, true, false, true, true>(p, lds, p.in[0], nullptr, p.in[9], mod, 3 * D, 4 * D, nullptr, act, nullptr, nullptr, ctl + CW_CNT + 128, mres); }
    xcd_barrier(bar);
    compute_base(cnt0, base);
    { pg8::MoeOrder<true, 0, true, false> S{base, (const int*)(p.wp[IX_LIST]), cnt0, G, cid, base[NE] / 256, ctl + CW_FLG}; pg8::EpiGluF8 E{(unsigned char*)hid, (const float*)(p.wp[IX_LW]), cnt0, base};
        pg8::gemm_phase<pg8::EpiGluF8, pg8::MoeOrder<true, 0, true, false>, true, true, true>(lds, act, p.wp[IX_WGU0], D, S, E); }
    { pg8::MoeOrder<false, 2, false, true> S{base, nullptr, cnt0, G, cid, base[NE] / 256, ctl + CW_FLG}; pg8::EpiBf16 E{ybuf, D, 1.f / (F8_SH * F8_SWD)};
        pg8::gemm_phase<pg8::EpiBf16, pg8::MoeOrder<false, 2, false, true>, true, true, true>(lds, hid, p.wp[IX_WD0], DFF, S, E); }
    xcd_barrier(bar);
    PH(11, phase_combine<false, true>(p, lds, p.in[0], xb, p.in[13], mod + 8 * 12288, mod, act, nullptr, cnt0, mres););
    xcd_barrier(bar);
    PH(12, { pg8::StaticOrder S; S.init(M, ODW, G, cid); pg8::EpiBf16Rope E{proj, LD1, (const float*)(p.wp[IX_ROPE]), (const float*)(p.wp[IX_ROPE]) + 2048 * 16, 1.f / (F8_SA * F8_SW)};
        pg8::gemm_phase<pg8::EpiBf16Rope, pg8::StaticOrder, true, true, true>(lds, act, p.wp[IX_WIN1], D, S, E); });
    xcd_barrier(bar);
    PH(13, diffattn_units(p, lds, p.out, (float*)(p.wp[IX_O1])););
    xcd_barrier(bar);
    { pg8::StaticOrder S; S.init(M, D, G, cid); pg8::EpiBf16 E{mres, D, OUT_F8 ? 1.f / (F8_SM * F8_SWD) : 1.f};
      pg8::gemm_phase<pg8::EpiBf16, pg8::StaticOrder, true, true, OUT_F8>(lds, act, p.wp[IX_WOUT1], D, S, E); }
    xcd_barrier(bar);
    phase_rows<false, true, false, true>(p, lds, xb, nullptr, p.in[20], mod + 8 * 12288, 3 * D, 4 * D, nullptr, act, nullptr, nullptr, cnt1, mres);
    xcd_barrier(bar);
    compute_base(cnt1, base);
    { pg8::MoeOrder<true, 0, true, false> S{base, (const int*)(p.wp[IX_LIST]), cnt1, G, cid, base[NE] / 256, ctl + CW_FLG + 256}; pg8::EpiGluF8 E{(unsigned char*)hid, (const float*)(p.wp[IX_LW]), cnt1, base};
      pg8::gemm_phase<pg8::EpiGluF8, pg8::MoeOrder<true, 0, true, false>, true, true, true>(lds, act, p.wp[IX_WGU1], D, S, E); }
    { pg8::MoeOrder<false, 2, false, true> S{base, nullptr, cnt1, G, cid, base[NE] / 256, ctl + CW_FLG + 256}; pg8::EpiBf16 E{ybuf, D, 1.f / (F8_SH * F8_SWD)};
      pg8::gemm_phase<pg8::EpiBf16, pg8::MoeOrder<false, 2, false, true>, true, true, true>(lds, hid, p.wp[IX_WD1], DFF, S, E); }
    xcd_barrier(bar);
    PH(16, phase_combine<true, false>(p, lds, xb, nullptr, p.in[27], nullptr, mod + 8 * 12288, nullptr, p.out, cnt1, mres););
}

extern "C" void kernel_launch(void* const* d_in, const int* in_sizes, int n_in, void* d_out, int out_size, void* d_ws, size_t ws_size, hipStream_t stream) {
    static int grid = 0;
    if (grid == 0) {
        if (n_in != 28 || out_size != M * D || ws_size < WS_END) { fprintf(stderr, "kernel_launch: unexpected shapes: n_in %d out %d ws %zu\n", n_in, out_size, ws_size); grid = -1; return; }
        int dev = 0, cus = 0, per_cu = 0;
        if (hipGetDevice(&dev) != hipSuccess || hipDeviceGetAttribute(&cus, hipDeviceAttributeMultiprocessorCount, dev) != hipSuccess) { grid = -1; return; }
        if (hipFuncSetAttribute((const void*)fwd_kernel, hipFuncAttributeMaxDynamicSharedMemorySize, LDS_BYTES) != hipSuccess) { fprintf(stderr, "kernel_launch: hipFuncSetAttribute failed\n"); grid = -1; return; }
        if (hipOccupancyMaxActiveBlocksPerMultiprocessor(&per_cu, (const void*)fwd_kernel, 512, LDS_BYTES) != hipSuccess || per_cu < 1) { fprintf(stderr, "kernel_launch: occupancy query says %d\n", per_cu); grid = -1; return; }
        (void)hipGetLastError();
        grid = cus;
    }
    if (grid < 0) return;
    if (hipMemsetAsync((char*)d_ws + WS_CTL, 0, CTL_BYTES, stream) != hipSuccess) return;
    Params p{};
    for (int i = 0; i < 28; ++i) p.in[i] = (const float*)d_in[i];
    p.out = (float*)d_out;
    p.wp[IX_ACT] = (unsigned char*)d_ws + WS_ACT;
    p.wp[IX_CTL] = (unsigned char*)d_ws + WS_CTL;
    p.wp[IX_HID] = (unsigned char*)d_ws + WS_HID;
    p.wp[IX_LIST] = (unsigned char*)d_ws + WS_LIST;
    p.wp[IX_LW] = (unsigned char*)d_ws + WS_LW;
    p.wp[IX_MOD] = (unsigned char*)d_ws + WS_MOD;
    p.wp[IX_O1] = (unsigned char*)d_ws + WS_O1;
    p.wp[IX_PROJ] = (unsigned char*)d_ws + WS_PROJ;
    p.wp[IX_ROPE] = (unsigned char*)d_ws + WS_ROPE;
    p.wp[IX_TOK] = (unsigned char*)d_ws + WS_TOK;
    p.wp[IX_VT] = (unsigned char*)d_ws + WS_VT;
    p.wp[IX_WD0] = (unsigned char*)d_ws + WS_WD0;
    p.wp[IX_WD1] = (unsigned char*)d_ws + WS_WD1;
    p.wp[IX_WGU0] = (unsigned char*)d_ws + WS_WGU0;
    p.wp[IX_WGU1] = (unsigned char*)d_ws + WS_WGU1;
    p.wp[IX_WIN0] = (unsigned char*)d_ws + WS_WIN0;
    p.wp[IX_WIN1] = (unsigned char*)d_ws + WS_WIN1;
    p.wp[IX_WOUT0] = (unsigned char*)d_ws + WS_WOUT0;
    p.wp[IX_WOUT1] = (unsigned char*)d_ws + WS_WOUT1;
    p.wp[IX_XB] = (unsigned char*)d_ws + WS_XB;
    p.wp[IX_Y] = (unsigned char*)d_ws + WS_Y;
    for (int j = 0; j < 16; ++j) p.inv[j] = pow(500000.0, -(double)j / 16.0);
    hipLaunchKernelGGL(fwd_kernel, dim3(grid), dim3(512), LDS_BYTES, stream, p);
    const hipError_t le = hipPeekAtLastError();
    if (le != hipSuccess) fprintf(stderr, "kernel_launch: launch failed: %s\n", hipGetErrorName(le));
}
```

```cpp
#include <hip/hip_runtime.h>
#include <cstdio>
#include <cstdint>
#include <cmath>

#define LAS __attribute__((address_space(3)))
typedef unsigned short bf16_t;
typedef float f32x4 __attribute__((ext_vector_type(4)));
typedef float f32x2 __attribute__((ext_vector_type(2)));
typedef __bf16 bf16x2_t __attribute__((ext_vector_type(2)));
typedef unsigned u32x4 __attribute__((ext_vector_type(4)));
typedef unsigned u32x2 __attribute__((ext_vector_type(2)));

constexpr int NB = 8, T = 2048, D = 2048, M = NB * T;
constexpr int EVW = 8192, ODW = 6144, NE = 16, DFF = 1024;
constexpr int LD0 = EVW + 64, LD1 = ODW + 64, VTLD = M + 64;
constexpr int PMAX = 2 * M + NE * 256;
constexpr float EPS = 1e-6f;
constexpr float LAM_INIT = 0.35550906759f;

constexpr size_t MiB = 1u << 20;
constexpr size_t WS_CTL = 0, CTL_BYTES = 1 * MiB;
constexpr size_t WS_MOD = 1 * MiB;
constexpr size_t WS_ROPE = 2 * MiB;
constexpr size_t WS_TOK = 3 * MiB;
constexpr size_t WS_LIST = 4 * MiB;
constexpr size_t WS_LW = 5 * MiB;
constexpr size_t WS_XB = 8 * MiB;
constexpr size_t WS_ACT = 136 * MiB;
constexpr size_t WS_PROJ = 200 * MiB;
constexpr size_t WS_HID = WS_PROJ, WS_Y = WS_PROJ + 72 * MiB;
constexpr size_t WS_W = 464 * MiB;
constexpr size_t WS_WIN0 = WS_W, WS_WOUT0 = WS_WIN0 + 32 * MiB, WS_WGU0 = WS_WOUT0 + 8 * MiB, WS_WD0 = WS_WGU0 + 128 * MiB;
constexpr size_t WS_WIN1 = WS_WD0 + 64 * MiB, WS_WOUT1 = WS_WIN1 + 24 * MiB, WS_WGU1 = WS_WOUT1 + 8 * MiB, WS_WD1 = WS_WGU1 + 128 * MiB;
constexpr size_t WS_VT = WS_WD1 + 64 * MiB;
constexpr size_t WS_O1 = WS_WD1 + 64 * MiB;
constexpr size_t WS_END = WS_O1 + 128 * MiB;
constexpr int CW_BAR = 4096, CW_CNT = 8192, CW_NAQ = 8448, CW_FLG = 12288;
constexpr int LDS_BYTES = 163840;
constexpr int LDS_BASE_OFF = 131072 + 1024;
constexpr int LDS_UCNT_OFF = LDS_BASE_OFF + 128;

#define XB_TMO      128
#define XB_XCNT(j)  (256  + 64 * (j))
#define XB_XSUB(j)  (1280 + 64 * (j))
#define XB_XGEN(j)  (2304 + 64 * (j))
#define XB_TOP      3328
#define XB_TOPGEN   3392
#define XCD_BAR_WORDS 3456
#define XB_SPIN_CAP (1u << 20)
__device__ __forceinline__ unsigned xb_ld(unsigned* p)              { return __hip_atomic_load(p, __ATOMIC_RELAXED, __HIP_MEMORY_SCOPE_AGENT); }
__device__ __forceinline__ unsigned xb_add(unsigned* p, unsigned v) { return __hip_atomic_fetch_add(p, v, __ATOMIC_RELAXED, __HIP_MEMORY_SCOPE_AGENT); }
__device__ __forceinline__ unsigned xb_xcc_id() { return (unsigned)__builtin_amdgcn_s_getreg((3 << 11) | 20) & 0xFu; }
#define XB_SPIN(cond, bar) do { unsigned _sp = 0; while (cond) { __builtin_amdgcn_s_sleep(1); \
    if ((++_sp & 255u) == 0u) { if (xb_ld(&(bar)[XB_TMO])) break; if (_sp > XB_SPIN_CAP) { atomicAdd(&(bar)[XB_TMO], 1u); break; } } } } while (0)
struct XcdBarrier { unsigned* bar; unsigned x; volatile LAS unsigned* st; };
__device__ __forceinline__ XcdBarrier xcd_barrier_post(unsigned* bar, volatile LAS unsigned* st) {
    XcdBarrier b; b.bar = bar; b.x = xb_xcc_id(); b.st = st;
    if (threadIdx.x == 0) (void)xb_add(&bar[XB_XCNT(b.x)], 1u);
    return b;
}
__device__ __forceinline__ void xcd_barrier_complete(unsigned* bar, unsigned x, unsigned& nloc, unsigned& nx) {
    const unsigned G = gridDim.x * gridDim.y * gridDim.z;
    unsigned sum, cnt, mine, sp = 0u;
    for (;;) {
        sum = 0u; cnt = 0u; mine = 0u;
#pragma unroll
        for (unsigned j = 0; j < 16; ++j) { const unsigned c = xb_ld(&bar[XB_XCNT(j)]); sum += c; cnt += (c > 0u) ? 1u : 0u; mine = (j == x) ? c : mine; }
        if (sum == G) break;
        __builtin_amdgcn_s_sleep(1);
        if ((++sp & 255u) == 0u) { if (xb_ld(&bar[XB_TMO])) break; if (sp > XB_SPIN_CAP) { atomicAdd(&bar[XB_TMO], 1u); break; } }
    }
    nloc = mine > 0u ? mine : 1u; nx = cnt > 0u ? cnt : 1u;
}
__device__ __forceinline__ void xcd_barrier(const XcdBarrier& b) {
    asm volatile("s_waitcnt vmcnt(0)" ::: "memory");
    __syncthreads();
    if (threadIdx.x == 0) {
        unsigned* bar = b.bar;
        __builtin_amdgcn_s_waitcnt(0);
        unsigned nloc = b.st[0], nx = b.st[1];
        if (nloc == 0u) { xcd_barrier_complete(bar, b.x, nloc, nx); b.st[0] = nloc; b.st[1] = nx; }
        const unsigned old = xb_add(&bar[XB_XSUB(b.x)], 1u);
        const unsigned gen = old / nloc;
        if (old + 1u == (gen + 1u) * nloc) {
            __builtin_amdgcn_fence(__ATOMIC_RELEASE, "agent");
            asm volatile("s_waitcnt vmcnt(0)" ::: "memory");
            const unsigned og = xb_add(&bar[XB_TOP], 1u);
            const unsigned tg = og / nx;
            if (og + 1u == (tg + 1u) * nx) xb_add(&bar[XB_TOPGEN], 1u);
            else XB_SPIN(xb_ld(&bar[XB_TOPGEN]) == tg, bar);
            __builtin_amdgcn_fence(__ATOMIC_ACQUIRE, "agent");
            xb_add(&bar[XB_XGEN(b.x)], 1u);
            asm volatile("s_waitcnt vmcnt(0)" ::: "memory");
        } else {
            XB_SPIN(xb_ld(&bar[XB_XGEN(b.x)]) == gen, bar);
            __builtin_amdgcn_fence(__ATOMIC_ACQUIRE, "agent");
            asm volatile("s_waitcnt vmcnt(0)" ::: "memory");
        }
    }
    __syncthreads();
}

__device__ __forceinline__ int opaque_tid() { int t = threadIdx.x; asm volatile("" : "+v"(t)); return t; }
__device__ __forceinline__ float bf2f(bf16_t v) { return __uint_as_float((unsigned)v << 16); }
__device__ __forceinline__ unsigned pk2(float a, float b) { f32x2 v = {a, b}; bf16x2_t r = __builtin_convertvector(v, bf16x2_t); return __builtin_bit_cast(unsigned, r); }
__device__ __forceinline__ bf16_t f2bf(float a) { return (bf16_t)(pk2(a, 0.f) & 0xffffu); }
__device__ __forceinline__ float frcp(float x) { return __builtin_amdgcn_rcpf(x); }
__device__ __forceinline__ float sigm(float x) { return frcp(1.f + __expf(-x)); }
__device__ __forceinline__ float silu(float x) { return x * frcp(1.f + __expf(-x)); }
constexpr bool OUT_F8 = true;
constexpr float F8_SM = 8.f;
constexpr float F8_SA = 16.f, F8_SW = 256.f, F8_SH = 8.f, F8_SWD = 256.f;
__device__ __forceinline__ unsigned pk4_fp8(float a, float b, float c, float d) { unsigned w = 0u; w = __builtin_amdgcn_cvt_pk_fp8_f32(a, b, w, false); w = __builtin_amdgcn_cvt_pk_fp8_f32(c, d, w, true); return w; }
__device__ __forceinline__ float wave_sum(float v) {
#pragma unroll
    for (int o = 1; o < 64; o <<= 1) v += __shfl_xor(v, o);
    return v;
}
__device__ __forceinline__ float wave_max(float v) {
#pragma unroll
    for (int o = 1; o < 64; o <<= 1) v = fmaxf(v, __shfl_xor(v, o));
    return v;
}

enum WsIx { IX_ACT, IX_CTL, IX_HID, IX_LIST, IX_LW, IX_MOD, IX_O1, IX_PROJ, IX_ROPE, IX_TOK, IX_VT, IX_WD0, IX_WD1, IX_WGU0, IX_WGU1, IX_WIN0, IX_WIN1, IX_WOUT0, IX_WOUT1, IX_XB, IX_Y, IX_N };
struct Params {
    const float* in[28];
    float* out;
    unsigned char* wp[IX_N];
    double inv[16];
};

__device__ __forceinline__ void phase_mod(const Params& p, LAS unsigned char* lds) {
    LAS float* cact = (LAS float*)lds;
    LAS float* red = (LAS float*)(lds + 65536);
    const int tid = opaque_tid(), wave = tid >> 6, lane = tid & 63;
    const float* c = p.in[1];
    float* mod = (float*)(p.wp[IX_MOD]);
    for (int i = tid; i < 8 * 2048; i += 512) { const int b = i / 2048, k = i % 2048; cact[k * 8 + b] = silu(c[i]); }
    __syncthreads();
    for (int u = blockIdx.x; u < 192; u += gridDim.x) {
        const int l = u / 96, cb = u % 96;
        const float* W = p.in[l ? 14 : 3]; const float* bias = p.in[l ? 15 : 4];
        float acc[8][2];
#pragma unroll
        for (int b = 0; b < 8; ++b) { acc[b][0] = 0.f; acc[b][1] = 0.f; }
        const float* wp = W + (size_t)(wave * 256) * 12288 + cb * 128 + 2 * lane;
#pragma unroll 16
        for (int k = 0; k < 256; ++k) {
            const f32x2 w = __builtin_nontemporal_load((const f32x2*)(wp + (size_t)k * 12288));
            const f32x4 c0 = *(LAS f32x4*)(cact + (wave * 256 + k) * 8), c1 = *(LAS f32x4*)(cact + (wave * 256 + k) * 8 + 4);
            acc[0][0] += c0.x * w.x; acc[0][1] += c0.x * w.y; acc[1][0] += c0.y * w.x; acc[1][1] += c0.y * w.y;
            acc[2][0] += c0.z * w.x; acc[2][1] += c0.z * w.y; acc[3][0] += c0.w * w.x; acc[3][1] += c0.w * w.y;
            acc[4][0] += c1.x * w.x; acc[4][1] += c1.x * w.y; acc[5][0] += c1.y * w.x; acc[5][1] += c1.y * w.y;
            acc[6][0] += c1.z * w.x; acc[6][1] += c1.z * w.y; acc[7][0] += c1.w * w.x; acc[7][1] += c1.w * w.y;
        }
#pragma unroll
        for (int b = 0; b < 8; ++b) { red[(wave * 8 + b) * 128 + 2 * lane] = acc[b][0]; red[(wave * 8 + b) * 128 + 2 * lane + 1] = acc[b][1]; }
        __syncthreads();
        for (int o = tid; o < 1024; o += 512) {
            const int b = o / 128, j = o % 128; float s = 0.f;
#pragma unroll
            for (int w = 0; w < 8; ++w) s += red[(w * 8 + b) * 128 + j];
            mod[(size_t)(l * 8 + b) * 12288 + cb * 128 + j] = s + bias[cb * 128 + j];
        }
        __syncthreads();
    }
    float* rc = (float*)(p.wp[IX_ROPE]); float* rs = rc + 2048 * 16;
    for (int i = blockIdx.x * 512 + tid; i < 2048 * 16; i += gridDim.x * 512) {
        const int pos = i / 16, j = i % 16;
        const double ang = (double)pos * p.inv[j];
        const double n = rint(ang * 0.15915494309189535);
        double r = fma(-n, 6.283185307179586, ang); r = fma(-n, 2.4492935982947064e-16, r);
        rc[i] = cosf((float)r); rs[i] = sinf((float)r);
    }
}

__device__ __forceinline__ void compute_base(const unsigned* cnt, LAS int* base) {
    if (threadIdx.x == 0) { int s = 0; for (int e = 0; e < NE; ++e) { base[e] = s; s += ((int)cnt[e] + 255) / 256 * 256; } base[NE] = s; *(LAS unsigned*)((LAS unsigned char*)base + 128) = 0u; }
    __syncthreads();
}
template <bool COMBINE, bool ROUTE, bool FINAL, bool OUT8 = false, bool DUMMY = false>
__device__ __forceinline__ void phase_rows(const Params& p, LAS unsigned char* lds, const float* xin, float* xnew, const float* g, const float* modl  ,
                                           int sh_off, int sc_off, const float* modprev  , bf16_t* hout, float* fout,
                                           const unsigned* cnt_prev, unsigned* cnt_cur, const bf16_t* mres = nullptr  ) {
    const int tid = opaque_tid(), wave = tid >> 6, lane = tid & 63;
    LAS int* base = (LAS int*)(lds + LDS_BASE_OFF);
    if (COMBINE) compute_base(cnt_prev, base);
    const int* tok_e = (const int*)(p.wp[IX_TOK]); const int* tok_pos = tok_e + 2 * M;
    int* tok_e_w = DUMMY ? (int*)(p.wp[IX_Y] + 4 * MiB) : (int*)(p.wp[IX_TOK]); int* tok_pos_w = tok_e_w + 2 * M;
    const bf16_t* Y = (const bf16_t*)(p.wp[IX_Y]);
    int* list = DUMMY ? (int*)(p.wp[IX_Y]) : (int*)(p.wp[IX_LIST]); float* lw = DUMMY ? (float*)(p.wp[IX_Y] + 2 * MiB) : (float*)(p.wp[IX_LW]);
    const float* rw = p.in[25]; const float* rb = p.in[26];
    LAS f32x4* WT = (LAS f32x4*)lds;
    LAS unsigned* rt_cnt = (LAS unsigned*)(lds + 131072 + 2048);
    LAS int* rt_sel = (LAS int*)(lds + 131072 + 4096);
    int rslot = 0;
    if (ROUTE) { if (tid < 32) rt_cnt[tid] = 0u;
        for (int i = tid; i < 8192; i += 512) { const int k = i >> 2, eg = i & 3; WT[(((k >> 8) * 4 + (k & 3)) * 4 + eg) * 64 + ((k & 255) >> 2)] = *(const f32x4*)(rw + k * 16 + eg * 4); }
        __syncthreads(); }
    for (int m = blockIdx.x * 8 + wave; m < M; m += gridDim.x * 8) {
        const int b = m / T;
        f32x4 xv[8];
#pragma unroll
        for (int j = 0; j < 8; ++j) xv[j] = *(const f32x4*)(xin + (size_t)m * D + 4 * lane + 256 * j);
        if (mres) { const float* gta = modl + (size_t)b * 12288 + 2 * D;
#pragma unroll
            for (int j = 0; j < 8; ++j) { const int c = 4 * lane + 256 * j; const u32x2 mm = *(const u32x2*)(mres + (size_t)m * D + c); const f32x4 gv = *(const f32x4*)(gta + c);
                xv[j].x += gv.x * __uint_as_float(mm.x << 16); xv[j].y += gv.y * __uint_as_float(mm.x & 0xffff0000u); xv[j].z += gv.z * __uint_as_float(mm.y << 16); xv[j].w += gv.w * __uint_as_float(mm.y & 0xffff0000u); } }
        if (COMBINE) {
            const int e0 = tok_e[2 * m], e1 = tok_e[2 * m + 1];
            const size_t r0 = (size_t)(base[e0] + tok_pos[2 * m]), r1 = (size_t)(base[e1] + tok_pos[2 * m + 1]);
            const float* gt = modprev + (size_t)b * 12288 + 5 * D;
#pragma unroll
            for (int j = 0; j < 8; ++j) {
                const int c = 4 * lane + 256 * j;
                const u32x2 a = *(const u32x2*)(Y + r0 * D + c), bb = *(const u32x2*)(Y + r1 * D + c);
                const f32x4 gv = *(const f32x4*)(gt + c);
                xv[j].x += gv.x * (__uint_as_float(a.x << 16) + __uint_as_float(bb.x << 16));
                xv[j].y += gv.y * (__uint_as_float(a.x & 0xffff0000u) + __uint_as_float(bb.x & 0xffff0000u));
                xv[j].z += gv.z * (__uint_as_float(a.y << 16) + __uint_as_float(bb.y << 16));
                xv[j].w += gv.w * (__uint_as_float(a.y & 0xffff0000u) + __uint_as_float(bb.y & 0xffff0000u));
                if (!FINAL) *(f32x4*)(xnew + (size_t)m * D + c) = xv[j];
            }
        }
        float ss = 0.f;
#pragma unroll
        for (int j = 0; j < 8; ++j) ss += xv[j].x * xv[j].x + xv[j].y * xv[j].y + xv[j].z * xv[j].z + xv[j].w * xv[j].w;
        ss = wave_sum(ss);
        const float rstd = 1.0f / sqrtf(ss * (1.f / D) + EPS);
        if (FINAL) {
#pragma unroll
            for (int j = 0; j < 8; ++j) { const int c = 4 * lane + 256 * j; const f32x4 gv = *(const f32x4*)(g + c); *(f32x4*)(fout + (size_t)m * D + c) = xv[j] * rstd * gv; }
        } else {
            const float* sh = modl + (size_t)b * 12288 + sh_off; const float* sc = modl + (size_t)b * 12288 + sc_off;
#pragma unroll
            for (int j = 0; j < 8; ++j) {
                const int c = 4 * lane + 256 * j;
                const f32x4 gv = *(const f32x4*)(g + c), shv = *(const f32x4*)(sh + c), scv = *(const f32x4*)(sc + c);
                xv[j] = xv[j] * rstd * gv * (1.f + scv) + shv;
                if (OUT8) *(unsigned*)((unsigned char*)hout + (size_t)m * D + c) = pk4_fp8(xv[j].x * F8_SA, xv[j].y * F8_SA, xv[j].z * F8_SA, xv[j].w * F8_SA);
                else { u32x2 o; o.x = pk2(xv[j].x, xv[j].y); o.y = pk2(xv[j].z, xv[j].w); *(u32x2*)(hout + (size_t)m * D + c) = o; }
            }
            if (ROUTE) {
                float lg[16];
#pragma unroll
                for (int e = 0; e < 16; ++e) lg[e] = 0.f;
#pragma unroll
                for (int j = 0; j < 8; ++j) {
#pragma unroll
                    for (int cc = 0; cc < 4; ++cc) {
                        const float hv = xv[j][cc];
                        const f32x4 w0 = WT[((j * 4 + cc) * 4 + 0) * 64 + lane], w1 = WT[((j * 4 + cc) * 4 + 1) * 64 + lane], w2 = WT[((j * 4 + cc) * 4 + 2) * 64 + lane], w3 = WT[((j * 4 + cc) * 4 + 3) * 64 + lane];
                        lg[0] += hv * w0.x; lg[1] += hv * w0.y; lg[2] += hv * w0.z; lg[3] += hv * w0.w;
                        lg[4] += hv * w1.x; lg[5] += hv * w1.y; lg[6] += hv * w1.z; lg[7] += hv * w1.w;
                        lg[8] += hv * w2.x; lg[9] += hv * w2.y; lg[10] += hv * w2.z; lg[11] += hv * w2.w;
                        lg[12] += hv * w3.x; lg[13] += hv * w3.y; lg[14] += hv * w3.z; lg[15] += hv * w3.w;
                    }
                    __builtin_amdgcn_sched_barrier(0);
                }
                float sc_[16], sel[16];
#pragma unroll
                for (int e = 0; e < 16; ++e) { lg[e] = wave_sum(lg[e]); sc_[e] = 1.f / (1.f + expf(-lg[e])); sel[e] = sc_[e] + rb[e]; }
                float gsv[4], gw1[4], gw2[4]; int gi1[4], gi2[4];
#pragma unroll
                for (int gq = 0; gq < 4; ++gq) {
                    float m1 = sel[4 * gq]; int i1 = 0; float s1 = sc_[4 * gq];
#pragma unroll
                    for (int i = 1; i < 4; ++i) if (sel[4 * gq + i] > m1) { m1 = sel[4 * gq + i]; i1 = i; s1 = sc_[4 * gq + i]; }
                    float m2 = -INFINITY; int i2 = 0; float s2 = 0.f;
#pragma unroll
                    for (int i = 0; i < 4; ++i) if (i != i1 && sel[4 * gq + i] > m2) { m2 = sel[4 * gq + i]; i2 = i; s2 = sc_[4 * gq + i]; }
                    gsv[gq] = m1 + m2; gi1[gq] = 4 * gq + i1; gi2[gq] = 4 * gq + i2; gw1[gq] = s1; gw2[gq] = s2;
                }
                float bv = gsv[0]; int e0 = gi1[0], e1 = gi2[0]; float w0 = gw1[0], w1 = gw2[0];
#pragma unroll
                for (int gq = 1; gq < 4; ++gq) if (gsv[gq] > bv) { bv = gsv[gq]; e0 = gi1[gq]; e1 = gi2[gq]; w0 = gw1[gq]; w1 = gw2[gq]; }
                const float wsum = w0 + w1; w0 /= wsum; w1 /= wsum;
                if (lane == 0) {
                    const int k = rslot++;
                    const int l0 = (int)__hip_atomic_fetch_add(rt_cnt + e0, 1u, __ATOMIC_RELAXED, __HIP_MEMORY_SCOPE_WORKGROUP), l1 = (int)__hip_atomic_fetch_add(rt_cnt + e1, 1u, __ATOMIC_RELAXED, __HIP_MEMORY_SCOPE_WORKGROUP);
                    LAS int* rr = rt_sel + (k * 8 + wave) * 8;
                    rr[0] = m; rr[1] = e0; rr[2] = e1; rr[3] = l0; rr[4] = l1; ((LAS float*)rr)[5] = w0; ((LAS float*)rr)[6] = w1;
                }
            }
        }
    }
    if (ROUTE) {
        __syncthreads();
        if (tid < NE) rt_cnt[16 + tid] = atomicAdd(cnt_cur + tid, rt_cnt[tid]);
        __syncthreads();
        const int nrow = (M - (int)blockIdx.x * 8 + (int)gridDim.x * 8 - 1) / ((int)gridDim.x * 8);
        for (int i = tid; i < nrow * 8; i += 512) {
            const LAS int* rr = rt_sel + i * 8; const int m = rr[0], e0 = rr[1], e1 = rr[2];
            const int p0 = (int)rt_cnt[16 + e0] + rr[3], p1 = (int)rt_cnt[16 + e1] + rr[4];
            list[e0 * M + p0] = m; lw[e0 * M + p0] = ((const LAS float*)rr)[5]; list[e1 * M + p1] = m; lw[e1 * M + p1] = ((const LAS float*)rr)[6];
            tok_e_w[2 * m] = e0; tok_e_w[2 * m + 1] = e1; tok_pos_w[2 * m] = p0; tok_pos_w[2 * m + 1] = p1;
        }
    }
}

__device__ __forceinline__ void hgrn_combine(const Params& p) {
    const bf16_t* proj = (const bf16_t*)(p.wp[IX_PROJ]);
    const bf16_t* oscr = (const bf16_t*)(p.wp[IX_XB]);
    unsigned char* mix8 = p.wp[IX_ACT]; bf16_t* mix = (bf16_t*)(p.wp[IX_ACT]);
    const float* ng = p.in[6];
    const int tid_ = opaque_tid(), wave = tid_ >> 6, lane = tid_ & 63, c = 16 * lane;
    f32x4 gn[4];
#pragma unroll
    for (int q = 0; q < 4; ++q) gn[q] = *(const f32x4*)(ng + c + 4 * q);
    const int stride = gridDim.x * 8;
    u32x4 na[2][2], nb[2][2], ng_[2][2];
#define HC_LOAD(r0_) do { _Pragma("unroll") for (int r = 0; r < 2; ++r) { const int rw = ((r0_) + r * stride < M) ? (r0_) + r * stride : (r0_); \
        _Pragma("unroll") for (int hq = 0; hq < 2; ++hq) { na[r][hq] = *(const u32x4*)(oscr + (size_t)rw * 1024 + c + 8 * hq); nb[r][hq] = *(const u32x4*)(oscr + ((size_t)M + rw) * 1024 + c + 8 * hq); \
            ng_[r][hq] = *(const u32x4*)(proj + (size_t)rw * LD0 + 4096 + c + 8 * hq); } } } while (0)
    int row = blockIdx.x * 8 + wave;
    if (row < M) HC_LOAD(row);
    for (; row < M; row += 2 * stride) {
        u32x4 a[2][2], bb[2][2], gg[2][2];
#pragma unroll
        for (int r = 0; r < 2; ++r)
#pragma unroll
            for (int hq = 0; hq < 2; ++hq) { a[r][hq] = na[r][hq]; bb[r][hq] = nb[r][hq]; gg[r][hq] = ng_[r][hq]; }
        if (row + 2 * stride < M) HC_LOAD(row + 2 * stride);
#pragma unroll
        for (int r = 0; r < 2; ++r) { const int rw = row + r * stride; if (rw >= M) break;
            float o[16]; float ss = 0.f;
#pragma unroll
            for (int hq = 0; hq < 2; ++hq)
#pragma unroll
                for (int k = 0; k < 4; ++k) { const unsigned x = a[r][hq][k], y = bb[r][hq][k];
                    const float v0 = __uint_as_float(x << 16) + __uint_as_float(y << 16), v1 = __uint_as_float(x & 0xffff0000u) + __uint_as_float(y & 0xffff0000u);
                    o[8 * hq + 2 * k] = v0; o[8 * hq + 2 * k + 1] = v1; ss += v0 * v0 + v1 * v1; }
            ss += __shfl_xor(ss, 1); ss += __shfl_xor(ss, 2); ss += __shfl_xor(ss, 4);
            const float rstd = 1.0f / sqrtf(ss * (1.f / 128.f) + EPS);
            float res[16];
#pragma unroll
            for (int hq = 0; hq < 2; ++hq)
#pragma unroll
                for (int k = 0; k < 4; ++k) { const unsigned g = gg[r][hq][k]; const int i0 = 8 * hq + 2 * k;
                    res[i0] = o[i0] * rstd * gn[i0 >> 2][i0 & 3] * silu(__uint_as_float(g << 16)); res[i0 + 1] = o[i0 + 1] * rstd * gn[(i0 + 1) >> 2][(i0 + 1) & 3] * silu(__uint_as_float(g & 0xffff0000u)); }
            if (OUT_F8) { u32x4 w; w.x = pk4_fp8(res[0] * F8_SM, res[1] * F8_SM, res[2] * F8_SM, res[3] * F8_SM); w.y = pk4_fp8(res[4] * F8_SM, res[5] * F8_SM, res[6] * F8_SM, res[7] * F8_SM);
                w.z = pk4_fp8(res[8] * F8_SM, res[9] * F8_SM, res[10] * F8_SM, res[11] * F8_SM); w.w = pk4_fp8(res[12] * F8_SM, res[13] * F8_SM, res[14] * F8_SM, res[15] * F8_SM);
                *(u32x4*)(mix8 + (size_t)rw * D + c) = w; }
            else { u32x4 w0, w1; w0.x = pk2(res[0], res[1]); w0.y = pk2(res[2], res[3]); w0.z = pk2(res[4], res[5]); w0.w = pk2(res[6], res[7]);
                w1.x = pk2(res[8], res[9]); w1.y = pk2(res[10], res[11]); w1.z = pk2(res[12], res[13]); w1.w = pk2(res[14], res[15]);
                *(u32x4*)(mix + (size_t)rw * D + c) = w0; *(u32x4*)(mix + (size_t)rw * D + c + 8) = w1; }
        }
    }
#undef HC_LOAD
}
__device__ __forceinline__ void rope_pass(const Params& p) {
    bf16_t* proj = (bf16_t*)(p.wp[IX_PROJ]);
    const float* rc = (const float*)(p.wp[IX_ROPE]); const float* rs = rc + 2048 * 16;
    for (size_t i = (size_t)blockIdx.x * 512 + opaque_tid(); i < (size_t)M * 32 * 16; i += (size_t)gridDim.x * 512) {
        const int j = (int)(i & 15), hh = (int)((i >> 4) & 31); const size_t row = i >> 9; const int pos = (int)(row % T);
        bf16_t* a = proj + row * LD1 + hh * 128 + j;
        const float x1 = bf2f(a[0]), x2 = bf2f(a[16]), cc = rc[pos * 16 + j], sn = rs[pos * 16 + j];
        a[0] = f2bf(x1 * cc - x2 * sn); a[16] = f2bf(x1 * sn + x2 * cc);
    }
}
template <bool FINAL, bool OUT8>
__device__ __forceinline__ void phase_combine(const Params& p, LAS unsigned char* lds, const float* xin, float* xnew, const float* g, const float* modl, const float* modprev, bf16_t* hout, float* fout, const unsigned* cnt_prev, const bf16_t* mres) {
    const int tid = opaque_tid(), wave = tid >> 6, lane = tid & 63;
    LAS int* base = (LAS int*)(lds + LDS_BASE_OFF);
    compute_base(cnt_prev, base);
    const int* tok_e = (const int*)(p.wp[IX_TOK]); const int* tok_pos = tok_e + 2 * M;
    const bf16_t* Y = (const bf16_t*)(p.wp[IX_Y]);
    const int stride = gridDim.x * 8;
    int m = blockIdx.x * 8 + wave;
    f32x4 xn[8]; u32x2 mn_[8]; int en0 = 0, en1 = 0, pn0 = 0, pn1 = 0;
    if (m < M) {
#pragma unroll
        for (int j = 0; j < 8; ++j) { xn[j] = *(const f32x4*)(xin + (size_t)m * D + 4 * lane + 256 * j); mn_[j] = *(const u32x2*)(mres + (size_t)m * D + 4 * lane + 256 * j); }
        en0 = tok_e[2 * m]; en1 = tok_e[2 * m + 1]; pn0 = tok_pos[2 * m]; pn1 = tok_pos[2 * m + 1]; }
    for (; m < M; m += stride) {
        const int b = m / T;
        f32x4 xv[8]; u32x2 mv[8];
#pragma unroll
        for (int j = 0; j < 8; ++j) { xv[j] = xn[j]; mv[j] = mn_[j]; }
        const size_t r0 = (size_t)(base[en0] + pn0), r1 = (size_t)(base[en1] + pn1);
        u32x2 ya[8], yb[8];
#pragma unroll
        for (int j = 0; j < 8; ++j) { const int c = 4 * lane + 256 * j; ya[j] = *(const u32x2*)(Y + r0 * D + c); yb[j] = *(const u32x2*)(Y + r1 * D + c); }
        const int mn = m + stride;
        if (mn < M) {
#pragma unroll
            for (int j = 0; j < 8; ++j) { xn[j] = *(const f32x4*)(xin + (size_t)mn * D + 4 * lane + 256 * j); mn_[j] = *(const u32x2*)(mres + (size_t)mn * D + 4 * lane + 256 * j); }
            en0 = tok_e[2 * mn]; en1 = tok_e[2 * mn + 1]; pn0 = tok_pos[2 * mn]; pn1 = tok_pos[2 * mn + 1]; }
        const float* gt = modprev + (size_t)b * 12288 + 5 * D; const float* gta = modprev + (size_t)b * 12288 + 2 * D;
        float ss = 0.f;
#pragma unroll
        for (int j = 0; j < 8; ++j) { const int c = 4 * lane + 256 * j; const f32x4 gv = *(const f32x4*)(gt + c), ga = *(const f32x4*)(gta + c); const u32x2 a = ya[j], bb = yb[j], mm = mv[j];
            xv[j].x += ga.x * __uint_as_float(mm.x << 16); xv[j].y += ga.y * __uint_as_float(mm.x & 0xffff0000u); xv[j].z += ga.z * __uint_as_float(mm.y << 16); xv[j].w += ga.w * __uint_as_float(mm.y & 0xffff0000u);
            xv[j].x += gv.x * (__uint_as_float(a.x << 16) + __uint_as_float(bb.x << 16)); xv[j].y += gv.y * (__uint_as_float(a.x & 0xffff0000u) + __uint_as_float(bb.x & 0xffff0000u));
            xv[j].z += gv.z * (__uint_as_float(a.y << 16) + __uint_as_float(bb.y << 16)); xv[j].w += gv.w * (__uint_as_float(a.y & 0xffff0000u) + __uint_as_float(bb.y & 0xffff0000u));
            if (!FINAL) *(f32x4*)(xnew + (size_t)m * D + c) = xv[j];
            ss += xv[j].x * xv[j].x + xv[j].y * xv[j].y + xv[j].z * xv[j].z + xv[j].w * xv[j].w; }
        ss = wave_sum(ss);
        const float rstd = 1.0f / sqrtf(ss * (1.f / D) + EPS);
        if (FINAL) {
#pragma unroll
            for (int j = 0; j < 8; ++j) { const int c = 4 * lane + 256 * j; const f32x4 gv = *(const f32x4*)(g + c); *(f32x4*)(fout + (size_t)m * D + c) = xv[j] * rstd * gv; }
        } else {
            const float* sh = modl + (size_t)b * 12288; const float* sc = modl + (size_t)b * 12288 + D;
#pragma unroll
            for (int j = 0; j < 8; ++j) { const int c = 4 * lane + 256 * j;
                const f32x4 gv = *(const f32x4*)(g + c), shv = *(const f32x4*)(sh + c), scv = *(const f32x4*)(sc + c);
                const f32x4 hv = xv[j] * rstd * gv * (1.f + scv) + shv;
                if (OUT8) *(unsigned*)((unsigned char*)hout + (size_t)m * D + c) = pk4_fp8(hv.x * F8_SA, hv.y * F8_SA, hv.z * F8_SA, hv.w * F8_SA);
                else { u32x2 o; o.x = pk2(hv.x, hv.y); o.y = pk2(hv.z, hv.w); *(u32x2*)(hout + (size_t)m * D + c) = o; } }
        }
    }
}

__device__ __forceinline__ void conv_item(const float* W, int K, int N, bf16_t* WT, int k0, int n0, int drow0, LAS unsigned* scr, int lane, bool rperm = false) {
    const int q = lane >> 4, n4 = lane & 15;
    f32x4 va[8], vb[8];
#pragma unroll
    for (int i = 0; i < 8; ++i) { const int rp = 4 * i + q;
        va[i] = *(const f32x4*)(W + (size_t)(k0 + 2 * rp) * N + n0 + 4 * n4); vb[i] = *(const f32x4*)(W + (size_t)(k0 + 2 * rp + 1) * N + n0 + 4 * n4); }
#pragma unroll
    for (int i = 0; i < 8; ++i) { const int rp = 4 * i + q; LAS unsigned* sp = scr + (4 * n4) * 33 + rp;
        sp[0] = pk2(va[i].x, vb[i].x); sp[33] = pk2(va[i].y, vb[i].y); sp[66] = pk2(va[i].z, vb[i].z); sp[99] = pk2(va[i].w, vb[i].w); }
    asm volatile("s_waitcnt lgkmcnt(0)" ::: "memory");
    const int c = lane & 7;
#pragma unroll
    for (int j = 0; j < 8; ++j) {
        const int n = (lane >> 3) + 8 * j; const LAS unsigned* sp = scr + n * 33 + 4 * c;
        u32x4 o; o.x = sp[0]; o.y = sp[1]; o.z = sp[2]; o.w = sp[3];
        const int nr = (rperm && n < 32) ? ((n < 16) ? 2 * n : 2 * (n - 16) + 1) : n;
        *(u32x4*)(WT + (size_t)(drow0 + nr) * K + k0 + 8 * c) = o;
    }
    asm volatile("s_waitcnt lgkmcnt(0)" ::: "memory");
}
__device__ __forceinline__ void conv_item8(const float* W, int K, int N, unsigned char* WT, int k0, int n0, int drow0, LAS unsigned* scr, int lane, float sc, bool rperm = false) {
    const int q = lane >> 4, n4 = lane & 15;
    f32x4 v[4][4];
#pragma unroll
    for (int i = 0; i < 4; ++i)
#pragma unroll
        for (int t = 0; t < 4; ++t) v[i][t] = __builtin_nontemporal_load((const f32x4*)(W + (size_t)(k0 + 4 * (4 * i + q) + t) * N + n0 + 4 * n4));
#pragma unroll
    for (int i = 0; i < 4; ++i) { const int rp = 4 * i + q; LAS unsigned* sp = scr + (4 * n4) * 17 + rp;
        sp[0]  = pk4_fp8(v[i][0].x * sc, v[i][1].x * sc, v[i][2].x * sc, v[i][3].x * sc);
        sp[17] = pk4_fp8(v[i][0].y * sc, v[i][1].y * sc, v[i][2].y * sc, v[i][3].y * sc);
        sp[34] = pk4_fp8(v[i][0].z * sc, v[i][1].z * sc, v[i][2].z * sc, v[i][3].z * sc);
        sp[51] = pk4_fp8(v[i][0].w * sc, v[i][1].w * sc, v[i][2].w * sc, v[i][3].w * sc); }
    asm volatile("s_waitcnt lgkmcnt(0)" ::: "memory");
    const int c = lane & 3;
#pragma unroll
    for (int j = 0; j < 4; ++j) {
        const int n = (lane >> 2) + 16 * j; const LAS unsigned* sp = scr + n * 17 + 4 * c;
        u32x4 o; o.x = sp[0]; o.y = sp[1]; o.z = sp[2]; o.w = sp[3];
        const int nr = (rperm && n < 32) ? ((n < 16) ? 2 * n : 2 * (n - 16) + 1) : n;
        *(u32x4*)(WT + (size_t)(drow0 + nr) * K + k0 + 16 * c) = o;
    }
    asm volatile("s_waitcnt lgkmcnt(0)" ::: "memory");
}
namespace cv {
constexpr int I_IN0 = 32 * 128, I_OUT = 32 * 32, I_G = 16 * 32 * 16, I_D = 16 * 16 * 32, I_IN1 = 32 * 96;
constexpr int I_L0 = I_IN0 + I_OUT + 2 * I_G + I_D, I_L1 = I_IN1 + I_OUT + 2 * I_G + I_D, NIT = I_L0 + I_L1;
constexpr int NIT_P0 = NIT - (2 * I_G + I_D);
constexpr int N_P0 = NIT_P0 - (2 * I_G + I_D), N_NAW = 6144, N_GW = 2 * I_G + I_D - N_NAW;
__device__ __forceinline__ int it_p0(int v) { return v < I_IN0 + I_OUT ? v : v + N_GW + N_NAW; }
}
__device__ __forceinline__ void conv_dispatch(const Params& p, int it, LAS unsigned* scr, int lane) {
    using namespace cv;
    int r = it; const int l = (r >= I_L0) ? 1 : 0; if (l) r -= I_L0;
    const int i_in = l ? I_IN1 : I_IN0;
    if (r < i_in) { const int N = l ? ODW : EVW, nb = N / 64;
        conv_item8(p.in[l ? 16 : 5], D, N, l ? p.wp[IX_WIN1] : p.wp[IX_WIN0], (r / nb) * 64, (r % nb) * 64, (r % nb) * 64, scr, lane, F8_SW, l == 1 && (r % nb) < 64 && ((r % nb) & 1) == 0);
        return; } r -= i_in;
    if (r < I_OUT) { if (OUT_F8) conv_item8(p.in[l ? 19 : 8], D, D, l ? p.wp[IX_WOUT1] : p.wp[IX_WOUT0], (r / 32) * 64, (r % 32) * 64, (r % 32) * 64, scr, lane, F8_SWD);
        else conv_item(p.in[l ? 19 : 8], D, D, (bf16_t*)(l ? p.wp[IX_WOUT1] : p.wp[IX_WOUT0]), (r / 32) * 64, (r % 32) * 64, (r % 32) * 64, scr, lane); return; } r -= I_OUT;
    if (r < 2 * I_G) { const int up = r >= I_G; if (up) r -= I_G; const int e = r / 512, rr = r % 512, kb = rr / 16, nb = rr % 16, n0 = nb * 64;
        conv_item8(p.in[(l ? 21 : 10) + up] + (size_t)e * D * DFF, D, DFF, (l ? p.wp[IX_WGU1] : p.wp[IX_WGU0]) + (size_t)e * 2048 * D, kb * 64, n0, (n0 >> 7) * 256 + (n0 & 127) + up * 128, scr, lane, F8_SW);
        return; } r -= 2 * I_G;
    { const int e = r / 512, rr = r % 512, kb = rr / 32, nb = rr % 32;
        conv_item8(p.in[l ? 23 : 12] + (size_t)e * DFF * D, DFF, D, (l ? p.wp[IX_WD1] : p.wp[IX_WD0]) + (size_t)e * D * DFF, kb * 64, nb * 64, nb * 64, scr, lane, F8_SWD); }
}
__device__ __forceinline__ void phase_convert(const Params& p, LAS unsigned char* lds) {
    const int tid_ = opaque_tid(), wave = tid_ >> 6, lane = tid_ & 63;
    LAS unsigned* scr = (LAS unsigned*)lds + wave * (64 * 33);
    constexpr int HEAD = 4096; const int nfree = (int)gridDim.x - 192;
    const int NIT = cv::N_P0, nhead = (nfree > 0) ? HEAD : 0;
    for (int pass = 0; pass < 2; ++pass)
    for (int it = (pass == 0) ? (((int)blockIdx.x - 192) * 8 + wave) : (nhead + (int)blockIdx.x * 8 + wave); (pass == 0) ? (nfree > 0 && (int)blockIdx.x >= 192 && it < nhead) : (it < NIT); it += ((pass == 0) ? nfree : (int)gridDim.x) * 8)
        conv_dispatch(p, cv::it_p0(it), scr, lane);
}
struct ConvHook { const Params* p; LAS unsigned char* lds; int slot; bool done;
    __device__ __forceinline__ void run() { done = true;
        const int tid_ = opaque_tid(), wave = tid_ >> 6, lane = tid_ & 63;
        if (wave < 7) { LAS unsigned* scr = (LAS unsigned*)(lds + 131072) + wave * (64 * 17);
            for (int v = (int)blockIdx.x * 7 + wave; v < cv::N_GW; v += (int)gridDim.x * 7) conv_dispatch(*p, cv::I_IN0 + cv::I_OUT + v, scr, lane); } }
    __device__ __forceinline__ void operator()(int ui) { if (ui == slot) run(); }
};
__device__ __forceinline__ void convert_naw(const Params& p, LAS unsigned char* lds, int widx, int nw) {
    const int tid_ = opaque_tid(), wave = tid_ >> 6, lane = tid_ & 63;
    LAS unsigned* scr = (LAS unsigned*)lds + wave * (64 * 33);
    __syncthreads();
    for (int v = widx * 8 + wave; v < cv::N_NAW; v += nw * 8) conv_dispatch(p, cv::I_IN0 + cv::I_OUT + cv::N_GW + v, scr, lane);
    __syncthreads();
}
struct NoHook { __device__ __forceinline__ void operator()(int) {} };
__device__ __forceinline__ void convert_late(const Params& p, LAS unsigned char* lds) {
    const int tid_ = opaque_tid(), wave = tid_ >> 6, lane = tid_ & 63;
    LAS unsigned* scr = (LAS unsigned*)lds + wave * (64 * 33);
    for (int it = cv::NIT_P0 + (int)blockIdx.x * 8 + wave; it < cv::NIT; it += (int)gridDim.x * 8) conv_dispatch(p, it, scr, lane);
    __syncthreads();
}
namespace pg8 {
typedef short bf16x8 __attribute__((ext_vector_type(8)));
typedef int v4i_t __attribute__((ext_vector_type(4)));
typedef int v8i_t __attribute__((ext_vector_type(8)));
constexpr int BM = 256, BK = 64, HALF = 128, HTB = HALF * BK * 2, STAGE_BYTES = 8 * HTB, NXCD = 8, WGM = 8;
__host__ __device__ __forceinline__ int lds_byte(int r, int c) { const int st = (r >> 4) * 2 + (c >> 5), rr = r & 15, cc = c & 31, ob = rr * 64 + cc * 2; return st * 1024 + (ob ^ (((ob >> 9) & 1) << 5)); }
__host__ __device__ __forceinline__ void stage_rc(int b, int& R, int& C) { const int st = b / 1024, sb = b % 1024, swz = sb ^ (((sb >> 9) & 1) << 5); R = (st >> 1) * 16 + swz / 64; C = (st & 1) * 32 + (swz % 64) / 2; }
__host__ __device__ __forceinline__ int perm32(int rho) { const int n = rho >> 4, i = rho & 15; return 8 * (i >> 2) + 4 * n + (i & 3); }
struct Unit { int pm, pn, e; };
struct StaticOrder {
    static constexpr bool GATHER = false, SIGF = false, WAITF = false;
    int nM, nN, nwg, G, c;
    __device__ void init(int M_, int N_, int G_, int c_) { nM = M_ / BM; nN = N_ / BM; nwg = nM * nN; G = G_; c = c_; }
    __device__ __forceinline__ bool next(int i, Unit& u) const {
        const long L = (long)i * G + c; if (L >= nwg) return false;
        int wgid = (int)L; { const int q = nwg / NXCD, r = nwg % NXCD, xcd = wgid % NXCD, off = wgid / NXCD; wgid = (xcd < r ? xcd * (q + 1) : r * (q + 1) + (xcd - r) * q) + off; }
        const int nig = WGM * nN, gid = wgid / nig, fm = gid * WGM, gsz = (nM - fm) < WGM ? (nM - fm) : WGM;
        u.pm = fm + ((wgid % nig) % gsz); u.pn = (wgid % nig) / gsz; u.e = 0; return true;
    }
    __device__ __forceinline__ size_t brow(const Unit& u) const { return (size_t)u.pn * BM; }
    __device__ __forceinline__ unsigned arow(const Unit&, int) const { return 0u; }
};
template <bool GATHER_, int TG = 0, bool SIGF_ = false, bool WAITF_ = false>
struct MoeOrder {
    static constexpr bool GATHER = GATHER_, SIGF = SIGF_, WAITF = WAITF_;
    const LAS int* base; const int* list; const unsigned* cnt; int G, c, nT; unsigned* flg;
    __device__ __forceinline__ bool next(int i, Unit& u) const {
        int pm, pn;
        if ((G & 63) == 0) { const int xcd = (c + (WAITF ? 3 : 0)) & 7, j = c >> 3, rt = G >> 6;
            const int nfull = nT / (8 * rt);
            if (i < nfull) pm = (i * 8 + xcd) * rt + (j >> 3);
            else { const int s = (i - nfull) * rt + (((j >> 3) + TG) % rt); pm = nfull * 8 * rt + s * 8 + xcd; }
            pn = j & 7; }
        else { const int L = i * G + c; pm = L >> 3; pn = L & 7; }
        if (pm >= nT) return false;
        u.pm = pm; u.pn = pn; int e = 0;
#pragma unroll
        for (int q = 1; q < NE; ++q) e += (pm * BM >= base[q]) ? 1 : 0;
        u.e = e; return true;
    }
    __device__ __forceinline__ void wait(const Unit& u) const {
        while (__hip_atomic_load(flg + u.pm, __ATOMIC_RELAXED, __HIP_MEMORY_SCOPE_AGENT) < 8u) __builtin_amdgcn_s_sleep(2);
        asm volatile("" ::: "memory");
    }
    __device__ __forceinline__ size_t brow(const Unit& u) const { return (size_t)u.e * 2048 + (size_t)u.pn * BM; }
    __device__ __forceinline__ unsigned arow(const Unit& u, int r) const { const int pos = u.pm * BM + r - base[u.e]; const unsigned t = (unsigned)list[u.e * M + pos]; return (pos < (int)cnt[u.e]) ? t : 0u; }
};

struct EpiBf16 { static constexpr bool PERM = true; bf16_t* O; int ldc; float sc = 1.f;
    __device__ __forceinline__ void operator()(const f32x4 (&acc)[2][2][4][2], const Unit& u, int wr, int wc, int fr, int fq) const {
        const int row0 = u.pm * BM + wr * 64 + fr, col0 = u.pn * BM + wc * 32 + 8 * fq;
#pragma unroll
        for (int ai = 0; ai < 2; ++ai)
#pragma unroll
            for (int m = 0; m < 4; ++m) { bf16_t* rowp = O + (size_t)(row0 + ai * HALF + m * 16) * ldc + col0;
#pragma unroll
                for (int bj = 0; bj < 2; ++bj) { const f32x4 v0 = acc[ai][bj][m][0] * sc, v1 = acc[ai][bj][m][1] * sc;
                    u32x4 w; w.x = pk2(v0[0], v0[1]); w.y = pk2(v0[2], v0[3]); w.z = pk2(v1[0], v1[1]); w.w = pk2(v1[2], v1[3]);
                    *(u32x4*)(rowp + bj * HALF) = w; } }
    }
};
struct EpiProj0 { static constexpr bool PERM = true; bf16_t* O; int ldc; float sc;
    __device__ __forceinline__ void operator()(const f32x4 (&acc)[2][2][4][2], const Unit& u, int wr, int wc, int fr, int fq) const {
        const int row0 = u.pm * BM + wr * 64 + fr, col0 = u.pn * BM + wc * 32 + 8 * fq; const int mode = (u.pn < 4 || (u.pn >= 16 && u.pn < 20)) ? 1 : ((u.pn >= 8 && u.pn < 16) ? 2 : 0);
#pragma unroll
        for (int ai = 0; ai < 2; ++ai)
#pragma unroll
            for (int m = 0; m < 4; ++m) { bf16_t* rowp = O + (size_t)(row0 + ai * HALF + m * 16) * ldc + col0;
#pragma unroll
                for (int bj = 0; bj < 2; ++bj) { f32x4 v0 = acc[ai][bj][m][0] * sc, v1 = acc[ai][bj][m][1] * sc;
                    if (mode == 1) {
#pragma unroll
                        for (int e = 0; e < 4; ++e) { v0[e] = silu(v0[e]); v1[e] = silu(v1[e]); } }
                    else if (mode == 2) {
#pragma unroll
                        for (int e = 0; e < 4; ++e) { v0[e] = frcp(1.f + __expf(v0[e])); v1[e] = frcp(1.f + __expf(v1[e])); } }
                    u32x4 w; w.x = pk2(v0[0], v0[1]); w.y = pk2(v0[2], v0[3]); w.z = pk2(v1[0], v1[1]); w.w = pk2(v1[2], v1[3]);
                    *(u32x4*)(rowp + bj * HALF) = w; } }
    }
};
struct EpiBf16Rope { static constexpr bool PERM = true; bf16_t* O; int ldc; const float* rc; const float* rs; float sc;
    __device__ __forceinline__ void operator()(const f32x4 (&acc)[2][2][4][2], const Unit& u, int wr, int wc, int fr, int fq) const {
        const int row0 = u.pm * BM + wr * 64 + fr, col0 = u.pn * BM + wc * 32 + 8 * fq; const bool rot = (u.pn < 16) && (wc == 0);
#pragma unroll
        for (int ai = 0; ai < 2; ++ai)
#pragma unroll
            for (int m = 0; m < 4; ++m) { const int row = row0 + ai * HALF + m * 16; bf16_t* rowp = O + (size_t)row * ldc + col0;
                f32x4 cv = {1.f, 1.f, 1.f, 1.f}, sv = {0.f, 0.f, 0.f, 0.f};
                if (rot) { const int pos = row & (T - 1); cv = *(const f32x4*)(rc + pos * 16 + 4 * fq); sv = *(const f32x4*)(rs + pos * 16 + 4 * fq); }
#pragma unroll
                for (int bj = 0; bj < 2; ++bj) { f32x4 v0 = acc[ai][bj][m][0] * sc, v1 = acc[ai][bj][m][1] * sc;
                    if (rot) { const f32x4 a = v0, b = v1;
                        v0[0] = a[0] * cv[0] - a[1] * sv[0]; v0[1] = a[0] * sv[0] + a[1] * cv[0]; v0[2] = a[2] * cv[1] - a[3] * sv[1]; v0[3] = a[2] * sv[1] + a[3] * cv[1];
                        v1[0] = b[0] * cv[2] - b[1] * sv[2]; v1[1] = b[0] * sv[2] + b[1] * cv[2]; v1[2] = b[2] * cv[3] - b[3] * sv[3]; v1[3] = b[2] * sv[3] + b[3] * cv[3]; }
                    u32x4 w; w.x = pk2(v0[0], v0[1]); w.y = pk2(v0[2], v0[3]); w.z = pk2(v1[0], v1[1]); w.w = pk2(v1[2], v1[3]);
                    *(u32x4*)(rowp + bj * HALF) = w; } }
    }
};
struct EpiResF32 { static constexpr bool PERM = false; const float* xin; float* xout; const float* gt; float sc = 1.f;
    __device__ __forceinline__ void operator()(const f32x4 (&acc)[2][2][4][2], const Unit& u, int wr, int wc, int fr, int fq) const {
        const int row0 = u.pm * BM + wr * 64 + fr, col0 = u.pn * BM + wc * 32 + 4 * fq; const int b = (u.pm * BM) / T;
        f32x4 gv[2][2];
#pragma unroll
        for (int bj = 0; bj < 2; ++bj)
#pragma unroll
            for (int n = 0; n < 2; ++n) gv[bj][n] = *(const f32x4*)(gt + (size_t)b * 12288 + col0 + bj * HALF + n * 16);
        f32x4 xi[2][2][2];
#pragma unroll
        for (int bj = 0; bj < 2; ++bj)
#pragma unroll
            for (int n = 0; n < 2; ++n) xi[0][bj][n] = *(const f32x4*)(xin + (size_t)row0 * D + col0 + bj * HALF + n * 16);
#pragma unroll
        for (int g = 0; g < 8; ++g) { const int ai = g >> 2, m = g & 3; const size_t off = (size_t)(row0 + ai * HALF + m * 16) * D + col0;
            if (g + 1 < 8) { const int ai2 = (g + 1) >> 2, m2 = (g + 1) & 3; const size_t off2 = (size_t)(row0 + ai2 * HALF + m2 * 16) * D + col0;
#pragma unroll
                for (int bj = 0; bj < 2; ++bj)
#pragma unroll
                    for (int n = 0; n < 2; ++n) xi[(g + 1) & 1][bj][n] = *(const f32x4*)(xin + off2 + bj * HALF + n * 16); }
            __builtin_amdgcn_sched_barrier(0);
#pragma unroll
            for (int bj = 0; bj < 2; ++bj)
#pragma unroll
                for (int n = 0; n < 2; ++n) *(f32x4*)(xout + off + bj * HALF + n * 16) = xi[g & 1][bj][n] + gv[bj][n] * (acc[ai][bj][m][n] * sc);
            __builtin_amdgcn_sched_barrier(0); }
    }
};
struct EpiGluBf16 { static constexpr bool PERM = true; bf16_t* H; const float* lw; const unsigned* cnt; const LAS int* base;
    __device__ __forceinline__ void operator()(const f32x4 (&acc)[2][2][4][2], const Unit& u, int wr, int wc, int fr, int fq) const {
        const int row0 = u.pm * BM + wr * 64 + fr, col0 = u.pn * HALF + wc * 32 + 8 * fq; const int eb = base[u.e], ec = (int)cnt[u.e];
#pragma unroll
        for (int ai = 0; ai < 2; ++ai)
#pragma unroll
            for (int m = 0; m < 4; ++m) { const int row = row0 + ai * HALF + m * 16, pos = row - eb; const float w = (pos < ec) ? lw[u.e * M + pos] : 0.f;
                const f32x4 g0 = acc[ai][0][m][0], g1 = acc[ai][0][m][1], u0 = acc[ai][1][m][0], u1 = acc[ai][1][m][1];
                u32x4 o; o.x = pk2(silu(g0[0]) * u0[0] * w, silu(g0[1]) * u0[1] * w); o.y = pk2(silu(g0[2]) * u0[2] * w, silu(g0[3]) * u0[3] * w);
                o.z = pk2(silu(g1[0]) * u1[0] * w, silu(g1[1]) * u1[1] * w); o.w = pk2(silu(g1[2]) * u1[2] * w, silu(g1[3]) * u1[3] * w);
                *(u32x4*)(H + (size_t)row * DFF + col0) = o; }
    }
};

struct EpiGluF8 { static constexpr bool PERM = true; unsigned char* H; const float* lw; const unsigned* cnt; const LAS int* base;
    __device__ __forceinline__ void operator()(const f32x4 (&acc)[2][2][4][2], const Unit& u, int wr, int wc, int fr, int fq) const {
        const int row0 = u.pm * BM + wr * 64 + fr, col0 = u.pn * HALF + wc * 32 + 8 * fq; const int eb = base[u.e], ec = (int)cnt[u.e];
        constexpr float DQ = 1.f / (F8_SA * F8_SW);
        float wrow[8];
#pragma unroll
        for (int g = 0; g < 8; ++g) { const int pos = row0 + (g >> 2) * HALF + (g & 3) * 16 - eb; wrow[g] = lw[u.e * M + pos]; wrow[g] = (pos < ec) ? wrow[g] * (F8_SH * DQ) : 0.f; }
#pragma unroll
        for (int ai = 0; ai < 2; ++ai)
#pragma unroll
            for (int m = 0; m < 4; ++m) { const int row = row0 + ai * HALF + m * 16; const float w = wrow[ai * 4 + m];
                const f32x4 g0 = acc[ai][0][m][0] * DQ, g1 = acc[ai][0][m][1] * DQ, u0 = acc[ai][1][m][0], u1 = acc[ai][1][m][1];
                u32x2 o; o.x = pk4_fp8(silu(g0[0]) * u0[0] * w, silu(g0[1]) * u0[1] * w, silu(g0[2]) * u0[2] * w, silu(g0[3]) * u0[3] * w);
                o.y = pk4_fp8(silu(g1[0]) * u1[0] * w, silu(g1[1]) * u1[1] * w, silu(g1[2]) * u1[2] * w, silu(g1[3]) * u1[3] * w);
                __hip_atomic_store((unsigned long long*)(H + (size_t)row * DFF + col0), ((unsigned long long)o.y << 32) | (unsigned long long)o.x, __ATOMIC_RELAXED, __HIP_MEMORY_SCOPE_AGENT); }
    }
};
template <class Epi, class Sched, bool ALIGN_EPI, bool SP2, bool F8 = false, class Hook = NoHook>
__device__ __forceinline__ void gemm_phase(LAS unsigned char* lds, const void* Ap, const void* Btp, const int K, const Sched& S, const Epi& E, Hook&& hook = Hook{}) {
    constexpr bool GATHER = Sched::GATHER; constexpr int ESZ = F8 ? 1 : 2;
    const int tid = opaque_tid(), wid = __builtin_amdgcn_readfirstlane(tid >> 6), lane = tid & 63, wr = wid >> 2, wc = wid & 3, fr = lane & 15, fq = lane >> 4;
    const int nt = K * ESZ / (BK * 2);
    unsigned voffA[2], voffB[2]; int sR[2], sC[2];
#pragma unroll
    for (int i = 0; i < 2; ++i) { int R, C; stage_rc(tid * 16 + i * 8192, R, C); const int Rb = Epi::PERM ? ((R & ~31) + perm32(R & 31)) : R; sR[i] = R; sC[i] = C;
        voffA[i] = (unsigned)(R * K * ESZ + C * 2); voffB[i] = (unsigned)(Rb * K * ESZ + C * 2); }
    const size_t kstep = (size_t)(BK * 2);
    const size_t hstep = (size_t)HALF * K * ESZ;
    const size_t tstep = 2 * hstep;
    const unsigned ldsw = (unsigned)wid * 1024u;
    const int aoff = lds_byte(wr * 64 + fr, fq * 8), boff = lds_byte(wc * 32 + fr, fq * 8);
#define PG8_SA(b, h) (((b) * 2 + (h)) * HTB)
#define PG8_SB(b, h) ((4 + (b) * 2 + (h)) * HTB)
#define PG8_ST2X(bufoff, gbase, o0, o1, AUX) do { unsigned _a = (o0), _b = (o1); asm volatile("" : "+v"(_a), "+v"(_b));   \
        __builtin_amdgcn_global_load_lds((const unsigned*)((const char*)(gbase) + _a), (LAS unsigned*)(lds + (bufoff) + ldsw), 16, 0, AUX); \
        __builtin_amdgcn_global_load_lds((const unsigned*)((const char*)(gbase) + _b), (LAS unsigned*)(lds + (bufoff) + ldsw + 8192), 16, 0, AUX); } while (0)
#define PG8_ST2(bufoff, gbase, o0, o1) PG8_ST2X(bufoff, gbase, o0, o1, 0)
#define PG8_STAGEB(bufoff, gbase) PG8_ST2(bufoff, gbase, voffB[0], voffB[1])
#define PG8_STAGEA(bufoff, P, KB, OV, h) do { if constexpr (GATHER) PG8_ST2(bufoff, (const char*)Ap + (KB), OV[h][0], OV[h][1]); else if constexpr (Sched::WAITF) PG8_ST2X(bufoff, (P) + (h) * hstep, voffA[0], voffA[1], 16);   else PG8_ST2(bufoff, (P) + (h) * hstep, voffA[0], voffA[1]); } while (0)
#define PG8_LDA(dst, b, h) do { _Pragma("unroll") for (int m = 0; m < 4; ++m) { if constexpr (F8) dst##8[m] = __builtin_shufflevector(*(const LAS v4i_t*)(lds + PG8_SA(b, h) + aoff + m * 2048), *(const LAS v4i_t*)(lds + PG8_SA(b, h) + aoff + m * 2048 + 1024), 0, 1, 2, 3, 4, 5, 6, 7); \
        else { _Pragma("unroll") for (int k = 0; k < 2; ++k) dst[m][k] = *(const LAS bf16x8*)(lds + PG8_SA(b, h) + aoff + m * 2048 + k * 1024); } } } while (0)
#define PG8_LDB(dst, b, h) do { _Pragma("unroll") for (int n = 0; n < 2; ++n) { if constexpr (F8) dst##8[n] = __builtin_shufflevector(*(const LAS v4i_t*)(lds + PG8_SB(b, h) + boff + n * 2048), *(const LAS v4i_t*)(lds + PG8_SB(b, h) + boff + n * 2048 + 1024), 0, 1, 2, 3, 4, 5, 6, 7); \
        else { _Pragma("unroll") for (int k = 0; k < 2; ++k) dst[n][k] = *(const LAS bf16x8*)(lds + PG8_SB(b, h) + boff + n * 2048 + k * 1024); } } } while (0)
#define PG8_CAT(x) __builtin_shufflevector(__builtin_bit_cast(v4i_t, (x)[0]), __builtin_bit_cast(v4i_t, (x)[1]), 0, 1, 2, 3, 4, 5, 6, 7)
#define PG8_MMA(ai, bj, At, Bt) do { __builtin_amdgcn_s_setprio(1); _Pragma("unroll") for (int m = 0; m < 4; ++m) _Pragma("unroll") for (int n = 0; n < 2; ++n) { \
        if constexpr (F8) asm volatile("v_mfma_scale_f32_16x16x128_f8f6f4 %0, %1, %2, %0, %3, %3 op_sel_hi:[0,0,0]" : "+v"(acc[ai][bj][m][n]) : "v"(Bt##8[n]), "v"(At##8[m]), "v"(sc127));   \
        else { _Pragma("unroll") for (int k = 0; k < 2; ++k) acc[ai][bj][m][n] = __builtin_amdgcn_mfma_f32_16x16x32_bf16(Bt[n][k], At[m][k], acc[ai][bj][m][n], 0, 0, 0); } } __builtin_amdgcn_s_setprio(0); } while (0)
#define PG8_WAIT_V(n) asm volatile("s_waitcnt vmcnt(" #n ")" ::: "memory")
#define PG8_WAIT_L(n) asm volatile("s_waitcnt lgkmcnt(" #n ")" ::: "memory")
#define PG8_BAR __builtin_amdgcn_s_barrier()
#define PG8_SCHED __builtin_amdgcn_sched_barrier(0)
    Unit cur, nxt; int ui = 0;
    if (!S.next(0, cur)) return;
    if constexpr (Sched::WAITF) S.wait(cur);
    f32x4 acc[2][2][4][2];
#pragma unroll
    for (int a = 0; a < 2; ++a)
#pragma unroll
        for (int b = 0; b < 2; ++b)
#pragma unroll
            for (int m = 0; m < 4; ++m)
#pragma unroll
                for (int n = 0; n < 2; ++n) acc[a][b][m][n] = (f32x4){0.f, 0.f, 0.f, 0.f};
    const int sc127 = 0x7F7F7F7F;
    bf16x8 At[4][2], B0[2][2], B1[2][2]; v8i_t At8[4], B08[2], B18[2];
    unsigned vc[2][2] = {{0u, 0u}, {0u, 0u}}, vn[2][2] = {{0u, 0u}, {0u, 0u}};
    if constexpr (GATHER) {
#pragma unroll
        for (int h = 0; h < 2; ++h)
#pragma unroll
            for (int i = 0; i < 2; ++i) vc[h][i] = S.arow(cur, h * HALF + sR[i]) * (unsigned)(K * ESZ) + (unsigned)sC[i] * 2u;
    }
    const char* cA = (const char*)Ap + (GATHER ? (size_t)0 : (size_t)cur.pm * tstep); const char* cB = (const char*)Btp + S.brow(cur) * (size_t)K * ESZ;
    if constexpr (SP2) {
        PG8_STAGEB(PG8_SB(0, 0), cB); PG8_STAGEB(PG8_SB(0, 1), cB + hstep); PG8_STAGEA(PG8_SA(0, 0), cA, 0, vc, 0); PG8_STAGEA(PG8_SA(0, 1), cA, 0, vc, 1);
        if (wr == 1) PG8_BAR;
        PG8_WAIT_V(2); PG8_BAR;
        PG8_STAGEB(PG8_SB(1, 0), cB + kstep); PG8_STAGEA(PG8_SA(1, 0), cA + kstep, kstep, vc, 0); PG8_STAGEB(PG8_SB(1, 1), cB + hstep + kstep);
        PG8_WAIT_V(6); PG8_BAR;
    } else {
        PG8_STAGEB(PG8_SB(0, 0), cB); PG8_STAGEA(PG8_SA(0, 0), cA, 0, vc, 0); PG8_STAGEB(PG8_SB(0, 1), cB + hstep); PG8_STAGEA(PG8_SA(0, 1), cA, 0, vc, 1);
        if (wr == 1) PG8_BAR;
        PG8_WAIT_V(4); PG8_BAR;
        PG8_STAGEB(PG8_SB(1, 0), cB + kstep); PG8_STAGEA(PG8_SA(1, 0), cA + kstep, kstep, vc, 0); PG8_STAGEB(PG8_SB(1, 1), cB + hstep + kstep);
        PG8_WAIT_V(6); PG8_BAR;
    }
    for (;;) {
        const bool has_next = S.next(ui + 1, nxt);
        if constexpr (Sched::WAITF) { if (has_next) S.wait(nxt); }
        const char* nA = (has_next && !GATHER) ? (const char*)Ap + (size_t)nxt.pm * tstep : cA; const char* nB = has_next ? (const char*)Btp + S.brow(nxt) * (size_t)K * ESZ : cB;
        if constexpr (GATHER) {
#pragma unroll
            for (int h = 0; h < 2; ++h)
#pragma unroll
                for (int i = 0; i < 2; ++i) vn[h][i] = has_next ? S.arow(nxt, h * HALF + sR[i]) * (unsigned)(K * ESZ) + (unsigned)sC[i] * 2u : vc[h][i];
        }
#pragma unroll 1
        for (int t = 0; t < nt; t += 2) {
            const bool last = (t == nt - 2);
            const char* a1 = cA + (size_t)(t + 1) * kstep; const size_t kb1 = (size_t)(t + 1) * kstep;
            const char* a2 = last ? nA : cA + (size_t)(t + 2) * kstep; const char* b2 = last ? nB : cB + (size_t)(t + 2) * kstep;
            const char* a3 = a2 + kstep; const char* b3 = b2 + kstep;
            const size_t kb2 = last ? (size_t)0 : (size_t)(t + 2) * kstep, kb3 = kb2 + kstep;
            unsigned v2[2][2];
#pragma unroll
            for (int h = 0; h < 2; ++h)
#pragma unroll
                for (int i = 0; i < 2; ++i) v2[h][i] = last ? vn[h][i] : vc[h][i];
            if constexpr (SP2) {
            PG8_LDB(B0, 0, 0); PG8_LDB(B1, 0, 1); PG8_SCHED; PG8_LDA(At, 0, 0); PG8_STAGEA(PG8_SA(1, 1), a1, kb1, vc, 1);
            PG8_WAIT_V(8); PG8_WAIT_L(0); PG8_BAR; PG8_MMA(0, 0, At, B0); PG8_MMA(0, 1, At, B1); PG8_BAR; PG8_SCHED;
            PG8_LDA(At, 0, 1); PG8_STAGEB(PG8_SB(0, 0), b2); PG8_STAGEB(PG8_SB(0, 1), b2 + hstep); PG8_STAGEA(PG8_SA(0, 0), a2, kb2, v2, 0);
            PG8_WAIT_V(8); PG8_WAIT_L(0); PG8_BAR; PG8_MMA(1, 0, At, B0); PG8_MMA(1, 1, At, B1); PG8_BAR; PG8_SCHED;
            PG8_LDB(B0, 1, 0); PG8_LDB(B1, 1, 1); PG8_SCHED; PG8_LDA(At, 1, 0); PG8_STAGEA(PG8_SA(0, 1), a2, kb2, v2, 1);
            PG8_WAIT_V(8); PG8_WAIT_L(0); PG8_BAR; PG8_MMA(0, 0, At, B0); PG8_MMA(0, 1, At, B1); PG8_BAR; PG8_SCHED;
            PG8_LDA(At, 1, 1); PG8_STAGEB(PG8_SB(1, 0), b3); PG8_STAGEB(PG8_SB(1, 1), b3 + hstep); PG8_STAGEA(PG8_SA(1, 0), a3, kb3, v2, 0);
            PG8_WAIT_V(8); PG8_WAIT_L(0); PG8_BAR; PG8_MMA(1, 0, At, B0); PG8_MMA(1, 1, At, B1); PG8_BAR; PG8_SCHED;
            } else {
            PG8_LDB(B0, 0, 0); PG8_SCHED; PG8_LDA(At, 0, 0); PG8_STAGEA(PG8_SA(1, 1), a1, kb1, vc, 1);
            PG8_WAIT_L(8); PG8_BAR; PG8_WAIT_L(0); PG8_MMA(0, 0, At, B0); PG8_BAR; PG8_SCHED;
            PG8_LDB(B1, 0, 1); PG8_STAGEB(PG8_SB(0, 0), b2);
            PG8_BAR; PG8_WAIT_L(0); PG8_MMA(0, 1, At, B1); PG8_BAR;
            PG8_LDA(At, 0, 1); PG8_STAGEA(PG8_SA(0, 0), a2, kb2, v2, 0);
            PG8_BAR; PG8_WAIT_L(0); PG8_MMA(1, 0, At, B0); PG8_BAR; PG8_SCHED;
            PG8_STAGEB(PG8_SB(0, 1), b2 + hstep);
            PG8_WAIT_V(6); PG8_BAR; PG8_MMA(1, 1, At, B1); PG8_BAR;
            PG8_LDB(B0, 1, 0); PG8_SCHED; PG8_LDA(At, 1, 0); PG8_STAGEA(PG8_SA(0, 1), a2, kb2, v2, 1);
            PG8_WAIT_L(8); PG8_BAR; PG8_WAIT_L(0); PG8_MMA(0, 0, At, B0); PG8_BAR; PG8_SCHED;
            PG8_LDB(B1, 1, 1); PG8_STAGEB(PG8_SB(1, 0), b3);
            PG8_BAR; PG8_WAIT_L(0); PG8_MMA(0, 1, At, B1); PG8_BAR;
            PG8_LDA(At, 1, 1); PG8_STAGEA(PG8_SA(1, 0), a3, kb3, v2, 0);
            PG8_BAR; PG8_WAIT_L(0); PG8_MMA(1, 0, At, B0); PG8_BAR; PG8_SCHED;
            PG8_STAGEB(PG8_SB(1, 1), b3 + hstep);
            PG8_WAIT_V(6); PG8_BAR; PG8_MMA(1, 1, At, B1); PG8_BAR;
            }
        }
        if constexpr (ALIGN_EPI) { if (wr == 0) PG8_BAR; }
        if constexpr (F8) { asm volatile("s_nop 15\n\ts_nop 7" ::: "memory");
#pragma unroll
            for (int a = 0; a < 2; ++a)
#pragma unroll
                for (int b = 0; b < 2; ++b)
#pragma unroll
                    for (int m = 0; m < 4; ++m)
#pragma unroll
                        for (int n = 0; n < 2; ++n) asm volatile("" : "+v"(acc[a][b][m][n])); }
        { const int tz = opaque_tid(), wz = __builtin_amdgcn_readfirstlane(tz >> 6), lz = tz & 63; E(acc, cur, wz >> 2, wz & 3, lz & 15, lz >> 4);
          if constexpr (Sched::SIGF) { asm volatile("s_waitcnt vmcnt(0)" ::: "memory");
              if (lz == 0) { const unsigned old = __hip_atomic_fetch_add((LAS unsigned*)(lds + LDS_UCNT_OFF), 1u, __ATOMIC_ACQ_REL, __HIP_MEMORY_SCOPE_WORKGROUP);
                  if ((old & 7u) == 7u) {   __hip_atomic_fetch_add(S.flg + cur.pm, 1u, __ATOMIC_RELAXED, __HIP_MEMORY_SCOPE_AGENT); } } } }
        hook(ui);
        if (!has_next) break;
#pragma unroll
        for (int a = 0; a < 2; ++a)
#pragma unroll
            for (int b = 0; b < 2; ++b)
#pragma unroll
                for (int m = 0; m < 4; ++m)
#pragma unroll
                    for (int n = 0; n < 2; ++n) acc[a][b][m][n] = (f32x4){0.f, 0.f, 0.f, 0.f};
        cur = nxt; cA = nA; cB = nB; ++ui;
        if constexpr (GATHER) {
#pragma unroll
            for (int h = 0; h < 2; ++h)
#pragma unroll
                for (int i = 0; i < 2; ++i) vc[h][i] = vn[h][i];
        }
        if constexpr (ALIGN_EPI) { if (wr == 1) PG8_BAR; }
    }
    PG8_WAIT_V(0);
    if constexpr (!ALIGN_EPI) { if (wr == 0) PG8_BAR; }
    PG8_BAR;
#undef PG8_SA
#undef PG8_SB
#undef PG8_ST2
#undef PG8_ST2X
#undef PG8_STAGEA
#undef PG8_STAGEB
#undef PG8_LDA
#undef PG8_LDB
#undef PG8_MMA
#undef PG8_CAT
#undef PG8_WAIT_V
#undef PG8_WAIT_L
#undef PG8_BAR
#undef PG8_SCHED
}
}

namespace att {
constexpr int AD = 128, NW = 8, QBLK = 32, KVBLK = 64;
constexpr float SCALE = 0.088388347648318440f;
constexpr float THR = 8.f;
constexpr int SDEPTH = 2;
constexpr int SHM_V = KVBLK * AD * 2, SHM_K = KVBLK * AD * 2, SHM_ATTN = 2 * SHM_V + 2 * SHM_K + NW * 64 * 4;
using bf16x8 = __attribute__((ext_vector_type(8))) short;
using s16x4  = __attribute__((ext_vector_type(4))) short;
using f32x16 = __attribute__((ext_vector_type(16))) float;
#define KSWZ(row, colB) ((row) * 256 + ((colB) ^ (((row) & 7) << 4)))
#define SBAR() __builtin_amdgcn_sched_barrier(0)
__device__ __forceinline__ int crow(int r, int hi) { return (r & 3) + 8 * (r >> 2) + 4 * hi; }
__device__ __forceinline__ unsigned cvtpk(float lo, float hi) { unsigned r; asm volatile("v_cvt_pk_bf16_f32 %0, %1, %2" : "=v"(r) : "v"(lo), "v"(hi)); return r; }
__device__ __forceinline__ void partialSM(f32x16& p0, f32x16& p1, float& m_reg, float& mn, float& alpha) {
  constexpr float C = SCALE * 1.4426950408889634f;
  float pmax = p0[0]; for (int r = 1; r < 16; ++r) pmax = fmaxf(pmax, p0[r]); for (int r = 0; r < 16; ++r) pmax = fmaxf(pmax, p1[r]);
  { auto rr = __builtin_amdgcn_permlane32_swap(__float_as_uint(pmax), __float_as_uint(pmax), false, false);
    pmax = fmaxf(__uint_as_float(rr[0]), __uint_as_float(rr[1])); }
  if (__builtin_expect(__all(pmax - m_reg <= THR / SCALE), 1)) { mn = m_reg; alpha = 1.f; }
  else { mn = fmaxf(m_reg, pmax); alpha = __builtin_amdgcn_exp2f((m_reg - mn) * C); m_reg = mn; }
  float mnC = -mn * C;
  for (int r = 0; r < 16; ++r) p0[r] = fmaf(p0[r], C, mnC); for (int r = 0; r < 16; ++r) p1[r] = fmaf(p1[r], C, mnC);
  for (int r = 0; r < 16; ++r) p0[r] = __builtin_amdgcn_exp2f(p0[r]);
}
__device__ __forceinline__ void finishSM(f32x16& p0, f32x16& p1, float alpha, float& l_reg, bf16x8& pa0, bf16x8& pa1, bf16x8& pa2, bf16x8& pa3) {
  for (int r = 0; r < 16; ++r) p1[r] = __builtin_amdgcn_exp2f(p1[r]);
  float ps = 0; for (int r = 0; r < 16; ++r) ps += p0[r]; for (int r = 0; r < 16; ++r) ps += p1[r];
  { auto rr = __builtin_amdgcn_permlane32_swap(__float_as_uint(ps), __float_as_uint(ps), false, false);
    ps = __uint_as_float(rr[0]) + __uint_as_float(rr[1]); }
  l_reg = l_reg * alpha + ps;
#define PK4(P, BASE, OUT) do { unsigned a0 = cvtpk(P[BASE + 0], P[BASE + 1]), a1 = cvtpk(P[BASE + 2], P[BASE + 3]);   \
    unsigned b0 = cvtpk(P[BASE + 4], P[BASE + 5]), b1 = cvtpk(P[BASE + 6], P[BASE + 7]);                              \
    auto r0 = __builtin_amdgcn_permlane32_swap(a0, b0, false, false); auto r1 = __builtin_amdgcn_permlane32_swap(a1, b1, false, false); \
    u32x4 w = {r0[0], r1[0], r0[1], r1[1]}; OUT = __builtin_bit_cast(bf16x8, w); } while (0)
  PK4(p0, 0, pa0); PK4(p0, 8, pa1); PK4(p1, 0, pa2); PK4(p1, 8, pa3);
#undef PK4
}
__device__ __forceinline__ void qkt(f32x16& p0, f32x16& p1, const LAS char* Ks, const bf16x8* qr, int r32, int hi) {
  p0 = f32x16{}; p1 = f32x16{};
#pragma unroll
  for (int d0 = 0; d0 < 8; ++d0) { int cb = (d0 * 16 + hi * 8) * 2;
    bf16x8 b0 = *(const LAS bf16x8*)(Ks + KSWZ(r32, cb));
    bf16x8 b1 = *(const LAS bf16x8*)(Ks + KSWZ(32 + r32, cb));
    p0 = __builtin_amdgcn_mfma_f32_32x32x16_bf16(b0, qr[d0], p0, 0, 0, 0);
    p1 = __builtin_amdgcn_mfma_f32_32x32x16_bf16(b1, qr[d0], p1, 0, 0, 0); }
}
__device__ __forceinline__ int v_st(int k, int c) { const int kk = (k & ~0xC) | ((k & 4) << 1) | ((k & 8) >> 1); return ((kk >> 3) * 4 + (c >> 5)) * 512 + ((kk & 7) * 32 + (c & 31)) * 2; }
__device__ __forceinline__ int v_rd_base(int lane) { return ((lane & 3) << 3) | (((lane >> 2) & 3) << 6) | (((lane >> 4) & 1) << 5) | (((lane >> 5) & 1) << 8); }
constexpr int v_rd_off(int d0, int ks, int half) { return d0 * 512 + ks * 4096 + half * 2048; }
template <int OFF> __device__ __forceinline__ s16x4 tr_read(int vb) {
  s16x4 r; asm volatile("ds_read_b64_tr_b16 %0, %1 offset:%2" : "=&v"(r) : "v"(vb), "i"(OFF) : "memory"); return r;
}
template <int D0> __device__ __forceinline__ void pv_one(f32x16& od, int vb, bf16x8 pa0, bf16x8 pa1, bf16x8 pa2, bf16x8 pa3) {
  const s16x4 l0 = tr_read<v_rd_off(D0, 0, 0)>(vb), h0 = tr_read<v_rd_off(D0, 0, 1)>(vb), l1 = tr_read<v_rd_off(D0, 1, 0)>(vb), h1 = tr_read<v_rd_off(D0, 1, 1)>(vb);
  const s16x4 l2 = tr_read<v_rd_off(D0, 2, 0)>(vb), h2 = tr_read<v_rd_off(D0, 2, 1)>(vb), l3 = tr_read<v_rd_off(D0, 3, 0)>(vb), h3 = tr_read<v_rd_off(D0, 3, 1)>(vb);
  asm volatile("s_waitcnt lgkmcnt(0)" ::: "memory"); SBAR();
#define PK(L, H) (bf16x8){L[0], L[1], L[2], L[3], H[0], H[1], H[2], H[3]}
  od = __builtin_amdgcn_mfma_f32_32x32x16_bf16(pa0, PK(l0, h0), od, 0, 0, 0);
  od = __builtin_amdgcn_mfma_f32_32x32x16_bf16(pa1, PK(l1, h1), od, 0, 0, 0);
  od = __builtin_amdgcn_mfma_f32_32x32x16_bf16(pa2, PK(l2, h2), od, 0, 0, 0);
  od = __builtin_amdgcn_mfma_f32_32x32x16_bf16(pa3, PK(l3, h3), od, 0, 0, 0);
#undef PK
}
__device__ __forceinline__ void pv_d0(f32x16* o, int vb, bf16x8 pa0, bf16x8 pa1, bf16x8 pa2, bf16x8 pa3) {
  pv_one<0>(o[0], vb, pa0, pa1, pa2, pa3); pv_one<1>(o[1], vb, pa0, pa1, pa2, pa3); pv_one<2>(o[2], vb, pa0, pa1, pa2, pa3); pv_one<3>(o[3], vb, pa0, pa1, pa2, pa3);
}
template <int LDQ, int LDK, int LDO>
__device__ __forceinline__ void attn_dense_body(const bf16_t* __restrict__ Qb, const bf16_t* __restrict__ Kh, const bf16_t* __restrict__ Vh, float* __restrict__ Ob, int seq, LAS char* lds) {
  const int tid = opaque_tid(), wid = tid >> 6, lane = tid & 63, r32 = lane & 31, hi = lane >> 5;
  LAS char* V_lds = lds; LAS char* K_lds = lds + 2 * SHM_V;
  LAS float* wsl = (LAS float*)(lds + 2 * SHM_V + 2 * SHM_K) + wid * 64; LAS float* li_l = wsl; LAS float* al_l = wsl + 32;
  float m_reg = -1e30f, l_reg = 0; f32x16 o[4] = {}; bf16x8 qr[8];
  const bf16_t* Qw = Qb + (long)(wid * QBLK + r32) * LDQ + hi * 8;
#pragma unroll
  for (int d0 = 0; d0 < 8; ++d0) qr[d0] = *(const bf16x8*)(Qw + d0 * 16);
  const int sr = tid >> 4, sc = (tid & 15) * 8, vst0 = v_st(sr, sc), vst1 = v_st(32 + sr, sc);
  const int vb0 = (int)(uintptr_t)V_lds + v_rd_base(lane);
  struct { bf16x8 vs0, vs1, ks0, ks1; } sr_[SDEPTH];
#define SLOAD(i, k0) do { sr_[i].vs0 = *(const bf16x8*)(&Vh[(long)((k0) + sr) * LDK + sc]); sr_[i].vs1 = *(const bf16x8*)(&Vh[(long)((k0) + 32 + sr) * LDK + sc]); \
    sr_[i].ks0 = *(const bf16x8*)(&Kh[(long)((k0) + sr) * LDK + sc]); sr_[i].ks1 = *(const bf16x8*)(&Kh[(long)((k0) + 32 + sr) * LDK + sc]); } while (0)
#define SWRITE(b, i) do { *(LAS bf16x8*)(V_lds + (b) * SHM_V + vst0) = sr_[i].vs0;          \
    *(LAS bf16x8*)(V_lds + (b) * SHM_V + vst1) = sr_[i].vs1; int kc = sc * 2;               \
    *(LAS bf16x8*)(K_lds + (b) * SHM_K + KSWZ(sr, kc)) = sr_[i].ks0;                       \
    *(LAS bf16x8*)(K_lds + (b) * SHM_K + KSWZ(32 + sr, kc)) = sr_[i].ks1; } while (0)
#define SWAIT() do { asm volatile("s_waitcnt vmcnt(4)" ::: "memory"); } while (0)
#define RESC(a) do { if (__any((a) < 1.f)) { if (hi == 0) al_l[r32] = (a); asm volatile("s_waitcnt lgkmcnt(0)" ::: "memory"); \
    for (int d = 0; d < 4; ++d) for (int r = 0; r < 16; ++r) o[d][r] *= al_l[crow(r, hi)]; } } while (0)
  f32x16 pA0, pA1, pB0, pB1; float mnA, mnB, alA, alB; bf16x8 pa0, pa1, pa2, pa3; const int NT = seq / KVBLK;
  constexpr int SE = 0, SO = SDEPTH - 1;
  SLOAD(SE, 0); asm volatile("s_waitcnt vmcnt(0)" ::: "memory"); SWRITE(0, SE); __syncthreads();
  qkt(pA0, pA1, K_lds, qr, r32, hi); partialSM(pA0, pA1, m_reg, mnA, alA);
  SLOAD(SO, KVBLK); if (2 < NT) SLOAD(SE, 2 * KVBLK);
  SWAIT(); SWRITE(1, SO); __syncthreads();
  for (int j = 1; j + 1 < NT; j += 2) {
    SBAR(); qkt(pB0, pB1, K_lds + SHM_K, qr, r32, hi);
    finishSM(pA0, pA1, alA, l_reg, pa0, pa1, pa2, pa3); SBAR();
    SLOAD(SO, (j + SDEPTH) * KVBLK); SBAR();
    pv_d0(o, vb0, pa0, pa1, pa2, pa3); partialSM(pB0, pB1, m_reg, mnB, alB);
    __syncthreads(); SWAIT(); SWRITE(0, SE);
    RESC(alB); __syncthreads();
    SBAR(); qkt(pA0, pA1, K_lds, qr, r32, hi);
    finishSM(pB0, pB1, alB, l_reg, pa0, pa1, pa2, pa3); SBAR();
    if (j + 3 < NT) SLOAD(SE, (j + 1 + SDEPTH) * KVBLK); SBAR();
    pv_d0(o, vb0 + (int)SHM_V, pa0, pa1, pa2, pa3); partialSM(pA0, pA1, m_reg, mnA, alA);
    __syncthreads(); SWAIT(); SWRITE(1, SO);
    RESC(alA); __syncthreads();
  }
  SBAR(); qkt(pB0, pB1, K_lds + SHM_K, qr, r32, hi);
  finishSM(pA0, pA1, alA, l_reg, pa0, pa1, pa2, pa3); SBAR();
  pv_d0(o, vb0, pa0, pa1, pa2, pa3); partialSM(pB0, pB1, m_reg, mnB, alB);
  __syncthreads(); RESC(alB);
  finishSM(pB0, pB1, alB, l_reg, pa0, pa1, pa2, pa3); SBAR();
  pv_d0(o, vb0 + (int)SHM_V, pa0, pa1, pa2, pa3);
  if (hi == 0) li_l[r32] = l_reg; asm volatile("s_waitcnt lgkmcnt(0)" ::: "memory");
  float rli[16];
#pragma unroll
  for (int r = 0; r < 16; ++r) rli[r] = __builtin_amdgcn_rcpf(li_l[crow(r, hi)]);
  float* Ow = Ob + (long)(wid * QBLK) * LDO;
#pragma unroll
  for (int r = 0; r < 16; ++r) { int orow = crow(r, hi);
#pragma unroll
    for (int d0 = 0; d0 < 4; ++d0) Ow[(long)orow * LDO + d0 * 32 + r32] = o[d0][r] * rli[r]; }
  asm volatile("s_waitcnt vmcnt(0) lgkmcnt(0)" ::: "memory"); __syncthreads();
#undef SLOAD
#undef SWRITE
#undef SWAIT
#undef RESC
}
constexpr int SHM_V2 = KVBLK * 256 * 2, SHM_K2 = KVBLK * AD * 2, SHM_ATTN256 = 2 * SHM_V2 + 2 * SHM_K2 + NW * 64 * 4;
__device__ __forceinline__ int v_st256(int k, int c) { const int kk = (k & ~0xC) | ((k & 4) << 1) | ((k & 8) >> 1); return ((kk >> 3) * 8 + (c >> 5)) * 512 + ((kk & 7) * 32 + (c & 31)) * 2; }
constexpr int v_rd_off256(int d0, int ks, int half) { return d0 * 512 + ks * 8192 + half * 4096; }
template <int D0> __device__ __forceinline__ void pv_one256(f32x16& od, int vb, bf16x8 pa0, bf16x8 pa1, bf16x8 pa2, bf16x8 pa3) {
  const s16x4 l0 = tr_read<v_rd_off256(D0, 0, 0)>(vb), h0 = tr_read<v_rd_off256(D0, 0, 1)>(vb), l1 = tr_read<v_rd_off256(D0, 1, 0)>(vb), h1 = tr_read<v_rd_off256(D0, 1, 1)>(vb);
  const s16x4 l2 = tr_read<v_rd_off256(D0, 2, 0)>(vb), h2 = tr_read<v_rd_off256(D0, 2, 1)>(vb), l3 = tr_read<v_rd_off256(D0, 3, 0)>(vb), h3 = tr_read<v_rd_off256(D0, 3, 1)>(vb);
  asm volatile("s_waitcnt lgkmcnt(0)" ::: "memory"); SBAR();
#define PK(L, H) (bf16x8){L[0], L[1], L[2], L[3], H[0], H[1], H[2], H[3]}
  od = __builtin_amdgcn_mfma_f32_32x32x16_bf16(pa0, PK(l0, h0), od, 0, 0, 0);
  od = __builtin_amdgcn_mfma_f32_32x32x16_bf16(pa1, PK(l1, h1), od, 0, 0, 0);
  od = __builtin_amdgcn_mfma_f32_32x32x16_bf16(pa2, PK(l2, h2), od, 0, 0, 0);
  od = __builtin_amdgcn_mfma_f32_32x32x16_bf16(pa3, PK(l3, h3), od, 0, 0, 0);
#undef PK
}
template <int LDQ, int LDK, int LDO>
__device__ __forceinline__ void attn_body256(const bf16_t* __restrict__ Qb, const bf16_t* __restrict__ Kh, const bf16_t* __restrict__ Vh, float* __restrict__ Ob, int seq, LAS char* lds) {
  const int tid = opaque_tid(), wid = tid >> 6, lane = tid & 63, r32 = lane & 31, hi = lane >> 5;
  LAS char* V_lds = lds; LAS char* K_lds = lds + 2 * SHM_V2;
  LAS float* wsl = (LAS float*)(lds + 2 * SHM_V2 + 2 * SHM_K2) + wid * 64; LAS float* li_l = wsl; LAS float* al_l = wsl + 32;
  float m_reg = -1e30f, l_reg = 0; f32x16 o[8] = {}; bf16x8 qr[8];
  const bf16_t* Qw = Qb + (long)(wid * QBLK + r32) * LDQ + hi * 8;
#pragma unroll
  for (int d0 = 0; d0 < 8; ++d0) qr[d0] = *(const bf16x8*)(Qw + d0 * 16);
  const int sr = tid >> 4, sc = (tid & 15) * 8;
  const int vst00 = v_st256(sr, sc), kst0 = KSWZ(sr, sc * 2);
  const unsigned toff = (unsigned)(sr * LDK + sc);
  const int vb0 = (int)(uintptr_t)V_lds + v_rd_base(lane);
  bf16x8 sa0, sa1, sa2, sa3;
#define SLOAD_A(k0) do { const bf16_t* vp_ = Vh + (long)(k0) * LDK + toff; const bf16_t* kp_ = Kh + (long)(k0) * LDK + toff; \
    sa0 = *(const bf16x8*)kp_; sa1 = *(const bf16x8*)(kp_ + 32L * LDK); sa2 = *(const bf16x8*)vp_; sa3 = *(const bf16x8*)(vp_ + 128); } while (0)
#define SWRITE_A(b) do { LAS char* vb_ = V_lds + (b) * SHM_V2 + vst00; LAS char* kb_ = K_lds + (b) * SHM_K2 + kst0; \
    *(LAS bf16x8*)(kb_) = sa0; *(LAS bf16x8*)(kb_ + 8192) = sa1; *(LAS bf16x8*)(vb_) = sa2; *(LAS bf16x8*)(vb_ + 2048) = sa3; } while (0)
#define SLOAD_B(k0) do { const bf16_t* vp_ = Vh + (long)((k0) + 32) * LDK + toff; sa0 = *(const bf16x8*)vp_; sa1 = *(const bf16x8*)(vp_ + 128); } while (0)
#define SWRITE_B(b) do { LAS char* vb_ = V_lds + (b) * SHM_V2 + vst00; *(LAS bf16x8*)(vb_ + 16384) = sa0; *(LAS bf16x8*)(vb_ + 18432) = sa1; } while (0)
  f32x16 p0, p1; float mn, al; bf16x8 pa0, pa1, pa2, pa3; const int NT = seq / KVBLK;
  SLOAD_A(0); asm volatile("s_waitcnt vmcnt(0)" ::: "memory"); SWRITE_A(0); SLOAD_B(0); asm volatile("s_waitcnt vmcnt(0)" ::: "memory"); SWRITE_B(0); __syncthreads();
#pragma unroll 1
  for (int j = 0; j < NT; ++j) {
    if (j + 1 < NT) SLOAD_A((j + 1) * KVBLK);
    SBAR(); qkt(p0, p1, K_lds + (j & 1) * SHM_K2, qr, r32, hi);
    partialSM(p0, p1, m_reg, mn, al);
    finishSM(p0, p1, al, l_reg, pa0, pa1, pa2, pa3); SBAR();
    if (j + 1 < NT) { asm volatile("s_waitcnt vmcnt(0)" ::: "memory"); SWRITE_A((j + 1) & 1); SLOAD_B((j + 1) * KVBLK); }
    SBAR();
    if (__any(al < 1.f)) { if (hi == 0) al_l[r32] = al; asm volatile("s_waitcnt lgkmcnt(0)" ::: "memory");
#pragma unroll
      for (int d = 0; d < 8; ++d)
#pragma unroll
        for (int r = 0; r < 16; ++r) o[d][r] *= al_l[crow(r, hi)]; }
    { const int vb = vb0 + (j & 1) * SHM_V2;
      pv_one256<0>(o[0], vb, pa0, pa1, pa2, pa3); pv_one256<1>(o[1], vb, pa0, pa1, pa2, pa3); pv_one256<2>(o[2], vb, pa0, pa1, pa2, pa3); pv_one256<3>(o[3], vb, pa0, pa1, pa2, pa3);
      pv_one256<4>(o[4], vb, pa0, pa1, pa2, pa3); pv_one256<5>(o[5], vb, pa0, pa1, pa2, pa3); pv_one256<6>(o[6], vb, pa0, pa1, pa2, pa3); pv_one256<7>(o[7], vb, pa0, pa1, pa2, pa3); }
    if (j + 1 < NT) { asm volatile("s_waitcnt vmcnt(0)" ::: "memory"); SWRITE_B((j + 1) & 1); }
    __syncthreads();
  }
  if (hi == 0) li_l[r32] = l_reg; asm volatile("s_waitcnt lgkmcnt(0)" ::: "memory");
  float* Ow = Ob + (long)(wid * QBLK) * LDO;
#pragma unroll
  for (int r = 0; r < 16; ++r) { const int orow = crow(r, hi); const float rli = __builtin_amdgcn_rcpf(li_l[orow]);
#pragma unroll
    for (int d0 = 0; d0 < 8; ++d0) Ow[(long)orow * LDO + d0 * 32 + r32] = o[d0][r] * rli; }
  asm volatile("s_waitcnt vmcnt(0) lgkmcnt(0)" ::: "memory"); __syncthreads();
#undef SLOAD_A
#undef SWRITE_A
#undef SLOAD_B
#undef SWRITE_B
}
#undef KSWZ
#undef SBAR
}

__device__ __forceinline__ void diffattn_units(const Params& p, LAS unsigned char* lds, float* O0, float* O1) {
    const bf16_t* proj = (const bf16_t*)(p.wp[IX_PROJ]);
    bf16_t* ao = (bf16_t*)(p.wp[IX_ACT]);
    const float* dl = p.in[17]; const float* dn = p.in[18];
    const int G = gridDim.x, bx = blockIdx.x; const int vcu = (G % 8 == 0) ? (bx % 8) * (G / 8) + bx / 8 : bx;
    int slot_k = 0; const int slot_me = (bx >> 3) & 3;
    for (int u = vcu; u < NB * 8 * 8; u += G) {
        const int qb = u & 7, h = (u >> 3) & 7, b = u >> 6;
        const size_t row0 = (size_t)b * T;
#pragma unroll 1
        for (int i = 0; i < 2; ++i) {
            if (slot_k == slot_me) convert_late(p, lds);
            ++slot_k;
            const bf16_t* Q = proj + (row0 + qb * 256) * LD1 + h * 256 + i * 128;
            const bf16_t* K = proj + row0 * LD1 + 2048 + h * 256 + i * 128;
            const bf16_t* V = proj + row0 * LD1 + 4096 + h * 256;
            float* O = (i ? O1 : O0) + (row0 + qb * 256) * D + h * 256;
            att::attn_body256<LD1, LD1, D>(Q, K, V, O, T, (LAS char*)lds);
        }
    }
    if (slot_k <= slot_me) convert_late(p, lds);
    const int tid_ = opaque_tid(), wave = tid_ >> 6, lane = tid_ & 63;
    float la = dl[lane] * dl[128 + lane] + dl[64 + lane] * dl[192 + lane], lb2 = dl[256 + lane] * dl[384 + lane] + dl[320 + lane] * dl[448 + lane];
    la = wave_sum(la); lb2 = wave_sum(lb2);
    const float lam = expf(la) - expf(lb2) + LAM_INIT;
    const f32x4 gv = *(const f32x4*)(dn + 4 * lane);
    for (int u = vcu; u < NB * 8 * 8; u += G) {
        const int qb = u & 7, h = (u >> 3) & 7, b = u >> 6;
        const size_t row0 = (size_t)b * T;
#pragma unroll 1
        for (int rr = 0; rr < 32; rr += 4) {
            f32x4 a[4], bb[4];
#pragma unroll
            for (int k = 0; k < 4; ++k) { const size_t off = (row0 + qb * 256 + wave * 32 + rr + k) * D + h * 256 + 4 * lane; a[k] = *(const f32x4*)(O0 + off); bb[k] = *(const f32x4*)(O1 + off); }
#pragma unroll
            for (int k = 0; k < 4; ++k) { const size_t off = (row0 + qb * 256 + wave * 32 + rr + k) * D + h * 256 + 4 * lane;
                const f32x4 o = a[k] - lam * bb[k];
                const float ss = wave_sum(o.x * o.x + o.y * o.y + o.z * o.z + o.w * o.w);
                const float rstd = (1.f - LAM_INIT) / sqrtf(ss * (1.f / 256.f) + EPS);
                if (OUT_F8) *(unsigned*)((unsigned char*)ao + off) = pk4_fp8(o.x * rstd * gv.x * F8_SM, o.y * rstd * gv.y * F8_SM, o.z * rstd * gv.z * F8_SM, o.w * rstd * gv.w * F8_SM);
                else { u32x2 ov; ov.x = pk2(o.x * rstd * gv.x, o.y * rstd * gv.y); ov.y = pk2(o.z * rstd * gv.z, o.w * rstd * gv.w); *(u32x2*)(ao + off) = ov; } }
        }
    }
}

namespace hg {
typedef short bf16x8 __attribute__((ext_vector_type(8)));
typedef short bf16x4 __attribute__((ext_vector_type(4)));
constexpr int SET_BYTES = 8192 * 3 + 512;
__device__ __forceinline__ int rm_byte(int c, int d) { return c * 256 + ((2 * d) ^ ((c & 7) << 4)); }
__device__ __forceinline__ bf16x8 pack8(const f32x4& a, const f32x4& b) { u32x4 w; w.x = pk2(a.x, a.y); w.y = pk2(a.z, a.w); w.z = pk2(b.x, b.y); w.w = pk2(b.z, b.w); return __builtin_bit_cast(bf16x8, w); }
}
__device__ __forceinline__ void hgrn_mfma(const Params& p, LAS unsigned char* lds) {
    using namespace hg;
    const bf16_t* proj = (const bf16_t*)(p.wp[IX_PROJ]);
    bf16_t* oscr = (bf16_t*)(p.wp[IX_XB]);
    const float* lbl = p.in[24];
    const int tid = opaque_tid(), w = __builtin_amdgcn_readfirstlane(tid >> 6), lane = tid & 63, fr = lane & 15, fq = lane >> 4;
    for (int u = blockIdx.x; u < 128; u += gridDim.x) {
        const int b = u >> 4, h = (u >> 1) & 7, dir = u & 1;
        const int d = 16 * w + fr;
        float lb; { const float l0 = lbl[h * 128 + d], l1 = lbl[1024 + h * 128 + d], l2 = lbl[2048 + h * 128 + d];
            const float mx = fmaxf(l0, fmaxf(l1, l2)); const float e0 = expf(l0 - mx), e1 = expf(l1 - mx), e2 = expf(l2 - mx); lb = e0 / (e0 + e1 + e2); }
        f32x4 S[8];
#pragma unroll
        for (int mi = 0; mi < 8; ++mi) S[mi] = (f32x4){0.f, 0.f, 0.f, 0.f};
        const bf16_t* pb = proj + (size_t)b * T * LD0 + h * 128 + d;
        const int zoff = dir ? 3072 : 2048;
        bf16_t rq[8], rz[8], rv[8], rp[8];
#define HG_LOAD(nn) do { _Pragma("unroll") for (int i = 0; i < 8; ++i) { \
                const int c_ = 8 * fq + i, tt_ = dir ? (T - 1 - (32 * (nn) + c_)) : (32 * (nn) + c_); const bf16_t* pr_ = pb + (size_t)tt_ * LD0; \
                rq[i] = pr_[0]; rv[i] = pr_[1024]; rz[i] = pr_[zoff]; \
                const int cp_ = (i < 4) ? (4 * fq + i) : (16 + 4 * fq + (i - 4)), tp_ = dir ? (T - 1 - (32 * (nn) + cp_)) : (32 * (nn) + cp_); \
                rp[i] = pb[(size_t)tp_ * LD0 + 1024]; } } while (0)
        HG_LOAD(0);
        for (int n = 0; n < T / 32; ++n) {
            LAS unsigned char* set = lds + (n & 1) * SET_BYTES;
            LAS unsigned char* QG = set; LAS unsigned char* KG = set + 8192; LAS unsigned char* KDT = set + 16384; LAS float* DEC = (LAS float*)(set + 24576);
            float qv[8], fv[8], vv[8], vp[8];
#pragma unroll
            for (int i = 0; i < 8; ++i) { qv[i] = bf2f(rq[i]); vv[i] = bf2f(rv[i]); fv[i] = bf2f(rz[i]); vp[i] = bf2f(rp[i]); }
            if (n + 1 < T / 32) HG_LOAD(n + 1);
            float Pl[8]; float P = 1.f;
#pragma unroll
            for (int i = 0; i < 8; ++i) { fv[i] = lb + (1.f - lb) * sigm(fv[i]); P *= fv[i]; Pl[i] = P; }
            const float p0 = __shfl(P, fr), p1 = __shfl(P, fr + 16), p2 = __shfl(P, fr + 32), p3 = __shfl(P, fr + 48);
            const float pre = (fq > 0 ? p0 : 1.f) * (fq > 1 ? p1 : 1.f) * (fq > 2 ? p2 : 1.f), tot = (p0 * p1) * (p2 * p3);
            float kd[8];
#pragma unroll
            for (int i = 0; i < 8; ++i) {
                const int c = 8 * fq + i; const float E = pre * Pl[i], rE = frcp(E), k = 1.f - fv[i];
                *(LAS bf16_t*)(QG + rm_byte(c, d)) = f2bf(silu(qv[i]) * E);
                *(LAS bf16_t*)(KG + rm_byte(c, d)) = f2bf(k * rE);
                kd[i] = k * tot * rE;
            }
            { u32x4 wv; wv.x = pk2(kd[0], kd[1]); wv.y = pk2(kd[2], kd[3]); wv.z = pk2(kd[4], kd[5]); wv.w = pk2(kd[6], kd[7]);
              *(LAS u32x4*)(KDT + d * 64 + ((fq ^ ((d >> 2) & 3)) << 4)) = wv; }
            if (fq == 0) DEC[d] = tot;
            const bf16x8 vB = pack8((f32x4){vv[0], vv[1], vv[2], vv[3]}, (f32x4){vv[4], vv[5], vv[6], vv[7]});
            const bf16x8 vP = pack8((f32x4){vp[0], vp[1], vp[2], vp[3]}, (f32x4){vp[4], vp[5], vp[6], vp[7]});
            __syncthreads();
            f32x4 at00 = {0.f, 0.f, 0.f, 0.f}, at01 = at00, at11 = at00;
#pragma unroll
            for (int ks = 0; ks < 4; ++ks) {
                const int d0 = 32 * ks + 8 * fq;
                const bf16x8 kg0 = *(const LAS bf16x8*)(KG + rm_byte(fr, d0)), kg1 = *(const LAS bf16x8*)(KG + rm_byte(16 + fr, d0));
                const bf16x8 qg0 = *(const LAS bf16x8*)(QG + rm_byte(fr, d0)), qg1 = *(const LAS bf16x8*)(QG + rm_byte(16 + fr, d0));
                at00 = __builtin_amdgcn_mfma_f32_16x16x32_bf16(kg0, qg0, at00, 0, 0, 0);
                at01 = __builtin_amdgcn_mfma_f32_16x16x32_bf16(kg0, qg1, at01, 0, 0, 0);
                at11 = __builtin_amdgcn_mfma_f32_16x16x32_bf16(kg1, qg1, at11, 0, 0, 0);
            }
#pragma unroll
            for (int j = 0; j < 4; ++j) { const bool ok = (4 * fq + j) <= fr; at00[j] = ok ? at00[j] : 0.f; at11[j] = ok ? at11[j] : 0.f; }
            const bf16x8 bi0 = pack8(at00, (f32x4){0.f, 0.f, 0.f, 0.f}), bi1 = pack8(at01, at11);
            f32x4 o0 = {0.f, 0.f, 0.f, 0.f}, o1 = o0;
            o0 = __builtin_amdgcn_mfma_f32_16x16x32_bf16(vP, bi0, o0, 0, 0, 0);
            o1 = __builtin_amdgcn_mfma_f32_16x16x32_bf16(vP, bi1, o1, 0, 0, 0);
#pragma unroll
            for (int ks = 0; ks < 4; ++ks) {
                const bf16x8 sb = pack8(S[2 * ks], S[2 * ks + 1]);
                const int da = 32 * ks + 4 * fq, db = da + 16;
                const bf16x4 q0a = *(const LAS bf16x4*)(QG + rm_byte(fr, da)), q0b = *(const LAS bf16x4*)(QG + rm_byte(fr, db));
                const bf16x4 q1a = *(const LAS bf16x4*)(QG + rm_byte(16 + fr, da)), q1b = *(const LAS bf16x4*)(QG + rm_byte(16 + fr, db));
                const bf16x8 qp0 = {q0a[0], q0a[1], q0a[2], q0a[3], q0b[0], q0b[1], q0b[2], q0b[3]}, qp1 = {q1a[0], q1a[1], q1a[2], q1a[3], q1b[0], q1b[1], q1b[2], q1b[3]};
                o0 = __builtin_amdgcn_mfma_f32_16x16x32_bf16(sb, qp0, o0, 0, 0, 0);
                o1 = __builtin_amdgcn_mfma_f32_16x16x32_bf16(sb, qp1, o1, 0, 0, 0);
            }
            { const int c0 = fr, c1 = 16 + fr; const int t0 = dir ? (T - 1 - (32 * n + c0)) : (32 * n + c0), t1 = dir ? (T - 1 - (32 * n + c1)) : (32 * n + c1);
              bf16_t* ob = oscr + ((size_t)dir * M + (size_t)b * T) * 1024 + h * 128 + 16 * w + 4 * fq;
              u32x2 w0; w0.x = pk2(o0[0], o0[1]); w0.y = pk2(o0[2], o0[3]); u32x2 w1; w1.x = pk2(o1[0], o1[1]); w1.y = pk2(o1[2], o1[3]);
              *(u32x2*)(ob + (size_t)t0 * 1024) = w0; *(u32x2*)(ob + (size_t)t1 * 1024) = w1; }
#pragma unroll
            for (int mi = 0; mi < 8; ++mi) {
                const int dr = 16 * mi + fr;
                const bf16x8 ka = *(const LAS bf16x8*)(KDT + dr * 64 + ((fq ^ ((dr >> 2) & 3)) << 4));
                const f32x4 dc = *(const LAS f32x4*)(DEC + 16 * mi + 4 * fq);
                S[mi] = __builtin_amdgcn_mfma_f32_16x16x32_bf16(ka, vB, S[mi] * dc, 0, 0, 0);
            }
        }
        __syncthreads();
    }
#undef HG_LOAD
}

__device__ __forceinline__ void na_task(const bf16_t* proj, const bf16_t* VT, const float* rpb, bf16_t* mix, LAS float* btab, int b, int r, int h, int qb, int lane) {
    typedef short bf16x8 __attribute__((ext_vector_type(8)));
    const int fr = lane & 15, fq = lane >> 4;
    const int r0 = min(max(r - 4, 0), 24), cb0 = (qb <= 1) ? 0 : 1;
    constexpr float LOG2E = 1.4426950408889634f, C = 0.125f * LOG2E;
    for (int i = lane; i < 8 * 31; i += 64) { const int kr = i / 31, dc = i % 31; btab[kr * 32 + dc] = rpb[(h * 15 + (r0 + kr - r + 7)) * 31 + dc] * LOG2E; }
    const size_t qtok = (size_t)b * T + r * 64 + 16 * qb + fr;
    bf16x8 qf[2];
#pragma unroll
    for (int ks = 0; ks < 2; ++ks) qf[ks] = *(const bf16x8*)(proj + qtok * LD0 + 5120 + h * 64 + 32 * ks + 8 * fq);
    f32x4 sc[24];
#pragma unroll
    for (int g = 0; g < 2; ++g) {
        bf16x8 kf[12][2];
#pragma unroll
        for (int t = 0; t < 12; ++t) { const int tile = 12 * g + t, kr = tile / 3, cbi = tile % 3;
            const size_t ktok = (size_t)b * T + (r0 + kr) * 64 + 16 * (cb0 + cbi) + fr;
            const bf16_t* kp = proj + ktok * LD0 + 6144 + h * 64 + 8 * fq;
            kf[t][0] = *(const bf16x8*)kp; kf[t][1] = *(const bf16x8*)(kp + 32); }
        __builtin_amdgcn_sched_barrier(0);
#pragma unroll
        for (int t = 0; t < 12; ++t) { f32x4 a = {0.f, 0.f, 0.f, 0.f};
            a = __builtin_amdgcn_mfma_f32_16x16x32_bf16(kf[t][0], qf[0], a, 0, 0, 0);
            a = __builtin_amdgcn_mfma_f32_16x16x32_bf16(kf[t][1], qf[1], a, 0, 0, 0);
            sc[12 * g + t] = a; }
        __builtin_amdgcn_sched_barrier(0);
    }
    const bf16_t* vbase = VT + (size_t)(h * 64 + fr) * VTLD + (size_t)b * T + 4 * fq;
    u32x2 vbuf[2][24];
#define NA_VLOAD(buf, nd) do { const bf16_t* vp_ = vbase + (size_t)(16 * (nd)) * VTLD; _Pragma("unroll") for (int t = 0; t < 24; ++t) vbuf[buf][t] = *(const u32x2*)(vp_ + (r0 + t / 3) * 64 + 16 * (cb0 + t % 3)); } while (0)
    NA_VLOAD(0, 0);
    asm volatile("s_waitcnt lgkmcnt(0)" ::: "memory");
    const int c = 16 * qb + fr, cs = min(max(c - 8, 0), 48);
    float mx = -1e30f;
#pragma unroll
    for (int kr = 0; kr < 8; ++kr)
#pragma unroll
        for (int cbi = 0; cbi < 3; ++cbi)
#pragma unroll
            for (int j = 0; j < 4; ++j) {
                const int sidx = 16 * (cb0 + cbi) + 4 * fq + j; const bool ok = (sidx >= cs) && (sidx < cs + 16);
                const int dc = min(max(sidx - c + 15, 0), 30);
                const float v = fmaf(sc[kr * 3 + cbi][j], C, btab[kr * 32 + dc]) + (ok ? 0.f : -1e30f);
                sc[kr * 3 + cbi][j] = v; mx = fmaxf(mx, v);
            }
    mx = fmaxf(mx, __shfl_xor(mx, 16)); mx = fmaxf(mx, __shfl_xor(mx, 32));
    float sum = 0.f;
#pragma unroll
    for (int t = 0; t < 24; ++t)
#pragma unroll
        for (int j = 0; j < 4; ++j) { const float e = __builtin_amdgcn_exp2f(sc[t][j] - mx); sc[t][j] = e; sum += e; }
    sum += __shfl_xor(sum, 16); sum += __shfl_xor(sum, 32);
    const float rs = 1.f / sum;
    f32x4 o[4];
#pragma unroll
    for (int nd = 0; nd < 4; ++nd) o[nd] = (f32x4){0.f, 0.f, 0.f, 0.f};
    bf16x8 pB[12];
#pragma unroll
    for (int kk = 0; kk < 12; ++kk) { const int t0 = 2 * kk, t1 = 2 * kk + 1;
        u32x4 w; w.x = pk2(sc[t0][0], sc[t0][1]); w.y = pk2(sc[t0][2], sc[t0][3]); w.z = pk2(sc[t1][0], sc[t1][1]); w.w = pk2(sc[t1][2], sc[t1][3]);
        pB[kk] = __builtin_bit_cast(bf16x8, w); }
#pragma unroll
    for (int nd = 0; nd < 4; ++nd) {
        if (nd + 1 < 4) NA_VLOAD((nd + 1) & 1, nd + 1);
#pragma unroll
        for (int kk = 0; kk < 12; ++kk) {
            const u32x2 va = vbuf[nd & 1][2 * kk], vb = vbuf[nd & 1][2 * kk + 1];
            u32x4 vw; vw.x = va.x; vw.y = va.y; vw.z = vb.x; vw.w = vb.y;
            o[nd] = __builtin_amdgcn_mfma_f32_16x16x32_bf16(__builtin_bit_cast(bf16x8, vw), pB[kk], o[nd], 0, 0, 0);
        }
    }
#undef NA_VLOAD
#pragma unroll
    for (int nd = 0; nd < 4; ++nd) { u32x2 ov; ov.x = pk2(o[nd][0] * rs, o[nd][1] * rs); ov.y = pk2(o[nd][2] * rs, o[nd][3] * rs);
        *(u32x2*)(mix + qtok * D + 1024 + h * 64 + 16 * nd + 4 * fq) = ov; }
}
constexpr int NA_UNITS = NB * 32 * 8, NA_FIRST = 1024;
__device__ __forceinline__ void na_mfma(const Params& p, LAS unsigned char* lds, int first, int stride, int lo, int hi) {
    const bf16_t* proj = (const bf16_t*)(p.wp[IX_PROJ]); const bf16_t* VT = (const bf16_t*)(p.wp[IX_VT]);
    bf16_t* mix = (bf16_t*)(p.wp[IX_ACT]);
    const int tid = opaque_tid(), w = __builtin_amdgcn_readfirstlane(tid >> 6), lane = tid & 63;
    LAS float* btab = (LAS float*)(lds + 65536) + w * 256;
    for (int u = lo + first; u < hi; u += stride) {
        const int hp = u & 7, r = (u >> 3) & 31, b = u >> 8;
        na_task(proj, VT, p.in[7], mix, btab, b, r, 2 * hp + (w >> 2), w & 3, lane);
    }
}

namespace na2 { constexpr int KRING = 0, VRING = 73728, MERGE = 147456, BIAS = 157696; }
__device__ __forceinline__ void na_ring(const Params& p, LAS unsigned char* lds, int unit) {
    using namespace na2;
    typedef short bf16x8 __attribute__((ext_vector_type(8)));
    const bf16_t* proj = (const bf16_t*)(p.wp[IX_PROJ]); const bf16_t* VT = (const bf16_t*)(p.wp[IX_VT]);
    bf16_t* mix = (bf16_t*)(p.wp[IX_ACT]); const float* rpb = p.in[7];
    const int tid = opaque_tid(), w = __builtin_amdgcn_readfirstlane(tid >> 6), lane = tid & 63, fr = lane & 15, fq = lane >> 4;
    const int b = unit >> 4, h = unit & 15, qb = w & 3, hf = w >> 2, cb0 = (qb <= 1) ? 0 : 1;
    constexpr float LOG2E = 1.4426950408889634f, C = 0.125f * LOG2E;
    LAS float* btab = (LAS float*)(lds + BIAS);
    for (int i = tid; i < 15 * 31; i += 512) btab[(i / 31) * 32 + (i % 31)] = rpb[h * 465 + i] * LOG2E;
    const int st_row = tid >> 3, st_pc = tid & 7, st_off = st_row * 128 + ((st_pc ^ (st_row & 7)) << 4);
    const bf16_t* kg = proj + ((size_t)b * T + st_row) * LD0 + 6144 + h * 64 + st_pc * 8;
    const bf16_t* vg = VT + (size_t)(h * 64 + st_row) * VTLD + (size_t)b * T + st_pc * 8;
    { u32x4 kk[8], vv[8];
#pragma unroll
      for (int g = 0; g < 8; ++g) { kk[g] = *(const u32x4*)(kg + (size_t)g * 64 * LD0); vv[g] = *(const u32x4*)(vg + g * 64); }
#pragma unroll
      for (int g = 0; g < 8; ++g) { *(LAS u32x4*)(lds + KRING + g * 8192 + st_off) = kk[g]; *(LAS u32x4*)(lds + VRING + g * 8192 + st_off) = vv[g]; } }
    const bf16_t* qg = proj + ((size_t)b * T + 16 * qb + fr) * LD0 + 5120 + h * 64 + 8 * fq;
    bf16x8 qf[2]; qf[0] = *(const bf16x8*)qg; qf[1] = *(const bf16x8*)(qg + 32);
    const int c = 16 * qb + fr, cs = min(max(c - 8, 0), 48);
    LAS unsigned* mb = (LAS unsigned*)(lds + MERGE) + qb * 640 + lane;
    __syncthreads();
    for (int r = 0; r < 32; ++r) {
        const int r0 = min(max(r - 4, 0), 24);
        const bool pf = (r >= 4) && (r < 28);
        u32x4 pk_ = {0u, 0u, 0u, 0u}, pv_ = {0u, 0u, 0u, 0u};
        if (pf) { pk_ = *(const u32x4*)(kg + (size_t)(r + 4) * 64 * LD0); pv_ = *(const u32x4*)(vg + (r + 4) * 64); }
        bf16x8 qn0 = qf[0], qn1 = qf[1];
        if (r + 1 < 32) { qn0 = *(const bf16x8*)(qg + (size_t)(r + 1) * 64 * LD0); qn1 = *(const bf16x8*)(qg + (size_t)(r + 1) * 64 * LD0 + 32); }
        f32x4 sc[12];
        int slot[4];
#pragma unroll
        for (int k4 = 0; k4 < 4; ++k4) { slot[k4] = (r0 + 4 * hf + k4) % 9;
            const LAS unsigned char* ks = lds + KRING + slot[k4] * 8192;
#pragma unroll
            for (int cbi = 0; cbi < 3; ++cbi) { const int tok = 16 * (cb0 + cbi) + fr;
                const bf16x8 a0 = *(const LAS bf16x8*)(ks + tok * 128 + ((fq ^ (tok & 7)) << 4)), a1 = *(const LAS bf16x8*)(ks + tok * 128 + (((4 + fq) ^ (tok & 7)) << 4));
                f32x4 a = {0.f, 0.f, 0.f, 0.f};
                a = __builtin_amdgcn_mfma_f32_16x16x32_bf16(a0, qf[0], a, 0, 0, 0);
                a = __builtin_amdgcn_mfma_f32_16x16x32_bf16(a1, qf[1], a, 0, 0, 0);
                sc[k4 * 3 + cbi] = a; } }
        float mx = -1e30f;
#pragma unroll
        for (int k4 = 0; k4 < 4; ++k4) { const LAS float* bt = btab + (r0 + 4 * hf + k4 - r + 7) * 32;
#pragma unroll
            for (int cbi = 0; cbi < 3; ++cbi)
#pragma unroll
                for (int j = 0; j < 4; ++j) { const int sidx = 16 * (cb0 + cbi) + 4 * fq + j; const bool ok = (sidx >= cs) && (sidx < cs + 16);
                    const int dc = min(max(sidx - c + 15, 0), 30);
                    const float v = fmaf(sc[k4 * 3 + cbi][j], C, bt[dc]) + (ok ? 0.f : -1e30f);
                    sc[k4 * 3 + cbi][j] = v; mx = fmaxf(mx, v); } }
        mx = fmaxf(mx, __shfl_xor(mx, 16)); mx = fmaxf(mx, __shfl_xor(mx, 32));
        float sum = 0.f;
#pragma unroll
        for (int t = 0; t < 12; ++t)
#pragma unroll
            for (int j = 0; j < 4; ++j) { const float e = __builtin_amdgcn_exp2f(sc[t][j] - mx); sc[t][j] = e; sum += e; }
        sum += __shfl_xor(sum, 16); sum += __shfl_xor(sum, 32);
        bf16x8 pB[6];
#pragma unroll
        for (int kk = 0; kk < 6; ++kk) { const int t0 = 2 * kk, t1 = 2 * kk + 1;
            u32x4 wv; wv.x = pk2(sc[t0][0], sc[t0][1]); wv.y = pk2(sc[t0][2], sc[t0][3]); wv.z = pk2(sc[t1][0], sc[t1][1]); wv.w = pk2(sc[t1][2], sc[t1][3]);
            pB[kk] = __builtin_bit_cast(bf16x8, wv); }
        f32x4 o[4];
#pragma unroll
        for (int nd = 0; nd < 4; ++nd) { o[nd] = (f32x4){0.f, 0.f, 0.f, 0.f}; const int d = 16 * nd + fr;
#pragma unroll
            for (int kk = 0; kk < 6; ++kk) { const int t0 = 2 * kk, t1 = 2 * kk + 1;
                const int tc0 = 16 * (cb0 + t0 % 3) + 4 * fq, tc1 = 16 * (cb0 + t1 % 3) + 4 * fq;
                const u32x2 va = *(const LAS u32x2*)(lds + VRING + slot[t0 / 3] * 8192 + d * 128 + (((tc0 >> 3) ^ (d & 7)) << 4) + (tc0 & 7) * 2);
                const u32x2 vb = *(const LAS u32x2*)(lds + VRING + slot[t1 / 3] * 8192 + d * 128 + (((tc1 >> 3) ^ (d & 7)) << 4) + (tc1 & 7) * 2);
                u32x4 vw; vw.x = va.x; vw.y = va.y; vw.z = vb.x; vw.w = vb.y;
                o[nd] = __builtin_amdgcn_mfma_f32_16x16x32_bf16(__builtin_bit_cast(bf16x8, vw), pB[kk], o[nd], 0, 0, 0); } }
        const bool merger = (hf == (r & 1));
        if (!merger) { mb[0] = __float_as_uint(mx); mb[64] = __float_as_uint(sum);
#pragma unroll
            for (int nd = 0; nd < 4; ++nd) { mb[(2 + 2 * nd) * 64] = pk2(o[nd][0], o[nd][1]); mb[(3 + 2 * nd) * 64] = pk2(o[nd][2], o[nd][3]); } }
        if (pf) { const int sl = (r + 4) % 9; *(LAS u32x4*)(lds + KRING + sl * 8192 + st_off) = pk_; *(LAS u32x4*)(lds + VRING + sl * 8192 + st_off) = pv_; }
        __syncthreads();
        if (merger) {
            const float m2 = __uint_as_float(mb[0]), l2 = __uint_as_float(mb[64]);
            const float mN = fmaxf(mx, m2), a1 = __builtin_amdgcn_exp2f(mx - mN), a2 = __builtin_amdgcn_exp2f(m2 - mN);
            const float rl = frcp(sum * a1 + l2 * a2);
            bf16_t* op = mix + ((size_t)b * T + r * 64 + 16 * qb + fr) * D + 1024 + h * 64 + 4 * fq;
            unsigned char* op8 = (unsigned char*)mix + ((size_t)b * T + r * 64 + 16 * qb + fr) * D + 1024 + h * 64 + 4 * fq;
#pragma unroll
            for (int nd = 0; nd < 4; ++nd) { const unsigned w0 = mb[(2 + 2 * nd) * 64], w1 = mb[(3 + 2 * nd) * 64];
                const float x0 = (o[nd][0] * a1 + __uint_as_float(w0 << 16) * a2) * rl, x1 = (o[nd][1] * a1 + __uint_as_float(w0 & 0xffff0000u) * a2) * rl;
                const float x2 = (o[nd][2] * a1 + __uint_as_float(w1 << 16) * a2) * rl, x3 = (o[nd][3] * a1 + __uint_as_float(w1 & 0xffff0000u) * a2) * rl;
                if (OUT_F8) *(unsigned*)(op8 + 16 * nd) = pk4_fp8(x0 * F8_SM, x1 * F8_SM, x2 * F8_SM, x3 * F8_SM);
                else { u32x2 ov; ov.x = pk2(x0, x1); ov.y = pk2(x2, x3); *(u32x2*)(op + 16 * nd) = ov; } }
        }
        qf[0] = qn0; qf[1] = qn1;
    }
    __syncthreads();
}

#ifndef PROBE
#define PROBE 0
#endif
#define PH(k, ...) do { __VA_ARGS__ if constexpr (PROBE == (k)) { xcd_barrier(bar); __VA_ARGS__ } } while (0)
__global__ void __launch_bounds__(512, 2) fwd_kernel(Params p) {
    extern __shared__ __attribute__((aligned(16))) unsigned char lds_raw[];
    LAS unsigned char* lds = (LAS unsigned char*)lds_raw;
    volatile LAS unsigned* xbw = (volatile LAS unsigned*)(lds + LDS_BYTES - 16);
    if (threadIdx.x < 4) xbw[threadIdx.x] = 0u;
    __syncthreads();
    unsigned* ctl = (unsigned*)(p.wp[IX_CTL]);
    XcdBarrier bar = xcd_barrier_post(ctl + CW_BAR, xbw);
    float* mod = (float*)(p.wp[IX_MOD]);
    float* xb = (float*)(p.wp[IX_XB]);
    bf16_t* act = (bf16_t*)(p.wp[IX_ACT]);
    bf16_t* proj = (bf16_t*)(p.wp[IX_PROJ]);
    bf16_t* hid = (bf16_t*)(p.wp[IX_HID]);
    bf16_t* ybuf = (bf16_t*)(p.wp[IX_Y]);
    bf16_t* mres = (bf16_t*)(p.wp[IX_O1]);
    unsigned* cnt0 = ctl + CW_CNT; unsigned* cnt1 = ctl + CW_CNT + 64;
    LAS int* base = (LAS int*)(lds + LDS_BASE_OFF);
    const int G = gridDim.x, cid = blockIdx.x;
    if constexpr (PROBE == 20) { for (int i = 0; i < 10; ++i) xcd_barrier(bar); }
    if constexpr (PROBE == 22) { xcd_barrier(bar); }

    PH(1, phase_mod(p, lds); __syncthreads(););
    PH(2, phase_convert(p, lds););
    xcd_barrier(bar);
    PH(3, phase_rows<false, false, false, true>(p, lds, p.in[0], nullptr, p.in[2], mod, 0, D, nullptr, act, nullptr, nullptr, nullptr););
    xcd_barrier(bar);
    if constexpr (PROBE == 21) { xcd_barrier(bar); xcd_barrier(bar); xcd_barrier(bar); xcd_barrier(bar); xcd_barrier(bar); xcd_barrier(bar); xcd_barrier(bar); xcd_barrier(bar); xcd_barrier(bar); xcd_barrier(bar); }
    PH(4, { pg8::StaticOrder S; S.init(M, 7168, G, cid); pg8::EpiBf16 E{proj, LD0, 1.f / (F8_SA * F8_SW)};
        ConvHook hk{&p, lds, ((int)blockIdx.x >> 3) % 7, false};
        pg8::gemm_phase<pg8::EpiBf16, pg8::StaticOrder, true, true, true, ConvHook&>(lds, act, p.wp[IX_WIN0], D, S, E, hk);
        if (!hk.done) hk.run();
        pg8::StaticOrder S2; S2.init(1024, M, G, cid); pg8::EpiBf16 E2{(bf16_t*)(p.wp[IX_VT]), VTLD, 1.f / (F8_SA * F8_SW)};
        pg8::gemm_phase<pg8::EpiBf16, pg8::StaticOrder, true, true, true>(lds, p.wp[IX_WIN0] + (size_t)7168 * D, act, D, S2, E2); });
    xcd_barrier(bar);
    PH(5, hgrn_mfma(p, lds););
    { const bool split = G >= 256; const int nw = split ? G - 128 : G, widx = split ? cid - 128 : cid;
      if (widx >= 0) { for (int u = widx; u < NB * 16; u += nw) na_ring(p, lds, u); convert_naw(p, lds, widx, nw); } }
    if constexpr (PROBE == 6) { xcd_barrier(bar); for (int u = cid; u < NB * 16; u += G) na_ring(p, lds, u); }
    xcd_barrier(bar);
    PH(7, hgrn_combine(p););
    xcd_barrier(bar);
    PH(8, { pg8::StaticOrder S; S.init(M, D, G, cid); pg8::EpiBf16 E{mres, D, OUT_F8 ? 1.f / (F8_SM * F8_SWD) : 1.f};
        pg8::gemm_phase<pg8::EpiBf16, pg8::StaticOrder, true, true, OUT_F8>(lds, act, p.wp[IX_WOUT0], D, S, E); });
    xcd_barrier(bar);
    phase_rows<false, true, false, true>(p, lds, p.in[0], nullptr, p.in[9], mod, 3 * D, 4 * D, nullptr, act, nullptr, nullptr, cnt0, mres);
    if constexpr (PROBE == 15) { xcd_barrier(bar); phase_rows<false, true, false, true, true>(p, lds, p.in[0], nullptr, p.in[9], mod, 3 * D, 4 * D, nullptr, act, nullptr, nullptr, ctl + CW_CNT + 128, mres); }
    xcd_barrier(bar);
    compute_base(cnt0, base);
    { pg8::MoeOrder<true, 0, true, false> S{base, (const int*)(p.wp[IX_LIST]), cnt0, G, cid, base[NE] / 256, ctl + CW_FLG}; pg8::EpiGluF8 E{(unsigned char*)hid, (const float*)(p.wp[IX_LW]), cnt0, base};
        pg8::gemm_phase<pg8::EpiGluF8, pg8::MoeOrder<true, 0, true, false>, true, true, true>(lds, act, p.wp[IX_WGU0], D, S, E); }
    { pg8::MoeOrder<false, 2, false, true> S{base, nullptr, cnt0, G, cid, base[NE] / 256, ctl + CW_FLG}; pg8::EpiBf16 E{ybuf, D, 1.f / (F8_SH * F8_SWD)};
        pg8::gemm_phase<pg8::EpiBf16, pg8::MoeOrder<false, 2, false, true>, true, true, true>(lds, hid, p.wp[IX_WD0], DFF, S, E); }
    xcd_barrier(bar);
    PH(11, phase_combine<false, true>(p, lds, p.in[0], xb, p.in[13], mod + 8 * 12288, mod, act, nullptr, cnt0, mres););
    xcd_barrier(bar);
    PH(12, { pg8::StaticOrder S; S.init(M, ODW, G, cid); pg8::EpiBf16Rope E{proj, LD1, (const float*)(p.wp[IX_ROPE]), (const float*)(p.wp[IX_ROPE]) + 2048 * 16, 1.f / (F8_SA * F8_SW)};
        pg8::gemm_phase<pg8::EpiBf16Rope, pg8::StaticOrder, true, true, true>(lds, act, p.wp[IX_WIN1], D, S, E); });
    xcd_barrier(bar);
    PH(13, diffattn_units(p, lds, p.out, (float*)(p.wp[IX_O1])););
    xcd_barrier(bar);
    { pg8::StaticOrder S; S.init(M, D, G, cid); pg8::EpiBf16 E{mres, D, OUT_F8 ? 1.f / (F8_SM * F8_SWD) : 1.f};
      pg8::gemm_phase<pg8::EpiBf16, pg8::StaticOrder, true, true, OUT_F8>(lds, act, p.wp[IX_WOUT1], D, S, E); }
    xcd_barrier(bar);
    phase_rows<false, true, false, true>(p, lds, xb, nullptr, p.in[20], mod + 8 * 12288, 3 * D, 4 * D, nullptr, act, nullptr, nullptr, cnt1, mres);
    xcd_barrier(bar);
    compute_base(cnt1, base);
    { pg8::MoeOrder<true, 0, true, false> S{base, (const int*)(p.wp[IX_LIST]), cnt1, G, cid, base[NE] / 256, ctl + CW_FLG + 256}; pg8::EpiGluF8 E{(unsigned char*)hid, (const float*)(p.wp[IX_LW]), cnt1, base};
      pg8::gemm_phase<pg8::EpiGluF8, pg8::MoeOrder<true, 0, true, false>, true, true, true>(lds, act, p.wp[IX_WGU1], D, S, E); }
    { pg8::MoeOrder<false, 2, false, true> S{base, nullptr, cnt1, G, cid, base[NE] / 256, ctl + CW_FLG + 256}; pg8::EpiBf16 E{ybuf, D, 1.f / (F8_SH * F8_SWD)};
      pg8::gemm_phase<pg8::EpiBf16, pg8::MoeOrder<false, 2, false, true>, true, true, true>(lds, hid, p.wp[IX_WD1], DFF, S, E); }
    xcd_barrier(bar);
    PH(16, phase_combine<true, false>(p, lds, xb, nullptr, p.in[27], nullptr, mod + 8 * 12288, nullptr, p.out, cnt1, mres););
}

extern "C" void kernel_launch(void* const* d_in, const int* in_sizes, int n_in, void* d_out, int out_size, void* d_ws, size_t ws_size, hipStream_t stream) {
    static int grid = 0;
    if (grid == 0) {
        if (n_in != 28 || out_size != M * D || ws_size < WS_END) { fprintf(stderr, "kernel_launch: unexpected shapes: n_in %d out %d ws %zu\n", n_in, out_size, ws_size); grid = -1; return; }
        int dev = 0, cus = 0, per_cu = 0;
        if (hipGetDevice(&dev) != hipSuccess || hipDeviceGetAttribute(&cus, hipDeviceAttributeMultiprocessorCount, dev) != hipSuccess) { grid = -1; return; }
        if (hipFuncSetAttribute((const void*)fwd_kernel, hipFuncAttributeMaxDynamicSharedMemorySize, LDS_BYTES) != hipSuccess) { fprintf(stderr, "kernel_launch: hipFuncSetAttribute failed\n"); grid = -1; return; }
        if (hipOccupancyMaxActiveBlocksPerMultiprocessor(&per_cu, (const void*)fwd_kernel, 512, LDS_BYTES) != hipSuccess || per_cu < 1) { fprintf(stderr, "kernel_launch: occupancy query says %d\n", per_cu); grid = -1; return; }
        (void)hipGetLastError();
        grid = cus;
    }
    if (grid < 0) return;
    if (hipMemsetAsync((char*)d_ws + WS_CTL, 0, CTL_BYTES, stream) != hipSuccess) return;
    Params p{};
    for (int i = 0; i < 28; ++i) p.in[i] = (const float*)d_in[i];
    p.out = (float*)d_out;
    p.wp[IX_ACT] = (unsigned char*)d_ws + WS_ACT;
    p.wp[IX_CTL] = (unsigned char*)d_ws + WS_CTL;
    p.wp[IX_HID] = (unsigned char*)d_ws + WS_HID;
    p.wp[IX_LIST] = (unsigned char*)d_ws + WS_LIST;
    p.wp[IX_LW] = (unsigned char*)d_ws + WS_LW;
    p.wp[IX_MOD] = (unsigned char*)d_ws + WS_MOD;
    p.wp[IX_O1] = (unsigned char*)d_ws + WS_O1;
    p.wp[IX_PROJ] = (unsigned char*)d_ws + WS_PROJ;
    p.wp[IX_ROPE] = (unsigned char*)d_ws + WS_ROPE;
    p.wp[IX_TOK] = (unsigned char*)d_ws + WS_TOK;
    p.wp[IX_VT] = (unsigned char*)d_ws + WS_VT;
    p.wp[IX_WD0] = (unsigned char*)d_ws + WS_WD0;
    p.wp[IX_WD1] = (unsigned char*)d_ws + WS_WD1;
    p.wp[IX_WGU0] = (unsigned char*)d_ws + WS_WGU0;
    p.wp[IX_WGU1] = (unsigned char*)d_ws + WS_WGU1;
    p.wp[IX_WIN0] = (unsigned char*)d_ws + WS_WIN0;
    p.wp[IX_WIN1] = (unsigned char*)d_ws + WS_WIN1;
    p.wp[IX_WOUT0] = (unsigned char*)d_ws + WS_WOUT0;
    p.wp[IX_WOUT1] = (unsigned char*)d_ws + WS_WOUT1;
    p.wp[IX_XB] = (unsigned char*)d_ws + WS_XB;
    p.wp[IX_Y] = (unsigned char*)d_ws + WS_Y;
    for (int j = 0; j < 16; ++j) p.inv[j] = pow(500000.0, -(double)j / 16.0);
    hipLaunchKernelGGL(fwd_kernel, dim3(grid), dim3(512), LDS_BYTES, stream, p);
    const hipError_t le = hipPeekAtLastError();
    if (le != hipSuccess) fprintf(stderr, "kernel_launch: launch failed: %s\n", hipGetErrorName(le));
}
```
